# Optimizing an MI355X kernel written in HIP

```python
import jax
import jax.numpy as jnp
from jax import lax
import numpy as np

D_MODEL = 1024
BATCH = 16
SEQ = 2048
DEPTH = 4

MIX_WIDTH = D_MODEL
MOBA_HEADS = 4
MOBA_WIDTH = MIX_WIDTH // 4
MOBA_DH = MOBA_WIDTH // MOBA_HEADS
MOBA_BLOCK = 256
MOBA_TOPK = 3
MOBA_Q_CHUNK = 16
MLSTM_HEADS = 4
MLSTM_WIDTH = MIX_WIDTH // 2
MLSTM_DV = MLSTM_WIDTH // MLSTM_HEADS
MLSTM_DQK = MLSTM_DV // 2
MLSTM_CHUNK = 64
MLSTM_CONV = 4
NSA_HEADS = 4
NSA_WIDTH = MIX_WIDTH - MOBA_WIDTH - MLSTM_WIDTH
NSA_DH = NSA_WIDTH // NSA_HEADS
NSA_CMP_LEN = 32
NSA_CMP_STRIDE = 16
NSA_CMP_HIDDEN = 256
NSA_SEL_BLOCK = 64
NSA_TOPN = 8
NSA_WINDOW = 512
NSA_Q_CHUNK = 64
D_FF = 4 * D_MODEL
NORM_EPS = 1e-6
NEG_INF = -1e30

IN_SPLITS = (
    MOBA_WIDTH, MOBA_WIDTH, MOBA_WIDTH,
    MLSTM_HEADS * MLSTM_DQK, MLSTM_HEADS * MLSTM_DQK,
    MLSTM_WIDTH, MLSTM_WIDTH,
    MLSTM_HEADS, MLSTM_HEADS,
    NSA_WIDTH,
    NSA_DH, NSA_DH, NSA_DH, NSA_DH, NSA_DH, NSA_DH,
    3 * NSA_HEADS,
)
D_IN = sum(IN_SPLITS)

kernel_name = 'hybrid_moba_mlstm_nsa_trunk'


def _rms_norm(x, g):
    xf = x.astype(jnp.float32)
    y = xf * lax.rsqrt(jnp.mean(xf * xf, axis=-1, keepdims=True) + NORM_EPS)
    return (y * g.astype(jnp.float32)).astype(x.dtype)


def _head_norm(y, g):
    b, s, h, dh = y.shape
    return _rms_norm(y, g.reshape(h, dh)).reshape(b, s, h * dh)


def _causal_conv(x, w, bias):
    k, c = w.shape
    y = lax.conv_general_dilated(x, w[:, None, :].astype(x.dtype), window_strides=(1,),
                                 padding=[(k - 1, 0)], dimension_numbers=('NWC', 'WIO', 'NWC'),
                                 feature_group_count=c)
    return y + bias.astype(x.dtype)


def _moba_attention(q, k, v):
    b, h, s, dh = q.shape
    n_blk = -(-s // MOBA_BLOCK)
    s_pad = n_blk * MOBA_BLOCK
    pad = ((0, 0), (0, 0), (0, s_pad - s), (0, 0))
    q, k, v = jnp.pad(q, pad), jnp.pad(k, pad), jnp.pad(v, pad)
    k_blk = k.reshape(b * h, n_blk, MOBA_BLOCK, dh)
    v_blk = v.reshape(b * h, n_blk, MOBA_BLOCK, dh)
    k_mean = jnp.mean(k_blk.astype(jnp.float32), axis=2).reshape(b, h, n_blk, dh)
    n_top = min(MOBA_TOPK, n_blk - 1)
    cq = MOBA_Q_CHUNK
    n_chunks = s_pad // cq
    q_chunks = jnp.moveaxis(q.reshape(b, h, n_chunks, cq, dh), 2, 0)
    scale = dh ** -0.5
    bh_ids = jnp.arange(b * h)[:, None]
    blk_ids = jnp.arange(n_blk)

    def one_chunk(args):
        c, qb = args
        q0 = c * cq
        q_pos = q0 + jnp.arange(cq)
        cur = q0 // MOBA_BLOCK
        k_own = lax.dynamic_slice_in_dim(k, cur * MOBA_BLOCK, MOBA_BLOCK, axis=2)
        v_own = lax.dynamic_slice_in_dim(v, cur * MOBA_BLOCK, MOBA_BLOCK, axis=2)
        k_pos = cur * MOBA_BLOCK + jnp.arange(MOBA_BLOCK)
        s_own = jnp.einsum('bhqd,bhkd->bhqk', qb, k_own).astype(jnp.float32) * scale
        s_own = jnp.where(k_pos[None, :] <= q_pos[:, None], s_own, NEG_INF)
        if n_top == 0:
            p_own = jax.nn.softmax(s_own, axis=-1).astype(v.dtype)
            return jnp.einsum('bhqk,bhkd->bhqd', p_own, v_own)
        gate = jnp.einsum('bhqd,bhnd->bhqn', qb.astype(jnp.float32), k_mean)
        gate = jnp.where(blk_ids < cur, gate, -jnp.inf)
        g_val, g_idx = lax.top_k(gate, n_top)
        flat_idx = g_idx.reshape(b * h, cq * n_top)
        k_sel = k_blk[bh_ids, flat_idx].reshape(b, h, cq, n_top, MOBA_BLOCK, dh)
        v_sel = v_blk[bh_ids, flat_idx].reshape(b, h, cq, n_top, MOBA_BLOCK, dh)
        s_sel = jnp.einsum('bhqd,bhqjkd->bhqjk', qb, k_sel).astype(jnp.float32) * scale
        s_sel = jnp.where((g_val > -jnp.inf)[..., None], s_sel, NEG_INF)
        scores = jnp.concatenate([s_sel.reshape(b, h, cq, n_top * MOBA_BLOCK), s_own], axis=-1)
        p = jax.nn.softmax(scores, axis=-1).astype(v.dtype)
        p_sel = p[..., : n_top * MOBA_BLOCK].reshape(b, h, cq, n_top, MOBA_BLOCK)
        p_own = p[..., n_top * MOBA_BLOCK:]
        return (jnp.einsum('bhqjk,bhqjkd->bhqd', p_sel, v_sel)
                + jnp.einsum('bhqk,bhkd->bhqd', p_own, v_own))

    out = lax.map(one_chunk, (jnp.arange(n_chunks), q_chunks))
    return jnp.moveaxis(out, 0, 2).reshape(b, h, s_pad, dh)[:, :, :s]


def _mlstm_chunkwise(q, k, v, i_pre, f_pre):
    b, s, h, dk = q.shape
    dv = v.shape[-1]
    L = MLSTM_CHUNK
    nc = s // L
    f32 = jnp.float32

    def chunks(t):
        t = jnp.moveaxis(t.astype(f32), 2, 1)
        return t.reshape((b, h, nc, L) + t.shape[3:])

    q = chunks(q)
    k = chunks(k) * (dk ** -0.5)
    v = chunks(v)
    ig = chunks(i_pre)
    logf = jax.nn.log_sigmoid(chunks(f_pre))
    bcum = jnp.cumsum(logf, axis=-1)
    b_end = bcum[..., -1]
    w_end = b_end[..., None] - bcum + ig
    a_end = jnp.max(w_end, axis=-1)
    e_end = jnp.exp(w_end - a_end[..., None])
    c_chunk = jnp.einsum('bhcs,bhcsv,bhcsk->bhcvk', e_end, v, k)
    n_chunk = jnp.einsum('bhcs,bhcsk->bhck', e_end, k)

    def step(carry, xs):
        c_st, n_st, m_st = carry
        be, ac, cc, nn = xs
        m_new = jnp.maximum(be + m_st, ac)
        decay = jnp.exp(be + m_st - m_new)
        inj = jnp.exp(ac - m_new)
        c_new = decay[..., None, None] * c_st + inj[..., None, None] * cc
        n_new = decay[..., None] * n_st + inj[..., None] * nn
        return (c_new, n_new, m_new), (c_st, n_st, m_st)

    init = (jnp.zeros((b, h, dv, dk), f32), jnp.zeros((b, h, dk), f32), jnp.zeros((b, h), f32))
    xs = (jnp.moveaxis(b_end, 2, 0), jnp.moveaxis(a_end, 2, 0),
          jnp.moveaxis(c_chunk, 2, 0), jnp.moveaxis(n_chunk, 2, 0))
    _, (c_prev, n_prev, m_prev) = lax.scan(step, init, xs)
    c_prev = jnp.moveaxis(c_prev, 0, 2)
    n_prev = jnp.moveaxis(n_prev, 0, 2)
    m_prev = jnp.moveaxis(m_prev, 0, 2)

    causal = jnp.tril(jnp.ones((L, L), dtype=bool))
    d_log = jnp.where(causal, bcum[..., :, None] - bcum[..., None, :] + ig[..., None, :], -jnp.inf)
    m_inter = bcum + m_prev[..., None]
    m_t = jnp.maximum(m_inter, jnp.max(d_log, axis=-1))
    s_intra = jnp.einsum('bhctd,bhcsd->bhcts', q, k) * jnp.exp(d_log - m_t[..., None])
    w_inter = jnp.exp(m_inter - m_t)
    num = (jnp.einsum('bhcts,bhcsv->bhctv', s_intra, v)
           + jnp.einsum('bhctd,bhcvd->bhctv', q, c_prev) * w_inter[..., None])
    den = s_intra.sum(axis=-1) + jnp.einsum('bhctd,bhcd->bhct', q, n_prev) * w_inter
    hid = num / jnp.maximum(jnp.abs(den), jnp.exp(-m_t))[..., None]
    return jnp.moveaxis(hid.reshape(b, h, s, dv), 1, 2)


def _nsa_attention(q, kc, vc, ksl, vsl, kwn, vwn, gate_pre, cmp_pe, cmp_w1, cmp_w2):
    b, h, s, dh = q.shape
    f32 = jnp.float32
    scale = dh ** -0.5
    t_pos = jnp.arange(s)

    n_cmp = (s - NSA_CMP_LEN) // NSA_CMP_STRIDE + 1
    cmp_idx = jnp.arange(n_cmp)[:, None] * NSA_CMP_STRIDE + jnp.arange(NSA_CMP_LEN)[None, :]

    def compress(t, j):
        blk = t[:, cmp_idx] + cmp_pe[j]
        blk = blk.reshape(b, n_cmp, NSA_CMP_LEN * dh)
        return jax.nn.gelu(blk @ cmp_w1[j]) @ cmp_w2[j]

    k_cmp = compress(kc, 0)
    v_cmp = compress(vc, 1)
    cmp_end = jnp.arange(n_cmp) * NSA_CMP_STRIDE + NSA_CMP_LEN - 1
    vis = cmp_end[None, :] <= t_pos[:, None]
    s_cmp = jnp.einsum('bhtd,bnd->bhtn', q, k_cmp).astype(f32) * scale
    p_cmp = jnp.where(vis, jax.nn.softmax(jnp.where(vis, s_cmp, NEG_INF), axis=-1), 0.0)
    o_cmp = jnp.einsum('bhtn,bnd->bhtd', p_cmp.astype(v_cmp.dtype), v_cmp)

    n_sel = s // NSA_SEL_BLOCK
    lo = np.arange(n_cmp)[:, None] * NSA_CMP_STRIDE
    sl = np.arange(n_sel)[None, :] * NSA_SEL_BLOCK
    overlap = np.maximum(np.minimum(lo + NSA_CMP_LEN, sl + NSA_SEL_BLOCK) - np.maximum(lo, sl), 0) / NSA_CMP_LEN
    p_slc = jnp.einsum('btn,nj->btj', p_cmp.sum(axis=1), jnp.asarray(overlap, dtype=f32))
    blk_ids = jnp.arange(n_sel)[None, :]
    cur = (t_pos // NSA_SEL_BLOCK)[:, None]
    forced = (blk_ids == 0) | (blk_ids == cur) | (blk_ids == cur - 1)
    score = jnp.where(blk_ids > cur, -jnp.inf, jnp.where(forced, jnp.inf, p_slc))
    top = min(NSA_TOPN, n_sel)
    s_val, s_idx = lax.top_k(score, top)
    s_valid = s_val > -jnp.inf

    cq = NSA_Q_CHUNK
    n_ch = s // cq
    k_sel_blk = ksl.reshape(b, n_sel, NSA_SEL_BLOCK, dh)
    v_sel_blk = vsl.reshape(b, n_sel, NSA_SEL_BLOCK, dh)
    win_pad = ((0, 0), (NSA_WINDOW, 0), (0, 0))
    k_win_pad = jnp.pad(kwn, win_pad)
    v_win_pad = jnp.pad(vwn, win_pad)
    b_ids = jnp.arange(b)[:, None]
    q_c = jnp.moveaxis(q.reshape(b, h, n_ch, cq, dh), 2, 0)
    idx_c = jnp.moveaxis(s_idx.reshape(b, n_ch, cq, top), 1, 0)
    val_c = jnp.moveaxis(s_valid.reshape(b, n_ch, cq, top), 1, 0)

    def one_chunk(args):
        c, qb, idx, valid = args
        q0 = c * cq
        q_pos = q0 + jnp.arange(cq)
        flat_idx = idx.reshape(b, cq * top)
        k_sel = k_sel_blk[b_ids, flat_idx].reshape(b, cq, top, NSA_SEL_BLOCK, dh)
        v_sel = v_sel_blk[b_ids, flat_idx].reshape(b, cq, top, NSA_SEL_BLOCK, dh)
        k_pos = idx[..., None] * NSA_SEL_BLOCK + jnp.arange(NSA_SEL_BLOCK)
        m_sel = valid[..., None] & (k_pos <= q_pos[None, :, None, None])
        s_sel = jnp.einsum('bhqd,bqjkd->bhqjk', qb, k_sel).astype(f32) * scale
        s_sel = jnp.where(m_sel[:, None], s_sel, NEG_INF).reshape(b, h, cq, top * NSA_SEL_BLOCK)
        p_sel = jax.nn.softmax(s_sel, axis=-1).astype(v_sel.dtype).reshape(b, h, cq, top, NSA_SEL_BLOCK)
        o_sel = jnp.einsum('bhqjk,bqjkd->bhqd', p_sel, v_sel)
        k_win = lax.dynamic_slice_in_dim(k_win_pad, q0, NSA_WINDOW + cq, axis=1)
        v_win = lax.dynamic_slice_in_dim(v_win_pad, q0, NSA_WINDOW + cq, axis=1)
        w_pos = q0 - NSA_WINDOW + jnp.arange(NSA_WINDOW + cq)
        rel = q_pos[:, None] - w_pos[None, :]
        m_win = (w_pos[None, :] >= 0) & (rel >= 0) & (rel < NSA_WINDOW)
        s_win = jnp.einsum('bhqd,bkd->bhqk', qb, k_win).astype(f32) * scale
        p_win = jax.nn.softmax(jnp.where(m_win, s_win, NEG_INF), axis=-1).astype(v_win.dtype)
        o_win = jnp.einsum('bhqk,bkd->bhqd', p_win, v_win)
        return o_sel, o_win

    o_sel, o_win = lax.map(one_chunk, (jnp.arange(n_ch), q_c, idx_c, val_c))
    o_sel = jnp.moveaxis(o_sel, 0, 2).reshape(b, h, s, dh)
    o_win = jnp.moveaxis(o_win, 0, 2).reshape(b, h, s, dh)
    g = jax.nn.sigmoid(gate_pre.astype(f32)).transpose(0, 2, 1, 3)
    out = g[..., 0:1] * o_cmp + g[..., 1:2] * o_sel + g[..., 2:3] * o_win
    return out.astype(q.dtype).transpose(0, 2, 1, 3)


def _hybrid_layer(x, norm_g, w_in, conv_w, conv_b, gate_b, cmp_pe, cmp_w1, cmp_w2, head_g, w_out, w1, w2):
    b, s, _ = x.shape
    hin = _rms_norm(x, norm_g[0])
    z = hin @ w_in
    split_points = [int(p) for p in np.cumsum(IN_SPLITS)[:-1]]
    (mq, mk, mv, lq, lk, lv, lo, li, lf,
     nq, kc, vc, ksl, vsl, kwn, vwn, ng) = jnp.split(z, split_points, axis=-1)

    def heads(t, n):
        return t.reshape(b, s, n, -1).transpose(0, 2, 1, 3)

    y_moba = _moba_attention(heads(mq, MOBA_HEADS), heads(mk, MOBA_HEADS), heads(mv, MOBA_HEADS))
    y_moba = y_moba.transpose(0, 2, 1, 3)
    qk = jax.nn.silu(_causal_conv(jnp.concatenate([lq, lk], axis=-1), conv_w, conv_b))
    lq, lk = jnp.split(qk, 2, axis=-1)
    y_ml = _mlstm_chunkwise(lq.reshape(b, s, MLSTM_HEADS, MLSTM_DQK), lk.reshape(b, s, MLSTM_HEADS, MLSTM_DQK),
                            lv.reshape(b, s, MLSTM_HEADS, MLSTM_DV), li + gate_b[0], lf + gate_b[1]).astype(x.dtype)
    y_nsa = _nsa_attention(heads(nq, NSA_HEADS), kc, vc, ksl, vsl, kwn, vwn,
                           ng.reshape(b, s, NSA_HEADS, 3), cmp_pe, cmp_w1, cmp_w2)
    g_moba, g_ml, g_nsa = jnp.split(head_g, [MOBA_WIDTH, MOBA_WIDTH + MLSTM_WIDTH])
    y = jnp.concatenate([_head_norm(y_moba, g_moba),
                         _head_norm(y_ml, g_ml) * jax.nn.sigmoid(lo),
                         _head_norm(y_nsa, g_nsa)], axis=-1)
    x = x + _rms_norm(y @ w_out, norm_g[1])
    hm = _rms_norm(x, norm_g[2])
    y = jnp.square(jax.nn.relu(hm @ w1)) @ w2
    return x + _rms_norm(y, norm_g[3])


def setup_inputs(seed: int = 0) -> dict:
    key = jax.random.key(seed)
    ks = jax.random.split(key, 14)
    f32 = jnp.float32

    def normal(k, shape, scale):
        return jax.random.normal(k, shape, f32) * scale

    qk_width = 2 * MLSTM_HEADS * MLSTM_DQK
    i_bias = normal(ks[5], (DEPTH, MLSTM_HEADS), 0.1)
    f_bias = jnp.linspace(3.0, 6.0, MLSTM_HEADS, dtype=f32)[None, :] + normal(ks[6], (DEPTH, MLSTM_HEADS), 0.1)
    return {
        'x': normal(ks[0], (BATCH, SEQ, D_MODEL), 1.0),
        'norm_g': 1.0 + normal(ks[1], (DEPTH, 4, D_MODEL), 0.02),
        'w_in': normal(ks[2], (DEPTH, D_MODEL, D_IN), D_MODEL ** -0.5),
        'mlstm_conv_w': normal(ks[3], (DEPTH, MLSTM_CONV, qk_width), MLSTM_CONV ** -0.5),
        'mlstm_conv_b': normal(ks[4], (DEPTH, qk_width), 0.02),
        'mlstm_gate_b': jnp.stack([i_bias, f_bias], axis=1),
        'nsa_cmp_pe': normal(ks[7], (DEPTH, 2, NSA_CMP_LEN, NSA_DH), 0.02),
        'nsa_cmp_w1': normal(ks[8], (DEPTH, 2, NSA_CMP_LEN * NSA_DH, NSA_CMP_HIDDEN), (NSA_CMP_LEN * NSA_DH) ** -0.5),
        'nsa_cmp_w2': normal(ks[9], (DEPTH, 2, NSA_CMP_HIDDEN, NSA_DH), NSA_CMP_HIDDEN ** -0.5),
        'head_g': 1.0 + normal(ks[10], (DEPTH, MIX_WIDTH), 0.02),
        'w_out': normal(ks[11], (DEPTH, MIX_WIDTH, D_MODEL), MIX_WIDTH ** -0.5),
        'w_mlp1': normal(ks[12], (DEPTH, D_MODEL, D_FF), D_MODEL ** -0.5),
        'w_mlp2': normal(ks[13], (DEPTH, D_FF, D_MODEL), D_FF ** -0.5),
    }


def reference(x, norm_g, w_in, mlstm_conv_w, mlstm_conv_b, mlstm_gate_b, nsa_cmp_pe, nsa_cmp_w1,
              nsa_cmp_w2, head_g, w_out, w_mlp1, w_mlp2):
    for layer in range(DEPTH):
        x = _hybrid_layer(x, norm_g[layer], w_in[layer], mlstm_conv_w[layer], mlstm_conv_b[layer],
                          mlstm_gate_b[layer], nsa_cmp_pe[layer], nsa_cmp_w1[layer], nsa_cmp_w2[layer],
                          head_g[layer], w_out[layer], w_mlp1[layer], w_mlp2[layer])
    return x
```

```cpp
#include <hip/hip_runtime.h>
#include <cstdio>
#include <cstdint>
namespace pg8 {
#define PG8_LAS __attribute__((address_space(3)))
typedef unsigned short bf16_t;
typedef short bf16x8 __attribute__((ext_vector_type(8)));
typedef float f32x4 __attribute__((ext_vector_type(4)));
typedef unsigned u32x4 __attribute__((ext_vector_type(4)));
constexpr int BM = 256, BK = 64, HALF = 128, HTB = HALF * BK * 2  , STAGE_BYTES = 8 * HTB, NXCD = 8, WGM = 8;

__host__ __device__ __forceinline__ int lds_byte(int r, int c) { const int st = (r >> 4) * 2 + (c >> 5), rr = r & 15, cc = c & 31, ob = rr * 64 + cc * 2; return st * 1024 + (ob ^ (((ob >> 9) & 1) << 5)); }
__host__ __device__ __forceinline__ void stage_rc(int b, int& R, int& C) { const int st = b / 1024, sb = b % 1024, swz = sb ^ (((sb >> 9) & 1) << 5); R = (st >> 1) * 16 + swz / 64; C = (st & 1) * 32 + (swz % 64) / 2; }
__host__ __device__ __forceinline__ int perm32(int rho) { const int n = rho >> 4, i = rho & 15; return 8 * (i >> 2) + 4 * n + (i & 3); }

struct Unit { int pm, pn; };
struct Gemm { const bf16_t* A; const bf16_t* Bt; int M, N, K, pad; };

struct StaticOrder {
    int nM, nN, nwg, G, c;
    __host__ __device__ void init(int M, int N, int G_, int c_) { nM = M / BM; nN = N / BM; nwg = nM * nN; G = G_; c = c_; }
    __host__ __device__ bool next(int i, Unit& u) const {
        const long L = (long)i * G + c; if (L >= nwg) return false;
        int wgid = (int)L; { const int q = nwg / NXCD, r = nwg % NXCD, xcd = wgid % NXCD, off = wgid / NXCD; wgid = (xcd < r ? xcd * (q + 1) : r * (q + 1) + (xcd - r) * q) + off; }
        const int nig = WGM * nN, gid = wgid / nig, fm = gid * WGM, gsz = (nM - fm) < WGM ? (nM - fm) : WGM;
        u.pm = fm + ((wgid % nig) % gsz); u.pn = (wgid % nig) / gsz; return true;
    }
    __device__ __forceinline__ void a_ready(const Unit&) const {}
    __device__ __forceinline__ void done(const Unit&) const {}
};

__device__ __forceinline__ unsigned cvt_pk_bf16(float lo, float hi) { unsigned r; asm volatile("v_cvt_pk_bf16_f32 %0, %1, %2" : "=v"(r) : "v"(lo), "v"(hi)); return r; }
typedef float f32x2 __attribute__((ext_vector_type(2)));
struct EpiF32 {
    static constexpr bool PERM = false, AFTER_DRAIN = false;
    float* C; const float* bias; int ldc, pad;
    __device__ __forceinline__ void operator()(const f32x4 (&acc)[2][2][4][2], const Unit& u, int wr, int wc, int fr, int fq) const {
        const int row0 = u.pm * BM + wr * 64 + fr, col0 = u.pn * BM + wc * 32 + 4 * fq;
        f32x4 bv[2][2];
#pragma unroll
        for (int bj = 0; bj < 2; ++bj)
#pragma unroll
            for (int n = 0; n < 2; ++n) bv[bj][n] = bias ? *(const f32x4*)(bias + col0 + bj * HALF + n * 16) : (f32x4){0.f, 0.f, 0.f, 0.f};
#pragma unroll
        for (int ai = 0; ai < 2; ++ai)
#pragma unroll
            for (int m = 0; m < 4; ++m) { float* rowp = C + (size_t)(row0 + ai * HALF + m * 16) * ldc + col0;
#pragma unroll
                for (int bj = 0; bj < 2; ++bj)
#pragma unroll
                    for (int n = 0; n < 2; ++n) *(f32x4*)(rowp + bj * HALF + n * 16) = acc[ai][bj][m][n] + bv[bj][n]; }
    }
};
template <int ACT> struct EpiBf16 {
    static constexpr bool PERM = true, AFTER_DRAIN = false;
    bf16_t* O; int ldc, pad;
    __device__ __forceinline__ void operator()(const f32x4 (&acc)[2][2][4][2], const Unit& u, int wr, int wc, int fr, int fq) const {
        const int row0 = u.pm * BM + wr * 64 + fr; const int col0 = u.pn * BM + wc * 32 + 8 * fq;
#pragma unroll
        for (int ai = 0; ai < 2; ++ai)
#pragma unroll
            for (int m = 0; m < 4; ++m) { bf16_t* rowp = O + (size_t)(row0 + ai * HALF + m * 16) * ldc + col0;
#pragma unroll
                for (int bj = 0; bj < 2; ++bj) { f32x4 v0 = acc[ai][bj][m][0], v1 = acc[ai][bj][m][1];
                    if (ACT == 1) {
#pragma unroll
                        for (int j = 0; j < 4; ++j) { const float a = fmaxf(v0[j], 0.f), b = fmaxf(v1[j], 0.f); v0[j] = a * a; v1[j] = b * b; } }
                    u32x4 w; w.x = cvt_pk_bf16(v0[0], v0[1]); w.y = cvt_pk_bf16(v0[2], v0[3]); w.z = cvt_pk_bf16(v1[0], v1[1]); w.w = cvt_pk_bf16(v1[2], v1[3]);
                    *(u32x4*)(rowp + bj * HALF) = w; } }
    }
};
template <class Epi, class Sched, bool ALIGN_EPI = false, bool SP2 = false>
__device__ __forceinline__ void gemm_phase(PG8_LAS unsigned char* lds, const Gemm g, const Sched& S, const Epi& E) {
    const int tid = threadIdx.x, wid = __builtin_amdgcn_readfirstlane(tid >> 6), lane = tid & 63, wr = wid >> 2, wc = wid & 3, fr = lane & 15, fq = lane >> 4;
    const int K = g.K, nt = K / BK;
    unsigned voffA[2], voffB[2];
#pragma unroll
    for (int i = 0; i < 2; ++i) { int R, C; stage_rc(tid * 16 + i * 8192, R, C); const int Rb = Epi::PERM ? ((R & ~31) + perm32(R & 31)) : R;
        voffA[i] = (unsigned)(R * K + C) * 2u; voffB[i] = (unsigned)(Rb * K + C) * 2u; }
    const size_t kstep = (size_t)(BK * 2);
    const size_t hstep = (size_t)HALF * K * 2;
    const size_t tstep = 2 * hstep;
    const unsigned ldsw = (unsigned)wid * 1024u;
    const int aoff = lds_byte(wr * 64 + fr, fq * 8), boff = lds_byte(wc * 32 + fr, fq * 8);
#define PG8_SA(b, h) (((b) * 2 + (h)) * HTB)
#define PG8_SB(b, h) ((4 + (b) * 2 + (h)) * HTB)
#define PG8_STAGE(bufoff, gbase, voff) do { _Pragma("unroll") for (int _i = 0; _i < 2; ++_i) \
        __builtin_amdgcn_global_load_lds((const unsigned*)((const char*)(gbase) + (voff)[_i]), (PG8_LAS unsigned*)(lds + (bufoff) + ldsw + _i * 8192), 16, 0, 0); } while (0)
#define PG8_LDA(dst, b, h) do { _Pragma("unroll") for (int m = 0; m < 4; ++m) _Pragma("unroll") for (int k = 0; k < 2; ++k) dst[m][k] = *(const PG8_LAS bf16x8*)(lds + PG8_SA(b, h) + aoff + m * 2048 + k * 1024); } while (0)
#define PG8_LDB(dst, b, h) do { _Pragma("unroll") for (int n = 0; n < 2; ++n) _Pragma("unroll") for (int k = 0; k < 2; ++k) dst[n][k] = *(const PG8_LAS bf16x8*)(lds + PG8_SB(b, h) + boff + n * 2048 + k * 1024); } while (0)
#define PG8_MMA(ai, bj, At, Bt) do { __builtin_amdgcn_s_setprio(1); _Pragma("unroll") for (int m = 0; m < 4; ++m) _Pragma("unroll") for (int n = 0; n < 2; ++n) _Pragma("unroll") for (int k = 0; k < 2; ++k) \
        acc[ai][bj][m][n] = __builtin_amdgcn_mfma_f32_16x16x32_bf16(Bt[n][k], At[m][k], acc[ai][bj][m][n], 0, 0, 0); __builtin_amdgcn_s_setprio(0); } while (0)
#define PG8_WAIT_V(n) asm volatile("s_waitcnt vmcnt(" #n ")" ::: "memory")
#define PG8_WAIT_L(n) asm volatile("s_waitcnt lgkmcnt(" #n ")" ::: "memory")
#define PG8_BAR __builtin_amdgcn_s_barrier()
#define PG8_SCHED __builtin_amdgcn_sched_barrier(0)
    Unit cur, nxt; int ui = 0;
    if (!S.next(0, cur)) return;
    f32x4 acc[2][2][4][2];
#pragma unroll
    for (int a = 0; a < 2; ++a)
#pragma unroll
        for (int b = 0; b < 2; ++b)
#pragma unroll
            for (int m = 0; m < 4; ++m)
#pragma unroll
                for (int n = 0; n < 2; ++n) acc[a][b][m][n] = (f32x4){0.f, 0.f, 0.f, 0.f};
    bf16x8 At[4][2], B0[2][2], B1[2][2];
    const char* cA = (const char*)g.A + (size_t)cur.pm * tstep; const char* cB = (const char*)g.Bt + (size_t)cur.pn * tstep;
    S.a_ready(cur);
    if constexpr (SP2) {
        PG8_STAGE(PG8_SB(0, 0), cB, voffB); PG8_STAGE(PG8_SB(0, 1), cB + hstep, voffB); PG8_STAGE(PG8_SA(0, 0), cA, voffA); PG8_STAGE(PG8_SA(0, 1), cA + hstep, voffA);
        if (wr == 1) PG8_BAR;
        PG8_WAIT_V(2); PG8_BAR;
        PG8_STAGE(PG8_SB(1, 0), cB + kstep, voffB); PG8_STAGE(PG8_SA(1, 0), cA + kstep, voffA); PG8_STAGE(PG8_SB(1, 1), cB + hstep + kstep, voffB);
        PG8_WAIT_V(6); PG8_BAR;
    } else {
        PG8_STAGE(PG8_SB(0, 0), cB, voffB); PG8_STAGE(PG8_SA(0, 0), cA, voffA); PG8_STAGE(PG8_SB(0, 1), cB + hstep, voffB); PG8_STAGE(PG8_SA(0, 1), cA + hstep, voffA);
        if (wr == 1) PG8_BAR;
        PG8_WAIT_V(4); PG8_BAR;
        PG8_STAGE(PG8_SB(1, 0), cB + kstep, voffB); PG8_STAGE(PG8_SA(1, 0), cA + kstep, voffA); PG8_STAGE(PG8_SB(1, 1), cB + hstep + kstep, voffB);
        PG8_WAIT_V(6); PG8_BAR;
    }
    for (;;) {
        const bool has_next = S.next(ui + 1, nxt);
        const char* nA = has_next ? (const char*)g.A + (size_t)nxt.pm * tstep : cA; const char* nB = has_next ? (const char*)g.Bt + (size_t)nxt.pn * tstep : cB;
        for (int t = 0; t < nt; t += 2) {
            const bool last = (t == nt - 2);
            const char* a1 = cA + (size_t)(t + 1) * kstep;
            const char* a2 = last ? nA : cA + (size_t)(t + 2) * kstep; const char* b2 = last ? nB : cB + (size_t)(t + 2) * kstep;
            const char* a3 = a2 + kstep; const char* b3 = b2 + kstep;
            if (last && has_next) S.a_ready(nxt);
            if constexpr (SP2) {
            PG8_LDB(B0, 0, 0); PG8_LDB(B1, 0, 1); PG8_SCHED; PG8_LDA(At, 0, 0); PG8_STAGE(PG8_SA(1, 1), a1 + hstep, voffA);
            PG8_WAIT_V(8); PG8_WAIT_L(0); PG8_BAR; PG8_MMA(0, 0, At, B0); PG8_MMA(0, 1, At, B1); PG8_BAR; PG8_SCHED;
            PG8_LDA(At, 0, 1); PG8_STAGE(PG8_SB(0, 0), b2, voffB); PG8_STAGE(PG8_SB(0, 1), b2 + hstep, voffB); PG8_STAGE(PG8_SA(0, 0), a2, voffA);
            PG8_WAIT_V(8); PG8_WAIT_L(0); PG8_BAR; PG8_MMA(1, 0, At, B0); PG8_MMA(1, 1, At, B1); PG8_BAR; PG8_SCHED;
            PG8_LDB(B0, 1, 0); PG8_LDB(B1, 1, 1); PG8_SCHED; PG8_LDA(At, 1, 0); PG8_STAGE(PG8_SA(0, 1), a2 + hstep, voffA);
            PG8_WAIT_V(8); PG8_WAIT_L(0); PG8_BAR; PG8_MMA(0, 0, At, B0); PG8_MMA(0, 1, At, B1); PG8_BAR; PG8_SCHED;
            PG8_LDA(At, 1, 1); PG8_STAGE(PG8_SB(1, 0), b3, voffB); PG8_STAGE(PG8_SB(1, 1), b3 + hstep, voffB); PG8_STAGE(PG8_SA(1, 0), a3, voffA);
            PG8_WAIT_V(8); PG8_WAIT_L(0); PG8_BAR; PG8_MMA(1, 0, At, B0); PG8_MMA(1, 1, At, B1); PG8_BAR; PG8_SCHED;
            } else {
            PG8_LDB(B0, 0, 0); PG8_SCHED; PG8_LDA(At, 0, 0); PG8_STAGE(PG8_SA(1, 1), a1 + hstep, voffA);
            PG8_WAIT_L(8); PG8_BAR; PG8_WAIT_L(0); PG8_MMA(0, 0, At, B0); PG8_BAR; PG8_SCHED;
            PG8_LDB(B1, 0, 1); PG8_STAGE(PG8_SB(0, 0), b2, voffB);
            PG8_BAR; PG8_WAIT_L(0); PG8_MMA(0, 1, At, B1); PG8_BAR;
            PG8_LDA(At, 0, 1); PG8_STAGE(PG8_SA(0, 0), a2, voffA);
            PG8_BAR; PG8_WAIT_L(0); PG8_MMA(1, 0, At, B0); PG8_BAR; PG8_SCHED;
            PG8_STAGE(PG8_SB(0, 1), b2 + hstep, voffB);
            PG8_WAIT_V(6); PG8_BAR; PG8_MMA(1, 1, At, B1); PG8_BAR;
            PG8_LDB(B0, 1, 0); PG8_SCHED; PG8_LDA(At, 1, 0); PG8_STAGE(PG8_SA(0, 1), a2 + hstep, voffA);
            PG8_WAIT_L(8); PG8_BAR; PG8_WAIT_L(0); PG8_MMA(0, 0, At, B0); PG8_BAR; PG8_SCHED;
            PG8_LDB(B1, 1, 1); PG8_STAGE(PG8_SB(1, 0), b3, voffB);
            PG8_BAR; PG8_WAIT_L(0); PG8_MMA(0, 1, At, B1); PG8_BAR;
            PG8_LDA(At, 1, 1); PG8_STAGE(PG8_SA(1, 0), a3, voffA);
            PG8_BAR; PG8_WAIT_L(0); PG8_MMA(1, 0, At, B0); PG8_BAR; PG8_SCHED;
            PG8_STAGE(PG8_SB(1, 1), b3 + hstep, voffB);
            PG8_WAIT_V(6); PG8_BAR; PG8_MMA(1, 1, At, B1); PG8_BAR;
            }
        }
        if constexpr (ALIGN_EPI) { if (wr == 0) PG8_BAR; }
        if constexpr (!Epi::AFTER_DRAIN) { E(acc, cur, wr, wc, fr, fq); S.done(cur); }
        if (!has_next) break;
#pragma unroll
        for (int a = 0; a < 2; ++a)
#pragma unroll
            for (int b = 0; b < 2; ++b)
#pragma unroll
                for (int m = 0; m < 4; ++m)
#pragma unroll
                    for (int n = 0; n < 2; ++n) acc[a][b][m][n] = (f32x4){0.f, 0.f, 0.f, 0.f};
        cur = nxt; cA = nA; cB = nB; ++ui;
        if constexpr (ALIGN_EPI) { if (wr == 1) PG8_BAR; }
    }
    PG8_WAIT_V(0);
    if constexpr (!ALIGN_EPI) { if (wr == 0) PG8_BAR; }
    PG8_BAR;
    if constexpr (Epi::AFTER_DRAIN) { E.fused(acc, cur, wr, wc, fr, fq, lds, wid, lane); S.done(cur); }
#undef PG8_SA
#undef PG8_SB
#undef PG8_STAGE
#undef PG8_LDA
#undef PG8_LDB
#undef PG8_MMA
#undef PG8_WAIT_V
#undef PG8_WAIT_L
#undef PG8_BAR
#undef PG8_SCHED
}
}

typedef unsigned short bf16_t;
constexpr int NB = 16, SEQ = 2048, DM = 1024, MTOK = NB * SEQ, DEPTH = 4, DIN = 2964, DINP = 3072, DFF = 4096;
constexpr int ZC_MQ = 0, ZC_MK = 256, ZC_MV = 512, ZC_LQ = 768, ZC_LK = 1024, ZC_LV = 1280, ZC_LO = 1792, ZC_LI = 2304, ZC_LF = 2308,
              ZC_NQ = 2312, ZC_KC = 2568, ZC_VC = 2632, ZC_KSL = 2696, ZC_VSL = 2760, ZC_KWN = 2824, ZC_VWN = 2888, ZC_NG = 2952;
constexpr float EPS = 1e-6f;
constexpr size_t MiB = 1u << 20;
constexpr size_t WS_CTL = 0, WS_WIN = 1 * MiB, WS_WOUT = 7 * MiB, WS_W1 = 9 * MiB, WS_W2 = 17 * MiB;
constexpr size_t WS_KMEAN = 28 * MiB, WS_KCMP = 28 * MiB + 256 * 1024, WS_VCMP = 28 * MiB + 768 * 1024 + 0;
constexpr size_t WS_GATES = 30 * MiB;
constexpr size_t WS_HN = 448 * MiB;
constexpr size_t WS_T2 = 32 * MiB;
constexpr size_t WS_QKC = 96 * MiB;
constexpr size_t WS_CC = 128 * MiB, WS_CPREV = 160 * MiB;
constexpr size_t WS_BIG = 192 * MiB;
constexpr size_t WS_Z = WS_BIG, WS_Y = WS_BIG + 192 * MiB, WS_H = WS_BIG, WS_T = WS_BIG;
constexpr size_t WS_HID = 128 * MiB;
constexpr size_t WS_END = 512 * MiB;

__device__ __forceinline__ float bf2f(bf16_t v) { return __uint_as_float(((unsigned)v) << 16); }
__device__ __forceinline__ bf16_t f2bf(float f) { unsigned u = __float_as_uint(f); u += 0x7fffu + ((u >> 16) & 1u); return (bf16_t)(u >> 16); }
__device__ __forceinline__ float wave_sum(float v) {
#pragma unroll
    for (int o = 1; o < 64; o <<= 1) v += __shfl_xor(v, o);
    return v;
}
__device__ __forceinline__ float wave_max(float v) {
#pragma unroll
    for (int o = 1; o < 64; o <<= 1) v = fmaxf(v, __shfl_xor(v, o));
    return v;
}

__global__ void __launch_bounds__(256) k_wconv(const float* __restrict__ src, bf16_t* __restrict__ dst, int K, int N, int Npad) {
    __shared__ float tile[64][65];
    const int ntn = Npad / 64, tk = blockIdx.x / ntn, tn = blockIdx.x % ntn, k0 = tk * 64, n0 = tn * 64, tid = threadIdx.x;
    for (int i = 0; i < 16; ++i) { const int kk = i * 4 + (tid >> 6), nn = tid & 63; const int n = n0 + nn;
        tile[kk][nn] = (n < N) ? src[(size_t)(k0 + kk) * N + n] : 0.f; }
    __syncthreads();
    const int nn = tid >> 2, ks = (tid & 3) * 16;
    unsigned w[8];
#pragma unroll
    for (int j = 0; j < 8; ++j) w[j] = (unsigned)f2bf(tile[ks + 2 * j][nn]) | ((unsigned)f2bf(tile[ks + 2 * j + 1][nn]) << 16);
    uint4* o = (uint4*)(dst + (size_t)(n0 + nn) * K + k0 + ks);
    o[0] = make_uint4(w[0], w[1], w[2], w[3]); o[1] = make_uint4(w[4], w[5], w[6], w[7]);
}

__global__ void __launch_bounds__(256) k_resid_norm(const float* __restrict__ xsrc, const float* __restrict__ T, float* xdst, const float* __restrict__ ga, const float* __restrict__ gb, bf16_t* HN) {
    const int row = blockIdx.x * 4 + (threadIdx.x >> 6), lane = threadIdx.x & 63;
    const float4* xr = (const float4*)(xsrc + (size_t)row * DM) + lane;
    float4 v[4];
#pragma unroll
    for (int j = 0; j < 4; ++j) v[j] = xr[64 * j];
    if (T) {
        const float4* tr = (const float4*)(T + (size_t)row * DM) + lane; float4 t[4]; float ss = 0.f;
#pragma unroll
        for (int j = 0; j < 4; ++j) { t[j] = tr[64 * j]; ss += t[j].x * t[j].x + t[j].y * t[j].y + t[j].z * t[j].z + t[j].w * t[j].w; }
        const float r = rsqrtf(wave_sum(ss) * (1.f / DM) + EPS);
#pragma unroll
        for (int j = 0; j < 4; ++j) { const float4 g = ((const float4*)ga)[lane + 64 * j];
            v[j].x += t[j].x * r * g.x; v[j].y += t[j].y * r * g.y; v[j].z += t[j].z * r * g.z; v[j].w += t[j].w * r * g.w; }
    }
    if (xdst) { float4* xo = (float4*)(xdst + (size_t)row * DM) + lane;
#pragma unroll
        for (int j = 0; j < 4; ++j) xo[64 * j] = v[j]; }
    if (HN) {
        float ss = 0.f;
#pragma unroll
        for (int j = 0; j < 4; ++j) ss += v[j].x * v[j].x + v[j].y * v[j].y + v[j].z * v[j].z + v[j].w * v[j].w;
        const float r = rsqrtf(wave_sum(ss) * (1.f / DM) + EPS);
        uint2* o = (uint2*)(HN + (size_t)row * DM) + lane;
#pragma unroll
        for (int j = 0; j < 4; ++j) { const float4 g = ((const float4*)gb)[lane + 64 * j];
            uint2 w; w.x = (unsigned)f2bf(v[j].x * r * g.x) | ((unsigned)f2bf(v[j].y * r * g.y) << 16); w.y = (unsigned)f2bf(v[j].z * r * g.z) | ((unsigned)f2bf(v[j].w * r * g.w) << 16);
            o[64 * j] = w; }
    }
}

template <class Epi> __global__ void __launch_bounds__(512, 2) k_gemm(pg8::Gemm g, Epi E) {
    extern __shared__ __attribute__((aligned(16))) unsigned char shm[];
    pg8::StaticOrder S; S.init(g.M, g.N, (int)gridDim.x, (int)blockIdx.x);
    pg8::gemm_phase<Epi, pg8::StaticOrder, true, true>((PG8_LAS unsigned char*)shm, g, S, E);
}

__global__ void __launch_bounds__(64) k_moba_kmean(const bf16_t* __restrict__ Z, float* __restrict__ kmean) {
    const int bh = blockIdx.x >> 3, n = blockIdx.x & 7, b = bh >> 2, h = bh & 3, d = threadIdx.x;
    const bf16_t* p = Z + ((size_t)b * SEQ + n * 256) * DINP + ZC_MK + h * 64 + d; float s = 0.f;
    for (int i = 0; i < 256; ++i) s += bf2f(p[(size_t)i * DINP]);
    kmean[(size_t)blockIdx.x * 64 + d] = s * (1.f / 256.f);
}
__global__ void __launch_bounds__(64) k_moba_naive(const bf16_t* __restrict__ Z, const float* __restrict__ kmean, const float* __restrict__ hg, bf16_t* __restrict__ Y) {
    __shared__ float qs[64]; __shared__ float sc[1024]; __shared__ float gate[8]; __shared__ int blks[4]; __shared__ int nblk_s;
    const int idx = blockIdx.x, h = idx & 3, m = idx >> 2, b = m / SEQ, t = m % SEQ, cur = t >> 8, lane = threadIdx.x;
    qs[lane] = bf2f(Z[(size_t)m * DINP + ZC_MQ + h * 64 + lane]);
    __syncthreads();
    for (int n = 0; n < cur; ++n) { const float g = wave_sum(qs[lane] * kmean[((size_t)(b * 4 + h) * 8 + n) * 64 + lane]); if (lane == 0) gate[n] = g; }
    __syncthreads();
    if (lane == 0) {
        int nb = 0;
        if (cur <= 3) { for (int n = 0; n < cur; ++n) blks[nb++] = n; }
        else { unsigned used = 0; for (int k = 0; k < 3; ++k) { int best = -1; float bv = -INFINITY; for (int n = 0; n < cur; ++n) if (!((used >> n) & 1u) && gate[n] > bv) { bv = gate[n]; best = n; }
                if (best < 0) { for (int n = 0; n < cur; ++n) if (!((used >> n) & 1u)) { best = n; break; } }
                used |= 1u << best; blks[nb++] = best; } }
        nblk_s = nb;
    }
    __syncthreads();
    const int nb = nblk_s, nown = t - cur * 256 + 1, total = nb * 256 + nown;
    const bf16_t* Kb = Z + (size_t)b * SEQ * DINP + ZC_MK + h * 64; const bf16_t* Vb = Z + (size_t)b * SEQ * DINP + ZC_MV + h * 64;
    float mx = -INFINITY;
    for (int kk = lane; kk < total; kk += 64) { const int bi = kk >> 8, blk = bi < nb ? blks[bi] : cur, key = blk * 256 + (kk & 255);
        const uint4* kr = (const uint4*)(Kb + (size_t)key * DINP); float s = 0.f;
#pragma unroll
        for (int c = 0; c < 8; ++c) { const uint4 w = kr[c]; const unsigned ww[4] = {w.x, w.y, w.z, w.w};
#pragma unroll
            for (int j = 0; j < 4; ++j) { s += qs[c * 8 + 2 * j] * __uint_as_float(ww[j] << 16) + qs[c * 8 + 2 * j + 1] * __uint_as_float(ww[j] & 0xffff0000u); } }
        s *= 0.125f; sc[kk] = s; mx = fmaxf(mx, s); }
    mx = wave_max(mx);
    float sum = 0.f;
    for (int kk = lane; kk < total; kk += 64) { const float p = __expf(sc[kk] - mx); sc[kk] = p; sum += p; }
    sum = wave_sum(sum);
    __syncthreads();
    float acc = 0.f;
    for (int kk = 0; kk < total; ++kk) { const int bi = kk >> 8, blk = bi < nb ? blks[bi] : cur, key = blk * 256 + (kk & 255); acc += sc[kk] * bf2f(Vb[(size_t)key * DINP + lane]); }
    const float o = acc / sum;
    const float ss = wave_sum(o * o);
    Y[(size_t)m * DM + h * 64 + lane] = f2bf(o * rsqrtf(ss * (1.f / 64.f) + EPS) * hg[h * 64 + lane]);
}

__device__ __forceinline__ float gelu_tanh(float x) { const float u = 0.7978845608028654f * (x + 0.044715f * x * x * x); return 0.5f * x * (1.f + tanhf(u)); }
__global__ void __launch_bounds__(256) k_cmp_naive(const bf16_t* __restrict__ Z, const float* __restrict__ pe, const float* __restrict__ w1, const float* __restrict__ w2, float* __restrict__ kcmp, float* __restrict__ vcmp) {
    __shared__ float blk[4][2048]; __shared__ float hid[4][256];
    const int g4 = blockIdx.x & 31, kv = (blockIdx.x >> 5) & 1, b = blockIdx.x >> 6, tid = threadIdx.x;
    const int col = kv ? ZC_VC : ZC_KC; const float* pej = pe + (size_t)kv * 2048; const float* w1j = w1 + (size_t)kv * 2048 * 256; const float* w2j = w2 + (size_t)kv * 256 * 64;
    for (int i = tid; i < 4 * 2048; i += 256) { const int g = i >> 11, e = i & 2047, l = e >> 6, d = e & 63, n = g4 * 4 + g; const int t = 16 * n + l;
        blk[g][e] = (n < 127) ? bf2f(Z[((size_t)b * SEQ + t) * DINP + col + d]) + pej[e] : 0.f; }
    __syncthreads();
    float a0 = 0.f, a1 = 0.f, a2 = 0.f, a3 = 0.f;
    for (int i = 0; i < 2048; ++i) { const float w = w1j[(size_t)i * 256 + tid]; a0 += blk[0][i] * w; a1 += blk[1][i] * w; a2 += blk[2][i] * w; a3 += blk[3][i] * w; }
    hid[0][tid] = gelu_tanh(a0); hid[1][tid] = gelu_tanh(a1); hid[2][tid] = gelu_tanh(a2); hid[3][tid] = gelu_tanh(a3);
    __syncthreads();
    const int g = tid >> 6, d = tid & 63, n = g4 * 4 + g; float o = 0.f;
    for (int j = 0; j < 256; ++j) o += hid[g][j] * w2j[j * 64 + d];
    float* dst = kv ? vcmp : kcmp; dst[((size_t)b * 128 + n) * 64 + d] = (n < 127) ? o : 0.f;
}
__global__ void __launch_bounds__(256) k_nsa_naive(const bf16_t* __restrict__ Z, const float* __restrict__ kcmp, const float* __restrict__ vcmp, const float* __restrict__ hg, bf16_t* __restrict__ Y) {
    __shared__ float qs[4][64]; __shared__ float pc[4][128]; __shared__ float Psum[128]; __shared__ float pslc[32]; __shared__ unsigned selmask; __shared__ float sc[4][512];
    const int m = blockIdx.x, b = m / SEQ, t = m % SEQ, cur = t >> 6, tid = threadIdx.x, h = tid >> 6, lane = tid & 63;
    const bf16_t* zr = Z + (size_t)m * DINP;
    qs[h][lane] = bf2f(zr[ZC_NQ + h * 64 + lane]);
    pc[h][lane] = 0.f; pc[h][lane + 64] = 0.f;
    __syncthreads();
    const int nvis = t >= 31 ? (t - 31) / 16 + 1 : 0;
    const float* kc = kcmp + (size_t)b * 128 * 64; const float* vc = vcmp + (size_t)b * 128 * 64;
    float o_cmp = 0.f;
    if (nvis > 0) {
        float s0 = -INFINITY, s1 = -INFINITY;
        if (lane < nvis) { float s = 0.f; for (int d = 0; d < 64; ++d) s += qs[h][d] * kc[lane * 64 + d]; s0 = s * 0.125f; }
        if (lane + 64 < nvis) { float s = 0.f; for (int d = 0; d < 64; ++d) s += qs[h][d] * kc[(lane + 64) * 64 + d]; s1 = s * 0.125f; }
        const float mx = wave_max(fmaxf(s0, s1));
        const float p0 = lane < nvis ? __expf(s0 - mx) : 0.f, p1 = lane + 64 < nvis ? __expf(s1 - mx) : 0.f;
        const float sum = wave_sum(p0 + p1);
        pc[h][lane] = p0 / sum; pc[h][lane + 64] = p1 / sum;
    }
    __syncthreads();
    if (nvis > 0) { for (int n = 0; n < nvis; ++n) o_cmp += pc[h][n] * vc[n * 64 + lane]; }
    if (tid < 128) Psum[tid] = pc[0][tid] + pc[1][tid] + pc[2][tid] + pc[3][tid];
    __syncthreads();
    if (tid < 32) { const int j = tid; float s = 0.f;
        if (4 * j - 1 >= 0) s += 0.5f * Psum[4 * j - 1];
        s += Psum[4 * j]; s += Psum[4 * j + 1]; s += Psum[4 * j + 2];
        if (4 * j + 3 <= 126) s += 0.5f * Psum[4 * j + 3];
        pslc[j] = s; }
    __syncthreads();
    if (tid == 0) {
        unsigned mask;
        if (cur <= 7) mask = (2u << cur) - 1u;
        else { mask = 1u | (1u << cur) | (1u << (cur - 1));
            for (int k = 0; k < 5; ++k) { int best = -1; float bv = -INFINITY; for (int j = 1; j <= cur - 2; ++j) if (!((mask >> j) & 1u) && pslc[j] > bv) { bv = pslc[j]; best = j; }
                if (best < 0) { for (int j = 1; j <= cur - 2; ++j) if (!((mask >> j) & 1u)) { best = j; break; } }
                mask |= 1u << best; } }
        selmask = mask;
    }
    __syncthreads();
    const unsigned mask = selmask;
    const bf16_t* Zb = Z + (size_t)b * SEQ * DINP;
    float o_sel, o_win;
    {
        int cnt = 0; float mx = -INFINITY;
        for (int j = 0; j <= cur; ++j) if ((mask >> j) & 1u) { const int key = j * 64 + lane; float s = -INFINITY;
            if (key <= t) { const bf16_t* kr = Zb + (size_t)key * DINP + ZC_KSL; float a = 0.f; for (int d = 0; d < 64; ++d) a += qs[h][d] * bf2f(kr[d]); s = a * 0.125f; }
            sc[h][cnt * 64 + lane] = s; mx = fmaxf(mx, s); ++cnt; }
        mx = wave_max(mx); float sum = 0.f;
        for (int i = 0; i < cnt; ++i) { const float s = sc[h][i * 64 + lane]; const float p = (s == -INFINITY) ? 0.f : __expf(s - mx); sc[h][i * 64 + lane] = p; sum += p; }
        sum = wave_sum(sum);
        __syncthreads();
        float acc = 0.f; int i = 0;
        for (int j = 0; j <= cur; ++j) if ((mask >> j) & 1u) { for (int k = 0; k < 64; ++k) acc += sc[h][i * 64 + k] * bf2f(Zb[(size_t)(j * 64 + k) * DINP + ZC_VSL + lane]); ++i; }
        o_sel = acc / sum;
        __syncthreads();
    }
    {
        float mx = -INFINITY;
        for (int i = 0; i < 8; ++i) { const int key = t - 511 + i * 64 + lane; float s = -INFINITY;
            if (key >= 0) { const bf16_t* kr = Zb + (size_t)key * DINP + ZC_KWN; float a = 0.f; for (int d = 0; d < 64; ++d) a += qs[h][d] * bf2f(kr[d]); s = a * 0.125f; }
            sc[h][i * 64 + lane] = s; mx = fmaxf(mx, s); }
        mx = wave_max(mx); float sum = 0.f;
        for (int i = 0; i < 8; ++i) { const float s = sc[h][i * 64 + lane]; const float p = (s == -INFINITY) ? 0.f : __expf(s - mx); sc[h][i * 64 + lane] = p; sum += p; }
        sum = wave_sum(sum);
        __syncthreads();
        float acc = 0.f;
        for (int kk = 0; kk < 512; ++kk) { const int key = t - 511 + kk; if (key >= 0) acc += sc[h][kk] * bf2f(Zb[(size_t)key * DINP + ZC_VWN + lane]); }
        o_win = acc / sum;
    }
    const float g0 = 1.f / (1.f + __expf(-bf2f(zr[ZC_NG + h * 3 + 0]))), g1 = 1.f / (1.f + __expf(-bf2f(zr[ZC_NG + h * 3 + 1]))), g2 = 1.f / (1.f + __expf(-bf2f(zr[ZC_NG + h * 3 + 2])));
    const float o = g0 * o_cmp + g1 * o_sel + g2 * o_win;
    const float ss = wave_sum(o * o);
    Y[(size_t)m * DM + 768 + h * 64 + lane] = f2bf(o * rsqrtf(ss * (1.f / 64.f) + EPS) * hg[768 + h * 64 + lane]);
}

__global__ void __launch_bounds__(256) k_ml_conv(const bf16_t* __restrict__ Z, const float* __restrict__ cw, const float* __restrict__ cb, const float* __restrict__ gb, bf16_t* __restrict__ QKC, float* __restrict__ gates) {
    const int m = blockIdx.x, t = m % SEQ, tid = threadIdx.x;
    for (int c = tid; c < 512; c += 256) { float a = cb[c];
#pragma unroll
        for (int j = 0; j < 4; ++j) { const int tt = t - 3 + j; if (tt >= 0) a += bf2f(Z[(size_t)(m - 3 + j) * DINP + ZC_LQ + c]) * cw[j * 512 + c]; }
        float y = a / (1.f + __expf(-a)); if (c >= 256) y *= 0.125f;
        QKC[(size_t)m * 512 + c] = f2bf(y); }
    if (tid < 4) gates[(size_t)m * 8 + tid] = bf2f(Z[(size_t)m * DINP + ZC_LI + tid]) + gb[tid];
    else if (tid < 8) { const float x = bf2f(Z[(size_t)m * DINP + ZC_LF + (tid - 4)]) + gb[tid];
        gates[(size_t)m * 8 + tid] = fminf(x, 0.f) - log1pf(__expf(-fabsf(x))); }
}
__global__ void __launch_bounds__(512) k_ml_naive(const bf16_t* __restrict__ Z, const bf16_t* __restrict__ QKC, const float* __restrict__ gates, float* __restrict__ HID) {
    const int b = blockIdx.x >> 2, h = blockIdx.x & 3, tid = threadIdx.x, v = tid >> 2, kq = (tid & 3) * 16;
    float C[16], nn[16];
#pragma unroll
    for (int j = 0; j < 16; ++j) { C[j] = 0.f; nn[j] = 0.f; }
    for (int t = 0; t < SEQ; ++t) { const size_t m = (size_t)b * SEQ + t;
        const float ig = gates[m * 8 + h], lf = gates[m * 8 + 4 + h]; const float f = __expf(lf), iv = __expf(ig) * bf2f(Z[m * DINP + ZC_LV + h * 128 + v]), ii = __expf(ig);
        const uint4* qp = (const uint4*)(QKC + m * 512 + h * 64 + kq); const uint4* kp = (const uint4*)(QKC + m * 512 + 256 + h * 64 + kq);
        const uint4 q0 = qp[0], q1 = qp[1], k0 = kp[0], k1 = kp[1];
        const unsigned qw[8] = {q0.x, q0.y, q0.z, q0.w, q1.x, q1.y, q1.z, q1.w}, kw[8] = {k0.x, k0.y, k0.z, k0.w, k1.x, k1.y, k1.z, k1.w};
        float num = 0.f, den = 0.f;
#pragma unroll
        for (int j = 0; j < 8; ++j) { const float ka = __uint_as_float(kw[j] << 16), kb = __uint_as_float(kw[j] & 0xffff0000u), qa = __uint_as_float(qw[j] << 16), qb = __uint_as_float(qw[j] & 0xffff0000u);
            C[2 * j] = f * C[2 * j] + iv * ka; C[2 * j + 1] = f * C[2 * j + 1] + iv * kb; nn[2 * j] = f * nn[2 * j] + ii * ka; nn[2 * j + 1] = f * nn[2 * j + 1] + ii * kb;
            num += C[2 * j] * qa + C[2 * j + 1] * qb; den += nn[2 * j] * qa + nn[2 * j + 1] * qb; }
        num += __shfl_xor(num, 1); num += __shfl_xor(num, 2); den += __shfl_xor(den, 1); den += __shfl_xor(den, 2);
        if ((tid & 3) == 0) HID[m * 512 + h * 128 + v] = num / fmaxf(fabsf(den), 1.f);
    }
}
__global__ void __launch_bounds__(512) k_ml_post(const bf16_t* __restrict__ Z, const float* __restrict__ HID, const float* __restrict__ hg, bf16_t* __restrict__ Y) {
    __shared__ float part[8];
    const int m = blockIdx.x, tid = threadIdx.x, w = tid >> 6;
    const float x = HID[(size_t)m * 512 + tid]; const float s = wave_sum(x * x);
    if ((tid & 63) == 0) part[w] = s;
    __syncthreads();
    const float ss = part[(w & ~1)] + part[(w | 1)];
    const float lo = bf2f(Z[(size_t)m * DINP + ZC_LO + tid]);
    Y[(size_t)m * DM + 256 + tid] = f2bf(x * rsqrtf(ss * (1.f / 128.f) + EPS) * hg[256 + tid] / (1.f + __expf(-lo)));
}

extern "C" void kernel_launch(void* const* d_in, const int* in_sizes, int n_in, void* d_out, int out_size, void* d_ws, size_t ws_size, hipStream_t stream) {
    static int ok = 0;
    if (ok == 0) {
        if (n_in != 13 || in_sizes[0] != MTOK * DM || out_size != MTOK * DM || ws_size < WS_END) { fprintf(stderr, "kernel_launch: unexpected shapes / workspace (%zu)\n", ws_size); ok = -1; return; }
        if (hipFuncSetAttribute((const void*)k_gemm<pg8::EpiBf16<0>>, hipFuncAttributeMaxDynamicSharedMemorySize, pg8::STAGE_BYTES) != hipSuccess ||
            hipFuncSetAttribute((const void*)k_gemm<pg8::EpiBf16<1>>, hipFuncAttributeMaxDynamicSharedMemorySize, pg8::STAGE_BYTES) != hipSuccess ||
            hipFuncSetAttribute((const void*)k_gemm<pg8::EpiF32>, hipFuncAttributeMaxDynamicSharedMemorySize, pg8::STAGE_BYTES) != hipSuccess) { fprintf(stderr, "hipFuncSetAttribute failed\n"); ok = -1; return; }
        ok = 1;
    }
    if (ok < 0) return;
    const float* x_in = (const float*)d_in[0]; const float* norm_g = (const float*)d_in[1]; const float* w_in = (const float*)d_in[2]; const float* conv_w = (const float*)d_in[3];
    const float* conv_b = (const float*)d_in[4]; const float* gate_b = (const float*)d_in[5]; const float* cmp_pe = (const float*)d_in[6]; const float* cmp_w1 = (const float*)d_in[7];
    const float* cmp_w2 = (const float*)d_in[8]; const float* head_g = (const float*)d_in[9]; const float* w_out = (const float*)d_in[10]; const float* w1 = (const float*)d_in[11]; const float* w2 = (const float*)d_in[12];
    float* xo = (float*)d_out; unsigned char* ws = (unsigned char*)d_ws;
    bf16_t* Win_t = (bf16_t*)(ws + WS_WIN); bf16_t* Wout_t = (bf16_t*)(ws + WS_WOUT); bf16_t* W1_t = (bf16_t*)(ws + WS_W1); bf16_t* W2_t = (bf16_t*)(ws + WS_W2);
    bf16_t* HN = (bf16_t*)(ws + WS_HN); bf16_t* Z = (bf16_t*)(ws + WS_Z); bf16_t* Y = (bf16_t*)(ws + WS_Y); bf16_t* H = (bf16_t*)(ws + WS_H); float* T = (float*)(ws + WS_T);
    float* kmean = (float*)(ws + WS_KMEAN); float* kcmp = (float*)(ws + WS_KCMP); float* vcmp = (float*)(ws + WS_VCMP); float* gates = (float*)(ws + WS_GATES);
    bf16_t* QKC = (bf16_t*)(ws + WS_QKC); float* HID = (float*)(ws + WS_HID); float* T2 = (float*)(ws + WS_T2);
    const int G = 256;
    for (int L = 0; L < DEPTH; ++L) {
        const float* ng = norm_g + (size_t)L * 4 * DM; const float* hg = head_g + (size_t)L * DM;
        hipLaunchKernelGGL(k_wconv, dim3((DM / 64) * (DINP / 64)), dim3(256), 0, stream, w_in + (size_t)L * DM * DIN, Win_t, DM, DIN, DINP);
        hipLaunchKernelGGL(k_wconv, dim3((DM / 64) * (DM / 64)), dim3(256), 0, stream, w_out + (size_t)L * DM * DM, Wout_t, DM, DM, DM);
        hipLaunchKernelGGL(k_wconv, dim3((DM / 64) * (DFF / 64)), dim3(256), 0, stream, w1 + (size_t)L * DM * DFF, W1_t, DM, DFF, DFF);
        hipLaunchKernelGGL(k_wconv, dim3((DFF / 64) * (DM / 64)), dim3(256), 0, stream, w2 + (size_t)L * DFF * DM, W2_t, DFF, DM, DM);
        if (L == 0) hipLaunchKernelGGL(k_resid_norm, dim3(MTOK / 4), dim3(256), 0, stream, x_in, (const float*)nullptr, (float*)nullptr, (const float*)nullptr, ng, HN);
        { pg8::Gemm g{HN, Win_t, MTOK, DINP, DM, 0}; pg8::EpiBf16<0> E{Z, DINP, 0}; hipLaunchKernelGGL(k_gemm<pg8::EpiBf16<0>>, dim3(G), dim3(512), pg8::STAGE_BYTES, stream, g, E); }
        hipLaunchKernelGGL(k_moba_kmean, dim3(64 * 8), dim3(64), 0, stream, Z, kmean);
        hipLaunchKernelGGL(k_moba_naive, dim3(MTOK * 4), dim3(64), 0, stream, Z, kmean, hg, Y);
        hipLaunchKernelGGL(k_cmp_naive, dim3(16 * 2 * 32), dim3(256), 0, stream, Z, cmp_pe + (size_t)L * 2 * 2048, cmp_w1 + (size_t)L * 2 * 2048 * 256, cmp_w2 + (size_t)L * 2 * 256 * 64, kcmp, vcmp);
        hipLaunchKernelGGL(k_nsa_naive, dim3(MTOK), dim3(256), 0, stream, Z, kcmp, vcmp, hg, Y);
        hipLaunchKernelGGL(k_ml_conv, dim3(MTOK), dim3(256), 0, stream, Z, conv_w + (size_t)L * 4 * 512, conv_b + (size_t)L * 512, gate_b + (size_t)L * 8, QKC, gates);
        hipLaunchKernelGGL(k_ml_naive, dim3(64), dim3(512), 0, stream, Z, QKC, gates, HID);
        hipLaunchKernelGGL(k_ml_post, dim3(MTOK), dim3(512), 0, stream, Z, HID, hg, Y);
        { pg8::Gemm g{Y, Wout_t, MTOK, DM, DM, 0}; pg8::EpiF32 E{T, nullptr, DM, 0}; hipLaunchKernelGGL(k_gemm<pg8::EpiF32>, dim3(G), dim3(512), pg8::STAGE_BYTES, stream, g, E); }
        hipLaunchKernelGGL(k_resid_norm, dim3(MTOK / 4), dim3(256), 0, stream, L == 0 ? x_in : (const float*)xo, (const float*)T, xo, ng + DM, ng + 2 * DM, HN);
        { pg8::Gemm g{HN, W1_t, MTOK, DFF, DM, 0}; pg8::EpiBf16<1> E{H, DFF, 0}; hipLaunchKernelGGL(k_gemm<pg8::EpiBf16<1>>, dim3(G), dim3(512), pg8::STAGE_BYTES, stream, g, E); }
        { pg8::Gemm g{H, W2_t, MTOK, DM, DFF, 0}; pg8::EpiF32 E{T2, nullptr, DM, 0}; hipLaunchKernelGGL(k_gemm<pg8::EpiF32>, dim3(G), dim3(512), pg8::STAGE_BYTES, stream, g, E); }
        hipLaunchKernelGGL(k_resid_norm, dim3(MTOK / 4), dim3(256), 0, stream, (const float*)xo, (const float*)T2, xo, ng + 3 * DM, L + 1 < DEPTH ? norm_g + (size_t)(L + 1) * 4 * DM : (const float*)nullptr, L + 1 < DEPTH ? HN : (bf16_t*)nullptr);
    }
}
```

```cpp
#include <hip/hip_runtime.h>
#include <cstdio>
#include <cstdint>
namespace pg8 {
#define PG8_LAS __attribute__((address_space(3)))
typedef unsigned short bf16_t;
typedef short bf16x8 __attribute__((ext_vector_type(8)));
typedef float f32x4 __attribute__((ext_vector_type(4)));
typedef unsigned u32x4 __attribute__((ext_vector_type(4)));
constexpr int BM = 256, BK = 64, HALF = 128, HTB = HALF * BK * 2  , STAGE_BYTES = 8 * HTB, NXCD = 8, WGM = 8;

__host__ __device__ __forceinline__ int lds_byte(int r, int c) { const int st = (r >> 4) * 2 + (c >> 5), rr = r & 15, cc = c & 31, ob = rr * 64 + cc * 2; return st * 1024 + (ob ^ (((ob >> 9) & 1) << 5)); }
__host__ __device__ __forceinline__ void stage_rc(int b, int& R, int& C) { const int st = b / 1024, sb = b % 1024, swz = sb ^ (((sb >> 9) & 1) << 5); R = (st >> 1) * 16 + swz / 64; C = (st & 1) * 32 + (swz % 64) / 2; }
__host__ __device__ __forceinline__ int perm32(int rho) { const int n = rho >> 4, i = rho & 15; return 8 * (i >> 2) + 4 * n + (i & 3); }

struct Unit { int pm, pn; };
struct Gemm { const bf16_t* A; const bf16_t* Bt; int M, N, K, pad; };

struct StaticOrder {
    int nM, nN, nwg, G, c;
    __host__ __device__ void init(int M, int N, int G_, int c_) { nM = M / BM; nN = N / BM; nwg = nM * nN; G = G_; c = c_; }
    __host__ __device__ bool next(int i, Unit& u) const {
        const long L = (long)i * G + c; if (L >= nwg) return false;
        int wgid = (int)L; { const int q = nwg / NXCD, r = nwg % NXCD, xcd = wgid % NXCD, off = wgid / NXCD; wgid = (xcd < r ? xcd * (q + 1) : r * (q + 1) + (xcd - r) * q) + off; }
        const int nig = WGM * nN, gid = wgid / nig, fm = gid * WGM, gsz = (nM - fm) < WGM ? (nM - fm) : WGM;
        u.pm = fm + ((wgid % nig) % gsz); u.pn = (wgid % nig) / gsz; return true;
    }
    __device__ __forceinline__ void a_ready(const Unit&) const {}
    __device__ __forceinline__ void done(const Unit&) const {}
};

__device__ __forceinline__ unsigned cvt_pk_bf16(float lo, float hi) { unsigned r; asm volatile("v_cvt_pk_bf16_f32 %0, %1, %2" : "=v"(r) : "v"(lo), "v"(hi)); return r; }
typedef float f32x2 __attribute__((ext_vector_type(2)));
struct EpiF32 {
    static constexpr bool PERM = false, AFTER_DRAIN = false;
    float* C; const float* bias; int ldc, pad;
    __device__ __forceinline__ void operator()(const f32x4 (&acc)[2][2][4][2], const Unit& u, int wr, int wc, int fr, int fq) const {
        const int row0 = u.pm * BM + wr * 64 + fr, col0 = u.pn * BM + wc * 32 + 4 * fq;
        f32x4 bv[2][2];
#pragma unroll
        for (int bj = 0; bj < 2; ++bj)
#pragma unroll
            for (int n = 0; n < 2; ++n) bv[bj][n] = bias ? *(const f32x4*)(bias + col0 + bj * HALF + n * 16) : (f32x4){0.f, 0.f, 0.f, 0.f};
#pragma unroll
        for (int ai = 0; ai < 2; ++ai)
#pragma unroll
            for (int m = 0; m < 4; ++m) { float* rowp = C + (size_t)(row0 + ai * HALF + m * 16) * ldc + col0;
#pragma unroll
                for (int bj = 0; bj < 2; ++bj)
#pragma unroll
                    for (int n = 0; n < 2; ++n) *(f32x4*)(rowp + bj * HALF + n * 16) = acc[ai][bj][m][n] + bv[bj][n]; }
    }
};
template <int ACT> struct EpiBf16 {
    static constexpr bool PERM = true, AFTER_DRAIN = false;
    bf16_t* O; int ldc, pad;
    __device__ __forceinline__ void operator()(const f32x4 (&acc)[2][2][4][2], const Unit& u, int wr, int wc, int fr, int fq) const {
        const int row0 = u.pm * BM + wr * 64 + fr; const int col0 = u.pn * BM + wc * 32 + 8 * fq;
#pragma unroll
        for (int ai = 0; ai < 2; ++ai)
#pragma unroll
            for (int m = 0; m < 4; ++m) { bf16_t* rowp = O + (size_t)(row0 + ai * HALF + m * 16) * ldc + col0;
#pragma unroll
                for (int bj = 0; bj < 2; ++bj) { f32x4 v0 = acc[ai][bj][m][0], v1 = acc[ai][bj][m][1];
                    if (ACT == 1) {
#pragma unroll
                        for (int j = 0; j < 4; ++j) { const float a = fmaxf(v0[j], 0.f), b = fmaxf(v1[j], 0.f); v0[j] = a * a; v1[j] = b * b; } }
                    u32x4 w; w.x = cvt_pk_bf16(v0[0], v0[1]); w.y = cvt_pk_bf16(v0[2], v0[3]); w.z = cvt_pk_bf16(v1[0], v1[1]); w.w = cvt_pk_bf16(v1[2], v1[3]);
                    *(u32x4*)(rowp + bj * HALF) = w; } }
    }
};
template <class Epi, class Sched, bool ALIGN_EPI = false, bool SP2 = false>
__device__ __forceinline__ void gemm_phase(PG8_LAS unsigned char* lds, const Gemm g, const Sched& S, const Epi& E) {
    int tid_ = threadIdx.x; asm volatile("" : "+v"(tid_));
    const int tid = tid_, wid = __builtin_amdgcn_readfirstlane(tid >> 6), lane = tid & 63, wr = wid >> 2, wc = wid & 3, fr = lane & 15, fq = lane >> 4;
    const int K = g.K, nt = K / BK;
    unsigned voffA[2], voffB[2];
#pragma unroll
    for (int i = 0; i < 2; ++i) { int R, C; stage_rc(tid * 16 + i * 8192, R, C); const int Rb = Epi::PERM ? ((R & ~31) + perm32(R & 31)) : R;
        voffA[i] = (unsigned)(R * K + C) * 2u; voffB[i] = (unsigned)(Rb * K + C) * 2u; }
    const size_t kstep = (size_t)(BK * 2);
    const size_t hstep = (size_t)HALF * K * 2;
    const size_t tstep = 2 * hstep;
    const unsigned ldsw = (unsigned)wid * 1024u;
    const int aoff = lds_byte(wr * 64 + fr, fq * 8), boff = lds_byte(wc * 32 + fr, fq * 8);
#define PG8_SA(b, h) (((b) * 2 + (h)) * HTB)
#define PG8_SB(b, h) ((4 + (b) * 2 + (h)) * HTB)
#define PG8_STAGE(bufoff, gbase, voff) do { _Pragma("unroll") for (int _i = 0; _i < 2; ++_i) \
        __builtin_amdgcn_global_load_lds((const unsigned*)((const char*)(gbase) + (voff)[_i]), (PG8_LAS unsigned*)(lds + (bufoff) + ldsw + _i * 8192), 16, 0, 0); } while (0)
#define PG8_LDA(dst, b, h) do { _Pragma("unroll") for (int m = 0; m < 4; ++m) _Pragma("unroll") for (int k = 0; k < 2; ++k) dst[m][k] = *(const PG8_LAS bf16x8*)(lds + PG8_SA(b, h) + aoff + m * 2048 + k * 1024); } while (0)
#define PG8_LDB(dst, b, h) do { _Pragma("unroll") for (int n = 0; n < 2; ++n) _Pragma("unroll") for (int k = 0; k < 2; ++k) dst[n][k] = *(const PG8_LAS bf16x8*)(lds + PG8_SB(b, h) + boff + n * 2048 + k * 1024); } while (0)
#define PG8_MMA(ai, bj, At, Bt) do { __builtin_amdgcn_s_setprio(1); _Pragma("unroll") for (int m = 0; m < 4; ++m) _Pragma("unroll") for (int n = 0; n < 2; ++n) _Pragma("unroll") for (int k = 0; k < 2; ++k) \
        acc[ai][bj][m][n] = __builtin_amdgcn_mfma_f32_16x16x32_bf16(Bt[n][k], At[m][k], acc[ai][bj][m][n], 0, 0, 0); __builtin_amdgcn_s_setprio(0); } while (0)
#define PG8_WAIT_V(n) asm volatile("s_waitcnt vmcnt(" #n ")" ::: "memory")
#define PG8_WAIT_L(n) asm volatile("s_waitcnt lgkmcnt(" #n ")" ::: "memory")
#define PG8_BAR __builtin_amdgcn_s_barrier()
#define PG8_SCHED __builtin_amdgcn_sched_barrier(0)
    Unit cur, nxt; int ui = 0;
    if (!S.next(0, cur)) return;
    f32x4 acc[2][2][4][2];
#pragma unroll
    for (int a = 0; a < 2; ++a)
#pragma unroll
        for (int b = 0; b < 2; ++b)
#pragma unroll
            for (int m = 0; m < 4; ++m)
#pragma unroll
                for (int n = 0; n < 2; ++n) acc[a][b][m][n] = (f32x4){0.f, 0.f, 0.f, 0.f};
    bf16x8 At[4][2], B0[2][2], B1[2][2];
    const char* cA = (const char*)g.A + (size_t)cur.pm * tstep; const char* cB = (const char*)g.Bt + (size_t)cur.pn * tstep;
    S.a_ready(cur);
    if constexpr (SP2) {
        PG8_STAGE(PG8_SB(0, 0), cB, voffB); PG8_STAGE(PG8_SB(0, 1), cB + hstep, voffB); PG8_STAGE(PG8_SA(0, 0), cA, voffA); PG8_STAGE(PG8_SA(0, 1), cA + hstep, voffA);
        if (wr == 1) PG8_BAR;
        PG8_WAIT_V(2); PG8_BAR;
        PG8_STAGE(PG8_SB(1, 0), cB + kstep, voffB); PG8_STAGE(PG8_SA(1, 0), cA + kstep, voffA); PG8_STAGE(PG8_SB(1, 1), cB + hstep + kstep, voffB);
        PG8_WAIT_V(6); PG8_BAR;
    } else {
        PG8_STAGE(PG8_SB(0, 0), cB, voffB); PG8_STAGE(PG8_SA(0, 0), cA, voffA); PG8_STAGE(PG8_SB(0, 1), cB + hstep, voffB); PG8_STAGE(PG8_SA(0, 1), cA + hstep, voffA);
        if (wr == 1) PG8_BAR;
        PG8_WAIT_V(4); PG8_BAR;
        PG8_STAGE(PG8_SB(1, 0), cB + kstep, voffB); PG8_STAGE(PG8_SA(1, 0), cA + kstep, voffA); PG8_STAGE(PG8_SB(1, 1), cB + hstep + kstep, voffB);
        PG8_WAIT_V(6); PG8_BAR;
    }
    for (;;) {
        const bool has_next = S.next(ui + 1, nxt);
        const char* nA = has_next ? (const char*)g.A + (size_t)nxt.pm * tstep : cA; const char* nB = has_next ? (const char*)g.Bt + (size_t)nxt.pn * tstep : cB;
        for (int t = 0; t < nt; t += 2) {
            const bool last = (t == nt - 2);
            const char* a1 = cA + (size_t)(t + 1) * kstep;
            const char* a2 = last ? nA : cA + (size_t)(t + 2) * kstep; const char* b2 = last ? nB : cB + (size_t)(t + 2) * kstep;
            const char* a3 = a2 + kstep; const char* b3 = b2 + kstep;
            if (last && has_next) S.a_ready(nxt);
            if constexpr (SP2) {
            PG8_LDB(B0, 0, 0); PG8_LDB(B1, 0, 1); PG8_SCHED; PG8_LDA(At, 0, 0); PG8_STAGE(PG8_SA(1, 1), a1 + hstep, voffA);
            PG8_WAIT_V(8); PG8_WAIT_L(0); PG8_BAR; PG8_MMA(0, 0, At, B0); PG8_MMA(0, 1, At, B1); PG8_BAR; PG8_SCHED;
            PG8_LDA(At, 0, 1); PG8_STAGE(PG8_SB(0, 0), b2, voffB); PG8_STAGE(PG8_SB(0, 1), b2 + hstep, voffB); PG8_STAGE(PG8_SA(0, 0), a2, voffA);
            PG8_WAIT_V(8); PG8_WAIT_L(0); PG8_BAR; PG8_MMA(1, 0, At, B0); PG8_MMA(1, 1, At, B1); PG8_BAR; PG8_SCHED;
            PG8_LDB(B0, 1, 0); PG8_LDB(B1, 1, 1); PG8_SCHED; PG8_LDA(At, 1, 0); PG8_STAGE(PG8_SA(0, 1), a2 + hstep, voffA);
            PG8_WAIT_V(8); PG8_WAIT_L(0); PG8_BAR; PG8_MMA(0, 0, At, B0); PG8_MMA(0, 1, At, B1); PG8_BAR; PG8_SCHED;
            PG8_LDA(At, 1, 1); PG8_STAGE(PG8_SB(1, 0), b3, voffB); PG8_STAGE(PG8_SB(1, 1), b3 + hstep, voffB); PG8_STAGE(PG8_SA(1, 0), a3, voffA);
            PG8_WAIT_V(8); PG8_WAIT_L(0); PG8_BAR; PG8_MMA(1, 0, At, B0); PG8_MMA(1, 1, At, B1); PG8_BAR; PG8_SCHED;
            } else {
            PG8_LDB(B0, 0, 0); PG8_SCHED; PG8_LDA(At, 0, 0); PG8_STAGE(PG8_SA(1, 1), a1 + hstep, voffA);
            PG8_WAIT_L(8); PG8_BAR; PG8_WAIT_L(0); PG8_MMA(0, 0, At, B0); PG8_BAR; PG8_SCHED;
            PG8_LDB(B1, 0, 1); PG8_STAGE(PG8_SB(0, 0), b2, voffB);
            PG8_BAR; PG8_WAIT_L(0); PG8_MMA(0, 1, At, B1); PG8_BAR;
            PG8_LDA(At, 0, 1); PG8_STAGE(PG8_SA(0, 0), a2, voffA);
            PG8_BAR; PG8_WAIT_L(0); PG8_MMA(1, 0, At, B0); PG8_BAR; PG8_SCHED;
            PG8_STAGE(PG8_SB(0, 1), b2 + hstep, voffB);
            PG8_WAIT_V(6); PG8_BAR; PG8_MMA(1, 1, At, B1); PG8_BAR;
            PG8_LDB(B0, 1, 0); PG8_SCHED; PG8_LDA(At, 1, 0); PG8_STAGE(PG8_SA(0, 1), a2 + hstep, voffA);
            PG8_WAIT_L(8); PG8_BAR; PG8_WAIT_L(0); PG8_MMA(0, 0, At, B0); PG8_BAR; PG8_SCHED;
            PG8_LDB(B1, 1, 1); PG8_STAGE(PG8_SB(1, 0), b3, voffB);
            PG8_BAR; PG8_WAIT_L(0); PG8_MMA(0, 1, At, B1); PG8_BAR;
            PG8_LDA(At, 1, 1); PG8_STAGE(PG8_SA(1, 0), a3, voffA);
            PG8_BAR; PG8_WAIT_L(0); PG8_MMA(1, 0, At, B0); PG8_BAR; PG8_SCHED;
            PG8_STAGE(PG8_SB(1, 1), b3 + hstep, voffB);
            PG8_WAIT_V(6); PG8_BAR; PG8_MMA(1, 1, At, B1); PG8_BAR;
            }
        }
        if constexpr (ALIGN_EPI) { if (wr == 0) PG8_BAR; }
        if constexpr (!Epi::AFTER_DRAIN) { E(acc, cur, wr, wc, fr, fq); S.done(cur); }
        if (!has_next) break;
#pragma unroll
        for (int a = 0; a < 2; ++a)
#pragma unroll
            for (int b = 0; b < 2; ++b)
#pragma unroll
                for (int m = 0; m < 4; ++m)
#pragma unroll
                    for (int n = 0; n < 2; ++n) acc[a][b][m][n] = (f32x4){0.f, 0.f, 0.f, 0.f};
        cur = nxt; cA = nA; cB = nB; ++ui;
        if constexpr (ALIGN_EPI) { if (wr == 1) PG8_BAR; }
    }
    PG8_WAIT_V(0);
    if constexpr (!ALIGN_EPI) { if (wr == 0) PG8_BAR; }
    PG8_BAR;
    if constexpr (Epi::AFTER_DRAIN) { E.fused(acc, cur, wr, wc, fr, fq, lds, wid, lane); S.done(cur); }
#undef PG8_SA
#undef PG8_SB
#undef PG8_STAGE
#undef PG8_LDA
#undef PG8_LDB
#undef PG8_MMA
#undef PG8_WAIT_V
#undef PG8_WAIT_L
#undef PG8_BAR
#undef PG8_SCHED
}
}
#define GAS __attribute__((address_space(1)))
#define LAS __attribute__((address_space(3)))

typedef unsigned v4u __attribute__((ext_vector_type(4)));


typedef GAS unsigned gu32;
typedef GAS unsigned long long gu64;
#define RLX_AGENT __ATOMIC_RELAXED, __HIP_MEMORY_SCOPE_AGENT
#define LDS_WAIT() asm volatile("s_waitcnt lgkmcnt(0)" ::: "memory")
#define VM_WAIT() asm volatile("s_waitcnt vmcnt(0)" ::: "memory")
#define XB_TMO      128
#define XB_XCNT(j)  (256  + 64 * (j))
#define XB_XSUB(j)  (1280 + 64 * (j))
#define XB_XGEN(j)  (2304 + 64 * (j))
#define XB_TOP      3328
#define XB_TOPGEN   3392
#define XCD_BAR_WORDS 3456
#define XB_SPIN_CAP (1u << 18)

__device__ __forceinline__ unsigned xb_ld(unsigned* p)              { return __hip_atomic_load(p, __ATOMIC_RELAXED, __HIP_MEMORY_SCOPE_AGENT); }
__device__ __forceinline__ unsigned xb_add(unsigned* p, unsigned v) { return __hip_atomic_fetch_add(p, v, __ATOMIC_RELAXED, __HIP_MEMORY_SCOPE_AGENT); }
__device__ __forceinline__ unsigned xb_xcc_id() { return (unsigned)__builtin_amdgcn_s_getreg((3 << 11) | 20) & 0xFu; }
#define XB_SPIN(cond, bar) do { unsigned _sp = 0; while (cond) { __builtin_amdgcn_s_sleep(1); \
    if ((++_sp & 255u) == 0u) { if (xb_ld(&(bar)[XB_TMO])) break; if (_sp > XB_SPIN_CAP) { atomicAdd(&(bar)[XB_TMO], 1u); break; } } } } while (0)

struct XcdBarrier {
    unsigned* bar; unsigned x;
    volatile LAS unsigned* st;
};

__device__ __forceinline__ XcdBarrier xcd_barrier_post(unsigned* bar, volatile LAS unsigned* st) {
    XcdBarrier b; b.bar = bar; b.x = xb_xcc_id(); b.st = st;
    if (threadIdx.x == 0) (void)xb_add(&bar[XB_XCNT(b.x)], 1u);
    return b;
}
__device__ __forceinline__ void xcd_barrier_complete(unsigned* bar, unsigned x, unsigned& nloc, unsigned& nx) {
    const unsigned G = gridDim.x * gridDim.y * gridDim.z;
    unsigned sum, cnt, mine, sp = 0u;
    for (;;) {
        sum = 0u; cnt = 0u; mine = 0u;
#pragma unroll
        for (unsigned j = 0; j < 16; ++j) { const unsigned c = xb_ld(&bar[XB_XCNT(j)]); sum += c; cnt += (c > 0u) ? 1u : 0u; mine = (j == x) ? c : mine; }
        if (sum == G) break;
        __builtin_amdgcn_s_sleep(1);
        if ((++sp & 255u) == 0u) { if (xb_ld(&bar[XB_TMO])) break; if (sp > XB_SPIN_CAP) { atomicAdd(&bar[XB_TMO], 1u); break; } }
    }
    nloc = mine > 0u ? mine : 1u; nx = cnt > 0u ? cnt : 1u;
}

__device__ __forceinline__ void xcd_barrier(const XcdBarrier& b) {
    asm volatile("s_waitcnt vmcnt(0)" ::: "memory");
    __syncthreads();
    if (threadIdx.x == 0) {
        unsigned* bar = b.bar;
        __builtin_amdgcn_s_waitcnt(0);
        unsigned nloc = b.st[0], nx = b.st[1];
        if (nloc == 0u) { xcd_barrier_complete(bar, b.x, nloc, nx); b.st[0] = nloc; b.st[1] = nx; }
        const unsigned old = xb_add(&bar[XB_XSUB(b.x)], 1u);
        const unsigned gen = old / nloc;
        if (old + 1u == (gen + 1u) * nloc) {
            __builtin_amdgcn_fence(__ATOMIC_RELEASE, "agent");
            asm volatile("s_waitcnt vmcnt(0)" ::: "memory");
            const unsigned og = xb_add(&bar[XB_TOP], 1u);
            const unsigned tg = og / nx;
            if (og + 1u == (tg + 1u) * nx) xb_add(&bar[XB_TOPGEN], 1u);
            else XB_SPIN(xb_ld(&bar[XB_TOPGEN]) == tg, bar);
            __builtin_amdgcn_fence(__ATOMIC_ACQUIRE, "agent");
            xb_add(&bar[XB_XGEN(b.x)], 1u);
            asm volatile("s_waitcnt vmcnt(0)" ::: "memory");
        } else {
            XB_SPIN(xb_ld(&bar[XB_XGEN(b.x)]) == gen, bar);
            __builtin_amdgcn_fence(__ATOMIC_ACQUIRE, "agent");
            asm volatile("s_waitcnt vmcnt(0)" ::: "memory");
        }
    }
    __syncthreads();
}

typedef unsigned short bf16_t;
constexpr int NB = 16, SEQ = 2048, DM = 1024, MTOK = NB * SEQ, DEPTH = 4, DIN = 2964, DINP = 3072, DFF = 4096;
constexpr int ZC_MQ = 0, ZC_MK = 256, ZC_MV = 512, ZC_LQ = 768, ZC_LK = 1024, ZC_LV = 1280, ZC_LO = 1792, ZC_LI = 2304, ZC_LF = 2308,
              ZC_NQ = 2312, ZC_KC = 2568, ZC_VC = 2632, ZC_KSL = 2696, ZC_VSL = 2760, ZC_KWN = 2824, ZC_VWN = 2888, ZC_NG = 2952;
constexpr float EPS = 1e-6f;
constexpr size_t MiB = 1u << 20;
constexpr size_t WS_CTL = 0, CTL_ZERO_BYTES = 1 * MiB;
constexpr size_t WS_WIN = 1 * MiB, WS_WOUT = 7 * MiB, WS_W1 = 9 * MiB, WS_W2 = 17 * MiB;
constexpr size_t WS_CW1 = 25 * MiB;
constexpr size_t WS_CW2 = 27 * MiB;
constexpr size_t WS_CPE = 27 * MiB + 65536;
constexpr size_t WS_KMEAN = 28 * MiB, WS_KCMP = 28 * MiB + 256 * 1024, WS_VCMP = 28 * MiB + 768 * 1024;
constexpr size_t WS_GATES = 30 * MiB;
constexpr size_t WS_T2 = 32 * MiB;
constexpr size_t WS_QKC = 96 * MiB;
constexpr size_t WS_CC = 128 * MiB, WS_CPREV = 160 * MiB;
constexpr size_t WS_HID = 128 * MiB;
constexpr size_t WS_BIG = 192 * MiB;
constexpr size_t WS_Z = WS_BIG, WS_Y = WS_BIG + 192 * MiB, WS_H = WS_BIG, WS_T = WS_BIG;
constexpr size_t WS_HN = 448 * MiB;
constexpr size_t WS_END = 512 * MiB;
constexpr int CW_BAR = 4096;

__device__ __forceinline__ float bf2f(bf16_t v) { return __uint_as_float(((unsigned)v) << 16); }
__device__ __forceinline__ bf16_t f2bf(float f) { unsigned u = __float_as_uint(f); u += 0x7fffu + ((u >> 16) & 1u); return (bf16_t)(u >> 16); }
__device__ __forceinline__ unsigned pk2bf(float lo, float hi) { return (unsigned)f2bf(lo) | ((unsigned)f2bf(hi) << 16); }
__device__ __forceinline__ float wave_sum(float v) {
#pragma unroll
    for (int o = 1; o < 64; o <<= 1) v += __shfl_xor(v, o);
    return v;
}
__device__ __forceinline__ float wave_max(float v) {
#pragma unroll
    for (int o = 1; o < 64; o <<= 1) v = fmaxf(v, __shfl_xor(v, o));
    return v;
}
__device__ __forceinline__ float sigmoidf_(float x) { return 1.f / (1.f + __expf(-x)); }
__device__ __forceinline__ float gelu_tanh(float x) { const float u = 0.7978845608028654f * (x + 0.044715f * x * x * x); return 0.5f * x * (1.f + tanhf(u)); }

struct Ctx {
    const float *x_in, *norm_g, *w_in, *conv_w, *conv_b, *gate_b, *cmp_pe, *cmp_w1, *cmp_w2, *head_g, *w_out, *w1, *w2;
    float* xo; unsigned char* ws; unsigned char* lds;
    int tid, lane, wave, bid, nb;
};

__device__ __forceinline__ void wconv_tile(const float* __restrict__ src, bf16_t* __restrict__ dst, int K, int N, int Npad, int it, int t256, float* tile  , bool active) {
    const int ntn = Npad / 64, tk = it / ntn, tn = it % ntn, k0 = tk * 64, n0 = tn * 64;
    if (active) {
#pragma unroll 4
        for (int i = 0; i < 16; ++i) { const int kk = i * 4 + (t256 >> 6), nn = t256 & 63; const int n = n0 + nn;
            tile[kk * 65 + nn] = (n < N) ? src[(size_t)(k0 + kk) * N + n] : 0.f; }
    }
    __syncthreads();
    if (active) {
        const int nn = t256 >> 2, ks = (t256 & 3) * 16;
        unsigned w[8];
#pragma unroll
        for (int j = 0; j < 8; ++j) w[j] = pk2bf(tile[(ks + 2 * j) * 65 + nn], tile[(ks + 2 * j + 1) * 65 + nn]);
        uint4* o = (uint4*)(dst + (size_t)(n0 + nn) * K + k0 + ks);
        o[0] = make_uint4(w[0], w[1], w[2], w[3]); o[1] = make_uint4(w[4], w[5], w[6], w[7]);
    }
    __syncthreads();
}
__device__ __forceinline__ void ph_wconv(const Ctx& c_, int L) {
    Ctx c = c_; asm volatile("" : "+v"(c.tid)); c.lane = c.tid & 63; asm volatile("" : "+s"(c.bid));
    const int half = c.tid >> 8, t256 = c.tid & 255; float* tile = (float*)(c.lds) + half * (64 * 65);
    constexpr int T_IN = (DM / 64) * (DINP / 64), T_OUT = (DM / 64) * (DM / 64), T_1 = (DM / 64) * (DFF / 64), T_2 = (DFF / 64) * (DM / 64), TOT = T_IN + T_OUT + T_1 + T_2;
    for (int base = c.bid * 2; base < TOT; base += c.nb * 2) {
        int it = base + half; const bool act = it < TOT;
        if (!act) it = 0;
        const float* src; bf16_t* dst; int K, N, Np;
        if (it < T_IN) { src = c.w_in + (size_t)L * DM * DIN; dst = (bf16_t*)(c.ws + WS_WIN); K = DM; N = DIN; Np = DINP; }
        else if ((it -= T_IN) < T_OUT) { src = c.w_out + (size_t)L * DM * DM; dst = (bf16_t*)(c.ws + WS_WOUT); K = DM; N = DM; Np = DM; }
        else if ((it -= T_OUT) < T_1) { src = c.w1 + (size_t)L * DM * DFF; dst = (bf16_t*)(c.ws + WS_W1); K = DM; N = DFF; Np = DFF; }
        else { it -= T_1; src = c.w2 + (size_t)L * DFF * DM; dst = (bf16_t*)(c.ws + WS_W2); K = DFF; N = DM; Np = DM; }
        wconv_tile(src, dst, K, N, Np, it, t256, tile, act);
    }
}

__device__ __forceinline__ void ph_resid_norm(const Ctx& c_, const float* __restrict__ xsrc, const float* __restrict__ T, float* xdst, const float* __restrict__ ga, const float* __restrict__ gb, bf16_t* HN) {
    Ctx c = c_; asm volatile("" : "+v"(c.tid)); c.lane = c.tid & 63; asm volatile("" : "+s"(c.bid));
    const int lane = c.lane;
    for (int row = c.bid * 8 + c.wave; row < MTOK; row += c.nb * 8) {
        const float4* xr = (const float4*)(xsrc + (size_t)row * DM) + lane;
        float4 v[4];
#pragma unroll
        for (int j = 0; j < 4; ++j) v[j] = xr[64 * j];
        if (T) {
            const float4* tr = (const float4*)(T + (size_t)row * DM) + lane; float4 t[4]; float ss = 0.f;
#pragma unroll
            for (int j = 0; j < 4; ++j) { t[j] = tr[64 * j]; ss += t[j].x * t[j].x + t[j].y * t[j].y + t[j].z * t[j].z + t[j].w * t[j].w; }
            const float r = rsqrtf(wave_sum(ss) * (1.f / DM) + EPS);
#pragma unroll
            for (int j = 0; j < 4; ++j) { const float4 g = ((const float4*)ga)[lane + 64 * j];
                v[j].x += t[j].x * r * g.x; v[j].y += t[j].y * r * g.y; v[j].z += t[j].z * r * g.z; v[j].w += t[j].w * r * g.w; }
        }
        if (xdst) { float4* xo = (float4*)(xdst + (size_t)row * DM) + lane;
#pragma unroll
            for (int j = 0; j < 4; ++j) xo[64 * j] = v[j]; }
        if (HN) {
            float ss = 0.f;
#pragma unroll
            for (int j = 0; j < 4; ++j) ss += v[j].x * v[j].x + v[j].y * v[j].y + v[j].z * v[j].z + v[j].w * v[j].w;
            const float r = rsqrtf(wave_sum(ss) * (1.f / DM) + EPS);
            uint2* o = (uint2*)(HN + (size_t)row * DM) + lane;
#pragma unroll
            for (int j = 0; j < 4; ++j) { const float4 g = ((const float4*)gb)[lane + 64 * j];
                uint2 w; w.x = pk2bf(v[j].x * r * g.x, v[j].y * r * g.y); w.y = pk2bf(v[j].z * r * g.z, v[j].w * r * g.w);
                o[64 * j] = w; }
        }
    }
}

__device__ __forceinline__ void wsync() { asm volatile("s_waitcnt lgkmcnt(0)" ::: "memory"); }

__device__ __forceinline__ void nv_kmean(const Ctx& c_) {
    Ctx c = c_; asm volatile("" : "+v"(c.tid)); c.lane = c.tid & 63; asm volatile("" : "+s"(c.bid));
    const bf16_t* Z = (const bf16_t*)(c.ws + WS_Z); float* kmean = (float*)(c.ws + WS_KMEAN);
    for (int it = c.bid * 8 + c.wave; it < 512; it += c.nb * 8) {
        const int bh = it >> 3, n = it & 7, b = bh >> 2, h = bh & 3, d = c.lane;
        const bf16_t* p = Z + ((size_t)b * SEQ + n * 256) * DINP + ZC_MK + h * 64 + d; float s = 0.f;
        for (int i = 0; i < 256; ++i) s += bf2f(p[(size_t)i * DINP]);
        kmean[(size_t)it * 64 + d] = s * (1.f / 256.f);
    }
}
__device__ __forceinline__ void nv_moba(const Ctx& c_, int L) {
    Ctx c = c_; asm volatile("" : "+v"(c.tid)); c.lane = c.tid & 63; asm volatile("" : "+s"(c.bid));
    const bf16_t* Z = (const bf16_t*)(c.ws + WS_Z); const float* kmean = (const float*)(c.ws + WS_KMEAN); bf16_t* Y = (bf16_t*)(c.ws + WS_Y); const float* hg = c.head_g + (size_t)L * DM;
    float* base = (float*)(c.lds + c.wave * 4608); float* qs = base; float* sc = base + 64; float* gate = base + 64 + 1024; int* blks = (int*)(base + 64 + 1024 + 8); int* nblk_s = blks + 4;
    const int lane = c.lane;
    for (int idx = c.bid * 8 + c.wave; idx < MTOK * 4; idx += c.nb * 8) {
        const int h = idx & 3, m = idx >> 2, b = m / SEQ, t = m % SEQ, cur = t >> 8;
        wsync();
        qs[lane] = bf2f(Z[(size_t)m * DINP + ZC_MQ + h * 64 + lane]);
        wsync();
        for (int n = 0; n < cur; ++n) { const float g = wave_sum(qs[lane] * kmean[((size_t)(b * 4 + h) * 8 + n) * 64 + lane]); if (lane == 0) gate[n] = g; }
        wsync();
        if (lane == 0) {
            int nb = 0;
            if (cur <= 3) { for (int n = 0; n < cur; ++n) blks[nb++] = n; }
            else { unsigned used = 0; for (int k = 0; k < 3; ++k) { int best = -1; float bv = -INFINITY; for (int n = 0; n < cur; ++n) if (!((used >> n) & 1u) && gate[n] > bv) { bv = gate[n]; best = n; }
                    if (best < 0) { for (int n = 0; n < cur; ++n) if (!((used >> n) & 1u)) { best = n; break; } }
                    used |= 1u << best; blks[nb++] = best; } }
            *nblk_s = nb;
        }
        wsync();
        const int nb = *nblk_s, nown = t - cur * 256 + 1, total = nb * 256 + nown;
        const bf16_t* Kb = Z + (size_t)b * SEQ * DINP + ZC_MK + h * 64; const bf16_t* Vb = Z + (size_t)b * SEQ * DINP + ZC_MV + h * 64;
        float mx = -INFINITY;
        for (int kk = lane; kk < total; kk += 64) { const int bi = kk >> 8, blk = bi < nb ? blks[bi] : cur, key = blk * 256 + (kk & 255);
            const uint4* kr = (const uint4*)(Kb + (size_t)key * DINP); float s = 0.f;
#pragma unroll
            for (int cc = 0; cc < 8; ++cc) { const uint4 w = kr[cc]; const unsigned ww[4] = {w.x, w.y, w.z, w.w};
#pragma unroll
                for (int j = 0; j < 4; ++j) { s += qs[cc * 8 + 2 * j] * __uint_as_float(ww[j] << 16) + qs[cc * 8 + 2 * j + 1] * __uint_as_float(ww[j] & 0xffff0000u); } }
            s *= 0.125f; sc[kk] = s; mx = fmaxf(mx, s); }
        mx = wave_max(mx);
        float sum = 0.f;
        for (int kk = lane; kk < total; kk += 64) { const float p = __expf(sc[kk] - mx); sc[kk] = p; sum += p; }
        sum = wave_sum(sum);
        wsync();
        float acc = 0.f;
        for (int kk = 0; kk < total; ++kk) { const int bi = kk >> 8, blk = bi < nb ? blks[bi] : cur, key = blk * 256 + (kk & 255); acc += sc[kk] * bf2f(Vb[(size_t)key * DINP + lane]); }
        const float o = acc / sum;
        const float ss = wave_sum(o * o);
        Y[(size_t)m * DM + h * 64 + lane] = f2bf(o * rsqrtf(ss * (1.f / 64.f) + EPS) * hg[h * 64 + lane]);
    }
}

__device__ __forceinline__ void nv_cmp(const Ctx& c_, int L) {
    Ctx c = c_; asm volatile("" : "+v"(c.tid)); c.lane = c.tid & 63; asm volatile("" : "+s"(c.bid));
    const bf16_t* Z = (const bf16_t*)(c.ws + WS_Z); float* kcmp = (float*)(c.ws + WS_KCMP); float* vcmp = (float*)(c.ws + WS_VCMP);
    const int half = c.tid >> 8, tid = c.tid & 255;
    float* blk = (float*)(c.lds + half * 36864); float* hid = blk + 4 * 2048;
    for (int base = c.bid * 2; base < 1024; base += c.nb * 2) {
        const int item = base + half; const int g4 = item & 31, kv = (item >> 5) & 1, b = item >> 6;
        const int col = kv ? ZC_VC : ZC_KC; const float* pej = c.cmp_pe + ((size_t)L * 2 + kv) * 2048; const float* w1j = c.cmp_w1 + ((size_t)L * 2 + kv) * 2048 * 256; const float* w2j = c.cmp_w2 + ((size_t)L * 2 + kv) * 256 * 64;
        for (int i = tid; i < 4 * 2048; i += 256) { const int g = i >> 11, e = i & 2047, l = e >> 6, d = e & 63, n = g4 * 4 + g; const int t = 16 * n + l;
            blk[g * 2048 + e] = (n < 127) ? bf2f(Z[((size_t)b * SEQ + t) * DINP + col + d]) + pej[e] : 0.f; }
        __syncthreads();
        float a0 = 0.f, a1 = 0.f, a2 = 0.f, a3 = 0.f;
        for (int i = 0; i < 2048; ++i) { const float w = w1j[(size_t)i * 256 + tid]; a0 += blk[i] * w; a1 += blk[2048 + i] * w; a2 += blk[4096 + i] * w; a3 += blk[6144 + i] * w; }
        hid[tid] = gelu_tanh(a0); hid[256 + tid] = gelu_tanh(a1); hid[512 + tid] = gelu_tanh(a2); hid[768 + tid] = gelu_tanh(a3);
        __syncthreads();
        const int g = tid >> 6, d = tid & 63, n = g4 * 4 + g; float o = 0.f;
        for (int j = 0; j < 256; ++j) o += hid[g * 256 + j] * w2j[j * 64 + d];
        float* dst = kv ? vcmp : kcmp; dst[((size_t)b * 128 + n) * 64 + d] = (n < 127) ? o : 0.f;
        __syncthreads();
    }
}

__device__ __forceinline__ void nv_nsa(const Ctx& c_, int L) {
    Ctx c = c_; asm volatile("" : "+v"(c.tid)); c.lane = c.tid & 63; asm volatile("" : "+s"(c.bid));
    const bf16_t* Z = (const bf16_t*)(c.ws + WS_Z); const float* kcmp = (const float*)(c.ws + WS_KCMP); const float* vcmp = (const float*)(c.ws + WS_VCMP); bf16_t* Y = (bf16_t*)(c.ws + WS_Y); const float* hg = c.head_g + (size_t)L * DM;
    const int half = c.tid >> 8, tid = c.tid & 255, h = tid >> 6, lane = tid & 63;
    float* base = (float*)(c.lds + 40960 + half * 12288);
    float* qs = base;
    float* pc = base + 256;
    float* Psum = base + 768;
    float* pslc = base + 896;
    unsigned* selmask = (unsigned*)(base + 928);
    float* sc = base + 1024;
    for (int m0 = c.bid * 2; m0 < MTOK; m0 += c.nb * 2) {
        const int m = m0 + half, b = m / SEQ, t = m % SEQ, cur = t >> 6;
        const bf16_t* zr = Z + (size_t)m * DINP;
        qs[h * 64 + lane] = bf2f(zr[ZC_NQ + h * 64 + lane]);
        pc[h * 128 + lane] = 0.f; pc[h * 128 + lane + 64] = 0.f;
        __syncthreads();
        const int nvis = t >= 31 ? (t - 31) / 16 + 1 : 0;
        const float* kc = kcmp + (size_t)b * 128 * 64; const float* vc = vcmp + (size_t)b * 128 * 64;
        float o_cmp = 0.f;
        if (nvis > 0) {
            float s0 = -INFINITY, s1 = -INFINITY;
            if (lane < nvis) { float s = 0.f; for (int d = 0; d < 64; ++d) s += qs[h * 64 + d] * kc[lane * 64 + d]; s0 = s * 0.125f; }
            if (lane + 64 < nvis) { float s = 0.f; for (int d = 0; d < 64; ++d) s += qs[h * 64 + d] * kc[(lane + 64) * 64 + d]; s1 = s * 0.125f; }
            const float mx = wave_max(fmaxf(s0, s1));
            const float p0 = lane < nvis ? __expf(s0 - mx) : 0.f, p1 = lane + 64 < nvis ? __expf(s1 - mx) : 0.f;
            const float sum = wave_sum(p0 + p1);
            pc[h * 128 + lane] = p0 / sum; pc[h * 128 + lane + 64] = p1 / sum;
        }
        __syncthreads();
        if (nvis > 0) { for (int n = 0; n < nvis; ++n) o_cmp += pc[h * 128 + n] * vc[n * 64 + lane]; }
        if (tid < 128) Psum[tid] = pc[tid] + pc[128 + tid] + pc[256 + tid] + pc[384 + tid];
        __syncthreads();
        if (tid < 32) { const int j = tid; float s = 0.f;
            if (4 * j - 1 >= 0) s += 0.5f * Psum[4 * j - 1];
            s += Psum[4 * j]; s += Psum[4 * j + 1]; s += Psum[4 * j + 2];
            if (4 * j + 3 <= 126) s += 0.5f * Psum[4 * j + 3];
            pslc[j] = s; }
        __syncthreads();
        if (tid == 0) {
            unsigned mask;
            if (cur <= 7) mask = (2u << cur) - 1u;
            else { mask = 1u | (1u << cur) | (1u << (cur - 1));
                for (int k = 0; k < 5; ++k) { int best = -1; float bv = -INFINITY; for (int j = 1; j <= cur - 2; ++j) if (!((mask >> j) & 1u) && pslc[j] > bv) { bv = pslc[j]; best = j; }
                    if (best < 0) { for (int j = 1; j <= cur - 2; ++j) if (!((mask >> j) & 1u)) { best = j; break; } }
                    mask |= 1u << best; } }
            *selmask = mask;
        }
        __syncthreads();
        const unsigned mask = *selmask;
        const bf16_t* Zb = Z + (size_t)b * SEQ * DINP;
        float o_sel, o_win;
        {
            int cnt = 0; float mx = -INFINITY;
            for (int j = 0; j <= cur; ++j) if ((mask >> j) & 1u) { const int key = j * 64 + lane; float s = -INFINITY;
                if (key <= t) { const bf16_t* kr = Zb + (size_t)key * DINP + ZC_KSL; float a = 0.f; for (int d = 0; d < 64; ++d) a += qs[h * 64 + d] * bf2f(kr[d]); s = a * 0.125f; }
                sc[h * 512 + cnt * 64 + lane] = s; mx = fmaxf(mx, s); ++cnt; }
            mx = wave_max(mx); float sum = 0.f;
            for (int i = 0; i < cnt; ++i) { const float s = sc[h * 512 + i * 64 + lane]; const float p = (s == -INFINITY) ? 0.f : __expf(s - mx); sc[h * 512 + i * 64 + lane] = p; sum += p; }
            sum = wave_sum(sum);
            __syncthreads();
            float acc = 0.f; int i = 0;
            for (int j = 0; j <= cur; ++j) if ((mask >> j) & 1u) { for (int k = 0; k < 64; ++k) acc += sc[h * 512 + i * 64 + k] * bf2f(Zb[(size_t)(j * 64 + k) * DINP + ZC_VSL + lane]); ++i; }
            o_sel = acc / sum;
            __syncthreads();
        }
        {
            float mx = -INFINITY;
            for (int i = 0; i < 8; ++i) { const int key = t - 511 + i * 64 + lane; float s = -INFINITY;
                if (key >= 0) { const bf16_t* kr = Zb + (size_t)key * DINP + ZC_KWN; float a = 0.f; for (int d = 0; d < 64; ++d) a += qs[h * 64 + d] * bf2f(kr[d]); s = a * 0.125f; }
                sc[h * 512 + i * 64 + lane] = s; mx = fmaxf(mx, s); }
            mx = wave_max(mx); float sum = 0.f;
            for (int i = 0; i < 8; ++i) { const float s = sc[h * 512 + i * 64 + lane]; const float p = (s == -INFINITY) ? 0.f : __expf(s - mx); sc[h * 512 + i * 64 + lane] = p; sum += p; }
            sum = wave_sum(sum);
            __syncthreads();
            float acc = 0.f;
            for (int kk = 0; kk < 512; ++kk) { const int key = t - 511 + kk; if (key >= 0) acc += sc[h * 512 + kk] * bf2f(Zb[(size_t)key * DINP + ZC_VWN + lane]); }
            o_win = acc / sum;
        }
        const float g0 = sigmoidf_(bf2f(zr[ZC_NG + h * 3 + 0])), g1 = sigmoidf_(bf2f(zr[ZC_NG + h * 3 + 1])), g2 = sigmoidf_(bf2f(zr[ZC_NG + h * 3 + 2]));
        const float o = g0 * o_cmp + g1 * o_sel + g2 * o_win;
        const float ss = wave_sum(o * o);
        Y[(size_t)m * DM + 768 + h * 64 + lane] = f2bf(o * rsqrtf(ss * (1.f / 64.f) + EPS) * hg[768 + h * 64 + lane]);
        __syncthreads();
    }
}

__device__ __forceinline__ void nv_ml_conv(const Ctx& c_, int L) {
    Ctx c = c_; asm volatile("" : "+v"(c.tid)); c.lane = c.tid & 63; asm volatile("" : "+s"(c.bid));
    const bf16_t* Z = (const bf16_t*)(c.ws + WS_Z); bf16_t* QKC = (bf16_t*)(c.ws + WS_QKC); float* gates = (float*)(c.ws + WS_GATES);
    const float* cw = c.conv_w + (size_t)L * 4 * 512; const float* cb = c.conv_b + (size_t)L * 512; const float* gb = c.gate_b + (size_t)L * 8;
    const int tid = c.tid;
    for (int m = c.bid; m < MTOK; m += c.nb) { const int t = m % SEQ;
        float a = cb[tid];
#pragma unroll
        for (int j = 0; j < 4; ++j) { const int tt = t - 3 + j; if (tt >= 0) a += bf2f(Z[(size_t)(m - 3 + j) * DINP + ZC_LQ + tid]) * cw[j * 512 + tid]; }
        float y = a / (1.f + __expf(-a)); if (tid >= 256) y *= 0.125f;
        QKC[(size_t)m * 512 + tid] = f2bf(y);
        if (tid < 4) gates[(size_t)m * 8 + tid] = bf2f(Z[(size_t)m * DINP + ZC_LI + tid]) + gb[tid];
        else if (tid < 8) { const float x = bf2f(Z[(size_t)m * DINP + ZC_LF + (tid - 4)]) + gb[tid]; gates[(size_t)m * 8 + tid] = fminf(x, 0.f) - log1pf(__expf(-fabsf(x))); }
    }
}
__device__ __forceinline__ void nv_ml(const Ctx& c_) {
    Ctx c = c_; asm volatile("" : "+v"(c.tid)); c.lane = c.tid & 63; asm volatile("" : "+s"(c.bid));
    if (c.bid >= 64) return;
    const bf16_t* Z = (const bf16_t*)(c.ws + WS_Z); const bf16_t* QKC = (const bf16_t*)(c.ws + WS_QKC); const float* gates = (const float*)(c.ws + WS_GATES); float* HID = (float*)(c.ws + WS_HID);
    const int b = c.bid >> 2, h = c.bid & 3, tid = c.tid, v = tid >> 2, kq = (tid & 3) * 16;
    float C[16], nn[16];
#pragma unroll
    for (int j = 0; j < 16; ++j) { C[j] = 0.f; nn[j] = 0.f; }
    for (int t = 0; t < SEQ; ++t) { const size_t m = (size_t)b * SEQ + t;
        const float ig = gates[m * 8 + h], lf = gates[m * 8 + 4 + h]; const float f = __expf(lf), ii = __expf(ig), iv = ii * bf2f(Z[m * DINP + ZC_LV + h * 128 + v]);
        const uint4* qp = (const uint4*)(QKC + m * 512 + h * 64 + kq); const uint4* kp = (const uint4*)(QKC + m * 512 + 256 + h * 64 + kq);
        const uint4 q0 = qp[0], q1 = qp[1], k0 = kp[0], k1 = kp[1];
        const unsigned qw[8] = {q0.x, q0.y, q0.z, q0.w, q1.x, q1.y, q1.z, q1.w}, kw[8] = {k0.x, k0.y, k0.z, k0.w, k1.x, k1.y, k1.z, k1.w};
        float num = 0.f, den = 0.f;
#pragma unroll
        for (int j = 0; j < 8; ++j) { const float ka = __uint_as_float(kw[j] << 16), kb = __uint_as_float(kw[j] & 0xffff0000u), qa = __uint_as_float(qw[j] << 16), qb = __uint_as_float(qw[j] & 0xffff0000u);
            C[2 * j] = f * C[2 * j] + iv * ka; C[2 * j + 1] = f * C[2 * j + 1] + iv * kb; nn[2 * j] = f * nn[2 * j] + ii * ka; nn[2 * j + 1] = f * nn[2 * j + 1] + ii * kb;
            num += C[2 * j] * qa + C[2 * j + 1] * qb; den += nn[2 * j] * qa + nn[2 * j + 1] * qb; }
        num += __shfl_xor(num, 1); num += __shfl_xor(num, 2); den += __shfl_xor(den, 1); den += __shfl_xor(den, 2);
        if ((tid & 3) == 0) HID[m * 512 + h * 128 + v] = num / fmaxf(fabsf(den), 1.f);
    }
}
__device__ __forceinline__ void nv_ml_post(const Ctx& c_, int L) {
    Ctx c = c_; asm volatile("" : "+v"(c.tid)); c.lane = c.tid & 63; asm volatile("" : "+s"(c.bid));
    const bf16_t* Z = (const bf16_t*)(c.ws + WS_Z); const float* HID = (const float*)(c.ws + WS_HID); bf16_t* Y = (bf16_t*)(c.ws + WS_Y); const float* hg = c.head_g + (size_t)L * DM;
    float* part = (float*)(c.lds + 65536); const int tid = c.tid, w = c.wave;
    for (int m = c.bid; m < MTOK; m += c.nb) {
        const float x = HID[(size_t)m * 512 + tid]; const float s = wave_sum(x * x);
        if ((tid & 63) == 0) part[w] = s;
        __syncthreads();
        const float ss = part[(w & ~1)] + part[(w | 1)];
        const float lo = bf2f(Z[(size_t)m * DINP + ZC_LO + tid]);
        Y[(size_t)m * DM + 256 + tid] = f2bf(x * rsqrtf(ss * (1.f / 128.f) + EPS) * hg[256 + tid] * sigmoidf_(lo));
        __syncthreads();
    }
}

constexpr int LDS_BYTES = 147456;
constexpr int LDSCTL_OFF = 131072, MISC_OFF = LDSCTL_OFF + 320;
struct Args { const float* in[13]; float* out; unsigned char* ws; };

__global__ void __launch_bounds__(512, 2) mega_fwd(Args args) {
    extern __shared__ __attribute__((aligned(16))) unsigned char lds[];
    Ctx c;
    c.x_in = args.in[0]; c.norm_g = args.in[1]; c.w_in = args.in[2]; c.conv_w = args.in[3]; c.conv_b = args.in[4]; c.gate_b = args.in[5]; c.cmp_pe = args.in[6];
    c.cmp_w1 = args.in[7]; c.cmp_w2 = args.in[8]; c.head_g = args.in[9]; c.w_out = args.in[10]; c.w1 = args.in[11]; c.w2 = args.in[12];
    c.xo = args.out; c.ws = args.ws; c.lds = lds;
    c.tid = threadIdx.x; c.lane = c.tid & 63; c.wave = __builtin_amdgcn_readfirstlane(c.tid >> 6); c.bid = blockIdx.x; c.nb = gridDim.x;
    for (int u = c.tid; u < (LDS_BYTES - LDSCTL_OFF) / 4; u += 512) ((LAS unsigned*)((LAS unsigned char*)lds + LDSCTL_OFF))[u] = 0u;
    __syncthreads();
    unsigned* ctl = (unsigned*)(c.ws + WS_CTL);
    XcdBarrier bar = xcd_barrier_post(ctl + CW_BAR, (volatile LAS unsigned*)((LAS unsigned char*)lds + MISC_OFF) + 8);
#define GRID_BAR() xcd_barrier(bar)
    bf16_t* Win_t = (bf16_t*)(c.ws + WS_WIN); bf16_t* Wout_t = (bf16_t*)(c.ws + WS_WOUT); bf16_t* W1_t = (bf16_t*)(c.ws + WS_W1); bf16_t* W2_t = (bf16_t*)(c.ws + WS_W2);
    bf16_t* HN = (bf16_t*)(c.ws + WS_HN); bf16_t* Z = (bf16_t*)(c.ws + WS_Z); bf16_t* Y = (bf16_t*)(c.ws + WS_Y); bf16_t* H = (bf16_t*)(c.ws + WS_H); float* T = (float*)(c.ws + WS_T); float* T2 = (float*)(c.ws + WS_T2);

    ph_wconv(c, 0);
    ph_resid_norm(c, c.x_in, nullptr, nullptr, nullptr, c.norm_g, HN);
    GRID_BAR();
    for (int L = 0; L < DEPTH; ++L) {
        const float* ng = c.norm_g + (size_t)L * 4 * DM;
        { pg8::Gemm g{HN, Win_t, MTOK, DINP, DM, 0}; pg8::StaticOrder S; S.init(MTOK, DINP, c.nb, c.bid); pg8::EpiBf16<0> E{Z, DINP, 0};
          pg8::gemm_phase<pg8::EpiBf16<0>, pg8::StaticOrder, true, true>((PG8_LAS unsigned char*)lds, g, S, E); }
        GRID_BAR();
        nv_kmean(c); nv_cmp(c, L); nv_ml_conv(c, L);
        GRID_BAR();
        nv_ml(c); nv_moba(c, L); nv_nsa(c, L);
        GRID_BAR();
        nv_ml_post(c, L);
        GRID_BAR();
        { pg8::Gemm g{Y, Wout_t, MTOK, DM, DM, 0}; pg8::StaticOrder S; S.init(MTOK, DM, c.nb, c.bid); pg8::EpiF32 E{T, nullptr, DM, 0};
          pg8::gemm_phase<pg8::EpiF32, pg8::StaticOrder, true, true>((PG8_LAS unsigned char*)lds, g, S, E); }
        GRID_BAR();
        ph_resid_norm(c, L == 0 ? c.x_in : (const float*)c.xo, T, c.xo, ng + DM, ng + 2 * DM, HN);
        GRID_BAR();
        { pg8::Gemm g{HN, W1_t, MTOK, DFF, DM, 0}; pg8::StaticOrder S; S.init(MTOK, DFF, c.nb, c.bid); pg8::EpiBf16<1> E{H, DFF, 0};
          pg8::gemm_phase<pg8::EpiBf16<1>, pg8::StaticOrder, true, true>((PG8_LAS unsigned char*)lds, g, S, E); }
        GRID_BAR();
        { pg8::Gemm g{H, W2_t, MTOK, DM, DFF, 0}; pg8::StaticOrder S; S.init(MTOK, DM, c.nb, c.bid); pg8::EpiF32 E{T2, nullptr, DM, 0};
          pg8::gemm_phase<pg8::EpiF32, pg8::StaticOrder, true, true>((PG8_LAS unsigned char*)lds, g, S, E); }
        GRID_BAR();
        if (L + 1 < DEPTH) { ph_resid_norm(c, c.xo, T2, c.xo, ng + 3 * DM, c.norm_g + (size_t)(L + 1) * 4 * DM, HN); ph_wconv(c, L + 1); GRID_BAR(); }
        else ph_resid_norm(c, c.xo, T2, c.xo, ng + 3 * DM, nullptr, nullptr);
    }
#undef GRID_BAR
}

extern "C" void kernel_launch(void* const* d_in, const int* in_sizes, int n_in, void* d_out, int out_size, void* d_ws, size_t ws_size, hipStream_t stream) {
    static int grid = 0;
    if (grid == 0) {
        if (n_in != 13 || in_sizes[0] != MTOK * DM || out_size != MTOK * DM || ws_size < WS_END) { fprintf(stderr, "kernel_launch: unexpected shapes / workspace (%zu)\n", ws_size); grid = -1; return; }
        int dev = 0, cus = 0, per_cu = 0;
        if (hipGetDevice(&dev) != hipSuccess || hipDeviceGetAttribute(&cus, hipDeviceAttributeMultiprocessorCount, dev) != hipSuccess) { grid = -1; return; }
        if (hipFuncSetAttribute((const void*)mega_fwd, hipFuncAttributeMaxDynamicSharedMemorySize, LDS_BYTES) != hipSuccess) { fprintf(stderr, "hipFuncSetAttribute failed\n"); grid = -1; return; }
        if (hipOccupancyMaxActiveBlocksPerMultiprocessor(&per_cu, (const void*)mega_fwd, 512, LDS_BYTES) != hipSuccess || per_cu < 1) { fprintf(stderr, "occupancy query: %d\n", per_cu); (void)hipGetLastError(); }
        grid = cus;
    }
    if (grid < 0) return;
    if (hipMemsetAsync((char*)d_ws + WS_CTL, 0, CTL_ZERO_BYTES, stream) != hipSuccess) return;
    Args a{};
    for (int i = 0; i < 13; ++i) a.in[i] = (const float*)d_in[i];
    a.out = (float*)d_out; a.ws = (unsigned char*)d_ws;
    hipLaunchKernelGGL(mega_fwd, dim3(grid), dim3(512), LDS_BYTES, stream, a);
}
```

```cpp
#include <hip/hip_runtime.h>
#include <cstdio>
#include <cstdint>
namespace pg8 {
#define PG8_LAS __attribute__((address_space(3)))
typedef unsigned short bf16_t;
typedef short bf16x8 __attribute__((ext_vector_type(8)));
typedef float f32x4 __attribute__((ext_vector_type(4)));
typedef unsigned u32x4 __attribute__((ext_vector_type(4)));
constexpr int BM = 256, BK = 64, HALF = 128, HTB = HALF * BK * 2  , STAGE_BYTES = 8 * HTB, NXCD = 8, WGM = 8;

__host__ __device__ __forceinline__ int lds_byte(int r, int c) { const int st = (r >> 4) * 2 + (c >> 5), rr = r & 15, cc = c & 31, ob = rr * 64 + cc * 2; return st * 1024 + (ob ^ (((ob >> 9) & 1) << 5)); }
__host__ __device__ __forceinline__ void stage_rc(int b, int& R, int& C) { const int st = b / 1024, sb = b % 1024, swz = sb ^ (((sb >> 9) & 1) << 5); R = (st >> 1) * 16 + swz / 64; C = (st & 1) * 32 + (swz % 64) / 2; }
__host__ __device__ __forceinline__ int perm32(int rho) { const int n = rho >> 4, i = rho & 15; return 8 * (i >> 2) + 4 * n + (i & 3); }

struct Unit { int pm, pn; };
struct Gemm { const bf16_t* A; const bf16_t* Bt; int M, N, K, pad; };

struct StaticOrder {
    int nM, nN, nwg, G, c;
    __host__ __device__ void init(int M, int N, int G_, int c_) { nM = M / BM; nN = N / BM; nwg = nM * nN; G = G_; c = c_; }
    __host__ __device__ bool next(int i, Unit& u) const {
        const long L = (long)i * G + c; if (L >= nwg) return false;
        int wgid = (int)L; { const int q = nwg / NXCD, r = nwg % NXCD, xcd = wgid % NXCD, off = wgid / NXCD; wgid = (xcd < r ? xcd * (q + 1) : r * (q + 1) + (xcd - r) * q) + off; }
        const int nig = WGM * nN, gid = wgid / nig, fm = gid * WGM, gsz = (nM - fm) < WGM ? (nM - fm) : WGM;
        u.pm = fm + ((wgid % nig) % gsz); u.pn = (wgid % nig) / gsz; return true;
    }
    __device__ __forceinline__ void a_ready(const Unit&) const {}
    __device__ __forceinline__ void done(const Unit&) const {}
};

__device__ __forceinline__ unsigned cvt_pk_bf16(float lo, float hi) { unsigned r; asm volatile("v_cvt_pk_bf16_f32 %0, %1, %2" : "=v"(r) : "v"(lo), "v"(hi)); return r; }
typedef float f32x2 __attribute__((ext_vector_type(2)));
struct EpiF32 {
    static constexpr bool PERM = false, AFTER_DRAIN = false;
    float* C; const float* bias; int ldc, pad;
    __device__ __forceinline__ void operator()(const f32x4 (&acc)[2][2][4][2], const Unit& u, int wr, int wc, int fr, int fq) const {
        const int row0 = u.pm * BM + wr * 64 + fr, col0 = u.pn * BM + wc * 32 + 4 * fq;
        f32x4 bv[2][2];
#pragma unroll
        for (int bj = 0; bj < 2; ++bj)
#pragma unroll
            for (int n = 0; n < 2; ++n) bv[bj][n] = bias ? *(const f32x4*)(bias + col0 + bj * HALF + n * 16) : (f32x4){0.f, 0.f, 0.f, 0.f};
#pragma unroll
        for (int ai = 0; ai < 2; ++ai)
#pragma unroll
            for (int m = 0; m < 4; ++m) { float* rowp = C + (size_t)(row0 + ai * HALF + m * 16) * ldc + col0;
#pragma unroll
                for (int bj = 0; bj < 2; ++bj)
#pragma unroll
                    for (int n = 0; n < 2; ++n) *(f32x4*)(rowp + bj * HALF + n * 16) = acc[ai][bj][m][n] + bv[bj][n]; }
    }
};
template <int ACT> struct EpiBf16 {
    static constexpr bool PERM = true, AFTER_DRAIN = false;
    bf16_t* O; int ldc, pad;
    __device__ __forceinline__ void operator()(const f32x4 (&acc)[2][2][4][2], const Unit& u, int wr, int wc, int fr, int fq) const {
        const int row0 = u.pm * BM + wr * 64 + fr; const int col0 = u.pn * BM + wc * 32 + 8 * fq;
#pragma unroll
        for (int ai = 0; ai < 2; ++ai)
#pragma unroll
            for (int m = 0; m < 4; ++m) { bf16_t* rowp = O + (size_t)(row0 + ai * HALF + m * 16) * ldc + col0;
#pragma unroll
                for (int bj = 0; bj < 2; ++bj) { f32x4 v0 = acc[ai][bj][m][0], v1 = acc[ai][bj][m][1];
                    if (ACT == 1) {
#pragma unroll
                        for (int j = 0; j < 4; ++j) { const float a = fmaxf(v0[j], 0.f), b = fmaxf(v1[j], 0.f); v0[j] = a * a; v1[j] = b * b; } }
                    u32x4 w; w.x = cvt_pk_bf16(v0[0], v0[1]); w.y = cvt_pk_bf16(v0[2], v0[3]); w.z = cvt_pk_bf16(v1[0], v1[1]); w.w = cvt_pk_bf16(v1[2], v1[3]);
                    *(u32x4*)(rowp + bj * HALF) = w; } }
    }
};
template <class Epi, class Sched, bool ALIGN_EPI = false, bool SP2 = false>
__device__ __forceinline__ void gemm_phase(PG8_LAS unsigned char* lds, const Gemm g, const Sched& S, const Epi& E, int wave_id  ) {
    int tid_ = wave_id * 64 + (int)__builtin_amdgcn_mbcnt_hi(~0u, __builtin_amdgcn_mbcnt_lo(~0u, 0u)); asm volatile("" : "+v"(tid_));
    const int tid = tid_, wid = __builtin_amdgcn_readfirstlane(tid >> 6), lane = tid & 63, wr = wid >> 2, wc = wid & 3, fr = lane & 15, fq = lane >> 4;
    const int K = g.K, nt = K / BK;
    unsigned voffA[2], voffB[2];
#pragma unroll
    for (int i = 0; i < 2; ++i) { int R, C; stage_rc(tid * 16 + i * 8192, R, C); const int Rb = Epi::PERM ? ((R & ~31) + perm32(R & 31)) : R;
        voffA[i] = (unsigned)(R * K + C) * 2u; voffB[i] = (unsigned)(Rb * K + C) * 2u; }
    const size_t kstep = (size_t)(BK * 2);
    const size_t hstep = (size_t)HALF * K * 2;
    const size_t tstep = 2 * hstep;
    const unsigned ldsw = (unsigned)wid * 1024u;
    const int aoff = lds_byte(wr * 64 + fr, fq * 8), boff = lds_byte(wc * 32 + fr, fq * 8);
#define PG8_SA(b, h) (((b) * 2 + (h)) * HTB)
#define PG8_SB(b, h) ((4 + (b) * 2 + (h)) * HTB)
#define PG8_STAGE(bufoff, gbase, voff) do { _Pragma("unroll") for (int _i = 0; _i < 2; ++_i) \
        __builtin_amdgcn_global_load_lds((const unsigned*)((const char*)(gbase) + (voff)[_i]), (PG8_LAS unsigned*)(lds + (bufoff) + ldsw + _i * 8192), 16, 0, 0); } while (0)
#define PG8_LDA(dst, b, h) do { _Pragma("unroll") for (int m = 0; m < 4; ++m) _Pragma("unroll") for (int k = 0; k < 2; ++k) dst[m][k] = *(const PG8_LAS bf16x8*)(lds + PG8_SA(b, h) + aoff + m * 2048 + k * 1024); } while (0)
#define PG8_LDB(dst, b, h) do { _Pragma("unroll") for (int n = 0; n < 2; ++n) _Pragma("unroll") for (int k = 0; k < 2; ++k) dst[n][k] = *(const PG8_LAS bf16x8*)(lds + PG8_SB(b, h) + boff + n * 2048 + k * 1024); } while (0)
#define PG8_MMA(ai, bj, At, Bt) do { __builtin_amdgcn_s_setprio(1); _Pragma("unroll") for (int m = 0; m < 4; ++m) _Pragma("unroll") for (int n = 0; n < 2; ++n) _Pragma("unroll") for (int k = 0; k < 2; ++k) \
        acc[ai][bj][m][n] = __builtin_amdgcn_mfma_f32_16x16x32_bf16(Bt[n][k], At[m][k], acc[ai][bj][m][n], 0, 0, 0); __builtin_amdgcn_s_setprio(0); } while (0)
#define PG8_WAIT_V(n) asm volatile("s_waitcnt vmcnt(" #n ")" ::: "memory")
#define PG8_WAIT_L(n) asm volatile("s_waitcnt lgkmcnt(" #n ")" ::: "memory")
#define PG8_BAR __builtin_amdgcn_s_barrier()
#define PG8_SCHED __builtin_amdgcn_sched_barrier(0)
    Unit cur, nxt; int ui = 0;
    if (!S.next(0, cur)) return;
    f32x4 acc[2][2][4][2];
#pragma unroll
    for (int a = 0; a < 2; ++a)
#pragma unroll
        for (int b = 0; b < 2; ++b)
#pragma unroll
            for (int m = 0; m < 4; ++m)
#pragma unroll
                for (int n = 0; n < 2; ++n) acc[a][b][m][n] = (f32x4){0.f, 0.f, 0.f, 0.f};
    bf16x8 At[4][2], B0[2][2], B1[2][2];
    const char* cA = (const char*)g.A + (size_t)cur.pm * tstep; const char* cB = (const char*)g.Bt + (size_t)cur.pn * tstep;
    S.a_ready(cur);
    if constexpr (SP2) {
        PG8_STAGE(PG8_SB(0, 0), cB, voffB); PG8_STAGE(PG8_SB(0, 1), cB + hstep, voffB); PG8_STAGE(PG8_SA(0, 0), cA, voffA); PG8_STAGE(PG8_SA(0, 1), cA + hstep, voffA);
        if (wr == 1) PG8_BAR;
        PG8_WAIT_V(2); PG8_BAR;
        PG8_STAGE(PG8_SB(1, 0), cB + kstep, voffB); PG8_STAGE(PG8_SA(1, 0), cA + kstep, voffA); PG8_STAGE(PG8_SB(1, 1), cB + hstep + kstep, voffB);
        PG8_WAIT_V(6); PG8_BAR;
    } else {
        PG8_STAGE(PG8_SB(0, 0), cB, voffB); PG8_STAGE(PG8_SA(0, 0), cA, voffA); PG8_STAGE(PG8_SB(0, 1), cB + hstep, voffB); PG8_STAGE(PG8_SA(0, 1), cA + hstep, voffA);
        if (wr == 1) PG8_BAR;
        PG8_WAIT_V(4); PG8_BAR;
        PG8_STAGE(PG8_SB(1, 0), cB + kstep, voffB); PG8_STAGE(PG8_SA(1, 0), cA + kstep, voffA); PG8_STAGE(PG8_SB(1, 1), cB + hstep + kstep, voffB);
        PG8_WAIT_V(6); PG8_BAR;
    }
    for (;;) {
        const bool has_next = S.next(ui + 1, nxt);
        const char* nA = has_next ? (const char*)g.A + (size_t)nxt.pm * tstep : cA; const char* nB = has_next ? (const char*)g.Bt + (size_t)nxt.pn * tstep : cB;
        for (int t = 0; t < nt; t += 2) {
            const bool last = (t == nt - 2);
            const char* a1 = cA + (size_t)(t + 1) * kstep;
            const char* a2 = last ? nA : cA + (size_t)(t + 2) * kstep; const char* b2 = last ? nB : cB + (size_t)(t + 2) * kstep;
            const char* a3 = a2 + kstep; const char* b3 = b2 + kstep;
            if (last && has_next) S.a_ready(nxt);
            if constexpr (SP2) {
            PG8_LDB(B0, 0, 0); PG8_LDB(B1, 0, 1); PG8_SCHED; PG8_LDA(At, 0, 0); PG8_STAGE(PG8_SA(1, 1), a1 + hstep, voffA);
            PG8_WAIT_V(8); PG8_WAIT_L(0); PG8_BAR; PG8_MMA(0, 0, At, B0); PG8_MMA(0, 1, At, B1); PG8_BAR; PG8_SCHED;
            PG8_LDA(At, 0, 1); PG8_STAGE(PG8_SB(0, 0), b2, voffB); PG8_STAGE(PG8_SB(0, 1), b2 + hstep, voffB); PG8_STAGE(PG8_SA(0, 0), a2, voffA);
            PG8_WAIT_V(8); PG8_WAIT_L(0); PG8_BAR; PG8_MMA(1, 0, At, B0); PG8_MMA(1, 1, At, B1); PG8_BAR; PG8_SCHED;
            PG8_LDB(B0, 1, 0); PG8_LDB(B1, 1, 1); PG8_SCHED; PG8_LDA(At, 1, 0); PG8_STAGE(PG8_SA(0, 1), a2 + hstep, voffA);
            PG8_WAIT_V(8); PG8_WAIT_L(0); PG8_BAR; PG8_MMA(0, 0, At, B0); PG8_MMA(0, 1, At, B1); PG8_BAR; PG8_SCHED;
            PG8_LDA(At, 1, 1); PG8_STAGE(PG8_SB(1, 0), b3, voffB); PG8_STAGE(PG8_SB(1, 1), b3 + hstep, voffB); PG8_STAGE(PG8_SA(1, 0), a3, voffA);
            PG8_WAIT_V(8); PG8_WAIT_L(0); PG8_BAR; PG8_MMA(1, 0, At, B0); PG8_MMA(1, 1, At, B1); PG8_BAR; PG8_SCHED;
            } else {
            PG8_LDB(B0, 0, 0); PG8_SCHED; PG8_LDA(At, 0, 0); PG8_STAGE(PG8_SA(1, 1), a1 + hstep, voffA);
            PG8_WAIT_L(8); PG8_BAR; PG8_WAIT_L(0); PG8_MMA(0, 0, At, B0); PG8_BAR; PG8_SCHED;
            PG8_LDB(B1, 0, 1); PG8_STAGE(PG8_SB(0, 0), b2, voffB);
            PG8_BAR; PG8_WAIT_L(0); PG8_MMA(0, 1, At, B1); PG8_BAR;
            PG8_LDA(At, 0, 1); PG8_STAGE(PG8_SA(0, 0), a2, voffA);
            PG8_BAR; PG8_WAIT_L(0); PG8_MMA(1, 0, At, B0); PG8_BAR; PG8_SCHED;
            PG8_STAGE(PG8_SB(0, 1), b2 + hstep, voffB);
            PG8_WAIT_V(6); PG8_BAR; PG8_MMA(1, 1, At, B1); PG8_BAR;
            PG8_LDB(B0, 1, 0); PG8_SCHED; PG8_LDA(At, 1, 0); PG8_STAGE(PG8_SA(0, 1), a2 + hstep, voffA);
            PG8_WAIT_L(8); PG8_BAR; PG8_WAIT_L(0); PG8_MMA(0, 0, At, B0); PG8_BAR; PG8_SCHED;
            PG8_LDB(B1, 1, 1); PG8_STAGE(PG8_SB(1, 0), b3, voffB);
            PG8_BAR; PG8_WAIT_L(0); PG8_MMA(0, 1, At, B1); PG8_BAR;
            PG8_LDA(At, 1, 1); PG8_STAGE(PG8_SA(1, 0), a3, voffA);
            PG8_BAR; PG8_WAIT_L(0); PG8_MMA(1, 0, At, B0); PG8_BAR; PG8_SCHED;
            PG8_STAGE(PG8_SB(1, 1), b3 + hstep, voffB);
            PG8_WAIT_V(6); PG8_BAR; PG8_MMA(1, 1, At, B1); PG8_BAR;
            }
        }
        if constexpr (ALIGN_EPI) { if (wr == 0) PG8_BAR; }
        if constexpr (!Epi::AFTER_DRAIN) { E(acc, cur, wr, wc, fr, fq); S.done(cur); }
        if (!has_next) break;
#pragma unroll
        for (int a = 0; a < 2; ++a)
#pragma unroll
            for (int b = 0; b < 2; ++b)
#pragma unroll
                for (int m = 0; m < 4; ++m)
#pragma unroll
                    for (int n = 0; n < 2; ++n) acc[a][b][m][n] = (f32x4){0.f, 0.f, 0.f, 0.f};
        cur = nxt; cA = nA; cB = nB; ++ui;
        if constexpr (ALIGN_EPI) { if (wr == 1) PG8_BAR; }
    }
    PG8_WAIT_V(0);
    if constexpr (!ALIGN_EPI) { if (wr == 0) PG8_BAR; }
    PG8_BAR;
    if constexpr (Epi::AFTER_DRAIN) { E.fused(acc, cur, wr, wc, fr, fq, lds, wid, lane); S.done(cur); }
#undef PG8_SA
#undef PG8_SB
#undef PG8_STAGE
#undef PG8_LDA
#undef PG8_LDB
#undef PG8_MMA
#undef PG8_WAIT_V
#undef PG8_WAIT_L
#undef PG8_BAR
#undef PG8_SCHED
}
}
#define GAS __attribute__((address_space(1)))
#define LAS __attribute__((address_space(3)))

typedef unsigned v4u __attribute__((ext_vector_type(4)));


typedef GAS unsigned gu32;
typedef GAS unsigned long long gu64;
#define RLX_AGENT __ATOMIC_RELAXED, __HIP_MEMORY_SCOPE_AGENT
#define LDS_WAIT() asm volatile("s_waitcnt lgkmcnt(0)" ::: "memory")
#define VM_WAIT() asm volatile("s_waitcnt vmcnt(0)" ::: "memory")
#define XB_TMO      128
#define XB_XCNT(j)  (256  + 64 * (j))
#define XB_XSUB(j)  (1280 + 64 * (j))
#define XB_XGEN(j)  (2304 + 64 * (j))
#define XB_TOP      3328
#define XB_TOPGEN   3392
#define XCD_BAR_WORDS 3456
#define XB_SPIN_CAP (1u << 18)

__device__ __forceinline__ unsigned xb_ld(unsigned* p)              { return __hip_atomic_load(p, __ATOMIC_RELAXED, __HIP_MEMORY_SCOPE_AGENT); }
__device__ __forceinline__ unsigned xb_add(unsigned* p, unsigned v) { return __hip_atomic_fetch_add(p, v, __ATOMIC_RELAXED, __HIP_MEMORY_SCOPE_AGENT); }
__device__ __forceinline__ unsigned xb_xcc_id() { return (unsigned)__builtin_amdgcn_s_getreg((3 << 11) | 20) & 0xFu; }
#define XB_SPIN(cond, bar) do { unsigned _sp = 0; while (cond) { __builtin_amdgcn_s_sleep(1); \
    if ((++_sp & 255u) == 0u) { if (xb_ld(&(bar)[XB_TMO])) break; if (_sp > XB_SPIN_CAP) { atomicAdd(&(bar)[XB_TMO], 1u); break; } } } } while (0)

struct XcdBarrier {
    unsigned* bar; unsigned x;
    volatile LAS unsigned* st;
};

__device__ __forceinline__ XcdBarrier xcd_barrier_post(unsigned* bar, volatile LAS unsigned* st) {
    XcdBarrier b; b.bar = bar; b.x = xb_xcc_id(); b.st = st;
    if (threadIdx.x == 0) (void)xb_add(&bar[XB_XCNT(b.x)], 1u);
    return b;
}
__device__ __forceinline__ void xcd_barrier_complete(unsigned* bar, unsigned x, unsigned& nloc, unsigned& nx) {
    const unsigned G = gridDim.x * gridDim.y * gridDim.z;
    unsigned sum, cnt, mine, sp = 0u;
    for (;;) {
        sum = 0u; cnt = 0u; mine = 0u;
#pragma unroll
        for (unsigned j = 0; j < 16; ++j) { const unsigned c = xb_ld(&bar[XB_XCNT(j)]); sum += c; cnt += (c > 0u) ? 1u : 0u; mine = (j == x) ? c : mine; }
        if (sum == G) break;
        __builtin_amdgcn_s_sleep(1);
        if ((++sp & 255u) == 0u) { if (xb_ld(&bar[XB_TMO])) break; if (sp > XB_SPIN_CAP) { atomicAdd(&bar[XB_TMO], 1u); break; } }
    }
    nloc = mine > 0u ? mine : 1u; nx = cnt > 0u ? cnt : 1u;
}

__device__ __forceinline__ void xcd_barrier(const XcdBarrier& b) {
    asm volatile("s_waitcnt vmcnt(0)" ::: "memory");
    __syncthreads();
    if (threadIdx.x == 0) {
        unsigned* bar = b.bar; asm volatile("" : "+s"(bar)); unsigned bx = b.x; asm volatile("" : "+s"(bx));
        __builtin_amdgcn_s_waitcnt(0);
        unsigned nloc = b.st[0], nx = b.st[1];
        if (nloc == 0u) { xcd_barrier_complete(bar, bx, nloc, nx); b.st[0] = nloc; b.st[1] = nx; }
        const unsigned old = xb_add(&bar[XB_XSUB(bx)], 1u);
        const unsigned gen = old / nloc;
        if (old + 1u == (gen + 1u) * nloc) {
            __builtin_amdgcn_fence(__ATOMIC_RELEASE, "agent");
            asm volatile("s_waitcnt vmcnt(0)" ::: "memory");
            const unsigned og = xb_add(&bar[XB_TOP], 1u);
            const unsigned tg = og / nx;
            if (og + 1u == (tg + 1u) * nx) xb_add(&bar[XB_TOPGEN], 1u);
            else XB_SPIN(xb_ld(&bar[XB_TOPGEN]) == tg, bar);
            __builtin_amdgcn_fence(__ATOMIC_ACQUIRE, "agent");
            xb_add(&bar[XB_XGEN(bx)], 1u);
            asm volatile("s_waitcnt vmcnt(0)" ::: "memory");
        } else {
            XB_SPIN(xb_ld(&bar[XB_XGEN(bx)]) == gen, bar);
            __builtin_amdgcn_fence(__ATOMIC_ACQUIRE, "agent");
            asm volatile("s_waitcnt vmcnt(0)" ::: "memory");
        }
    }
    __syncthreads();
}

typedef unsigned short bf16_t;
constexpr int NB = 16, SEQ = 2048, DM = 1024, MTOK = NB * SEQ, DEPTH = 4, DIN = 2964, DINP = 3072, DFF = 4096;
constexpr int ZC_MQ = 0, ZC_MK = 256, ZC_MV = 512, ZC_LQ = 768, ZC_LK = 1024, ZC_LV = 1280, ZC_LO = 1792, ZC_LI = 2304, ZC_LF = 2308,
              ZC_NQ = 2312, ZC_KC = 2568, ZC_VC = 2632, ZC_KSL = 2696, ZC_VSL = 2760, ZC_KWN = 2824, ZC_VWN = 2888, ZC_NG = 2952;
constexpr float EPS = 1e-6f;
constexpr size_t MiB = 1u << 20;
constexpr size_t WS_CTL = 0, CTL_ZERO_BYTES = 1 * MiB;
constexpr size_t WS_WIN = 1 * MiB, WS_WOUT = 7 * MiB, WS_W1 = 9 * MiB, WS_W2 = 17 * MiB;
constexpr size_t WS_CW1 = 25 * MiB;
constexpr size_t WS_CW2 = 27 * MiB;
constexpr size_t WS_CPE = 27 * MiB + 65536;
constexpr size_t WS_KMEAN = 28 * MiB, WS_KCMP = 28 * MiB + 256 * 1024, WS_VCMP = 28 * MiB + 768 * 1024;
constexpr size_t WS_GATES = 30 * MiB;
constexpr size_t WS_T2 = 32 * MiB;
constexpr size_t WS_QKC = 96 * MiB;
constexpr size_t WS_CC = 128 * MiB, WS_CPREV = 160 * MiB;
constexpr size_t WS_HID = 128 * MiB;
constexpr size_t WS_BIG = 192 * MiB;
constexpr size_t WS_Z = WS_BIG, WS_Y = WS_BIG + 192 * MiB, WS_H = WS_BIG, WS_T = WS_BIG;
constexpr size_t WS_HN = 448 * MiB;
constexpr size_t WS_END = 512 * MiB;
constexpr int CW_BAR = 4096;

__device__ __forceinline__ float bf2f(bf16_t v) { return __uint_as_float(((unsigned)v) << 16); }
__device__ __forceinline__ bf16_t f2bf(float f) { unsigned u = __float_as_uint(f); u += 0x7fffu + ((u >> 16) & 1u); return (bf16_t)(u >> 16); }
__device__ __forceinline__ unsigned pk2bf(float lo, float hi) { return (unsigned)f2bf(lo) | ((unsigned)f2bf(hi) << 16); }
__device__ __forceinline__ float wave_sum(float v) {
#pragma unroll
    for (int o = 1; o < 64; o <<= 1) v += __shfl_xor(v, o);
    return v;
}
__device__ __forceinline__ float wave_max(float v) {
#pragma unroll
    for (int o = 1; o < 64; o <<= 1) v = fmaxf(v, __shfl_xor(v, o));
    return v;
}
__device__ __forceinline__ float sigmoidf_(float x) { return 1.f / (1.f + __expf(-x)); }
__device__ __forceinline__ float gelu_tanh(float x) { const float u = 0.7978845608028654f * (x + 0.044715f * x * x * x); return 0.5f * x * (1.f + tanhf(u)); }

struct Ctx {
    const float *x_in, *norm_g, *w_in, *conv_w, *conv_b, *gate_b, *cmp_pe, *cmp_w1, *cmp_w2, *head_g, *w_out, *w1, *w2;
    float* xo; unsigned char* ws; unsigned char* lds;
    int tid, lane, wave, bid, nb;
};

__device__ __forceinline__ void wconv_tile(const float* __restrict__ src, bf16_t* __restrict__ dst, int K, int N, int Npad, int it, int t256, float* tile  , bool active) {
    const int ntn = Npad / 64, tk = it / ntn, tn = it % ntn, k0 = tk * 64, n0 = tn * 64;
    if (active) {
#pragma unroll 4
        for (int i = 0; i < 16; ++i) { const int kk = i * 4 + (t256 >> 6), nn = t256 & 63; const int n = n0 + nn;
            tile[kk * 65 + nn] = (n < N) ? src[(size_t)(k0 + kk) * N + n] : 0.f; }
    }
    __syncthreads();
    if (active) {
        const int nn = t256 >> 2, ks = (t256 & 3) * 16;
        unsigned w[8];
#pragma unroll
        for (int j = 0; j < 8; ++j) w[j] = pk2bf(tile[(ks + 2 * j) * 65 + nn], tile[(ks + 2 * j + 1) * 65 + nn]);
        uint4* o = (uint4*)(dst + (size_t)(n0 + nn) * K + k0 + ks);
        o[0] = make_uint4(w[0], w[1], w[2], w[3]); o[1] = make_uint4(w[4], w[5], w[6], w[7]);
    }
    __syncthreads();
}
__device__ __forceinline__ void ph_wconv(const Ctx& c_, int L) {
    Ctx c = c_; c.lane = (int)__builtin_amdgcn_mbcnt_hi(~0u, __builtin_amdgcn_mbcnt_lo(~0u, 0u)); asm volatile("" : "+v"(c.lane)); c.tid = c.wave * 64 + c.lane; asm volatile("" : "+s"(c.bid)); asm volatile("" : "+s"(c.ws));
    const int half = c.tid >> 8, t256 = c.tid & 255; float* tile = (float*)(c.lds) + half * (64 * 65);
    constexpr int T_IN = (DM / 64) * (DINP / 64), T_OUT = (DM / 64) * (DM / 64), T_1 = (DM / 64) * (DFF / 64), T_2 = (DFF / 64) * (DM / 64), TOT = T_IN + T_OUT + T_1 + T_2;
    for (int base = c.bid * 2; base < TOT; base += c.nb * 2) {
        int it = base + half; const bool act = it < TOT;
        if (!act) it = 0;
        const float* src; bf16_t* dst; int K, N, Np;
        if (it < T_IN) { src = c.w_in + (size_t)L * DM * DIN; dst = (bf16_t*)(c.ws + WS_WIN); K = DM; N = DIN; Np = DINP; }
        else if ((it -= T_IN) < T_OUT) { src = c.w_out + (size_t)L * DM * DM; dst = (bf16_t*)(c.ws + WS_WOUT); K = DM; N = DM; Np = DM; }
        else if ((it -= T_OUT) < T_1) { src = c.w1 + (size_t)L * DM * DFF; dst = (bf16_t*)(c.ws + WS_W1); K = DM; N = DFF; Np = DFF; }
        else { it -= T_1; src = c.w2 + (size_t)L * DFF * DM; dst = (bf16_t*)(c.ws + WS_W2); K = DFF; N = DM; Np = DM; }
        wconv_tile(src, dst, K, N, Np, it, t256, tile, act);
    }
}

__device__ __forceinline__ void ph_resid_norm(const Ctx& c_, const float* __restrict__ xsrc, const float* __restrict__ T, float* xdst, const float* __restrict__ ga, const float* __restrict__ gb, bf16_t* HN) {
    Ctx c = c_; c.lane = (int)__builtin_amdgcn_mbcnt_hi(~0u, __builtin_amdgcn_mbcnt_lo(~0u, 0u)); asm volatile("" : "+v"(c.lane)); c.tid = c.wave * 64 + c.lane; asm volatile("" : "+s"(c.bid)); asm volatile("" : "+s"(c.ws));
    const int lane = c.lane;
    for (int row = c.bid * 8 + c.wave; row < MTOK; row += c.nb * 8) {
        const float4* xr = (const float4*)(xsrc + (size_t)row * DM) + lane;
        float4 v[4];
#pragma unroll
        for (int j = 0; j < 4; ++j) v[j] = xr[64 * j];
        if (T) {
            const float4* tr = (const float4*)(T + (size_t)row * DM) + lane; float4 t[4]; float ss = 0.f;
#pragma unroll
            for (int j = 0; j < 4; ++j) { t[j] = tr[64 * j]; ss += t[j].x * t[j].x + t[j].y * t[j].y + t[j].z * t[j].z + t[j].w * t[j].w; }
            const float r = rsqrtf(wave_sum(ss) * (1.f / DM) + EPS);
#pragma unroll
            for (int j = 0; j < 4; ++j) { const float4 g = ((const float4*)ga)[lane + 64 * j];
                v[j].x += t[j].x * r * g.x; v[j].y += t[j].y * r * g.y; v[j].z += t[j].z * r * g.z; v[j].w += t[j].w * r * g.w; }
        }
        if (xdst) { float4* xo = (float4*)(xdst + (size_t)row * DM) + lane;
#pragma unroll
            for (int j = 0; j < 4; ++j) xo[64 * j] = v[j]; }
        if (HN) {
            float ss = 0.f;
#pragma unroll
            for (int j = 0; j < 4; ++j) ss += v[j].x * v[j].x + v[j].y * v[j].y + v[j].z * v[j].z + v[j].w * v[j].w;
            const float r = rsqrtf(wave_sum(ss) * (1.f / DM) + EPS);
            uint2* o = (uint2*)(HN + (size_t)row * DM) + lane;
#pragma unroll
            for (int j = 0; j < 4; ++j) { const float4 g = ((const float4*)gb)[lane + 64 * j];
                uint2 w; w.x = pk2bf(v[j].x * r * g.x, v[j].y * r * g.y); w.y = pk2bf(v[j].z * r * g.z, v[j].w * r * g.w);
                o[64 * j] = w; }
        }
    }
}

__device__ __forceinline__ void wsync() { asm volatile("s_waitcnt lgkmcnt(0)" ::: "memory"); }

__device__ __forceinline__ void nv_kmean(const Ctx& c_) {
    Ctx c = c_; c.lane = (int)__builtin_amdgcn_mbcnt_hi(~0u, __builtin_amdgcn_mbcnt_lo(~0u, 0u)); asm volatile("" : "+v"(c.lane)); c.tid = c.wave * 64 + c.lane; asm volatile("" : "+s"(c.bid)); asm volatile("" : "+s"(c.ws));
    const bf16_t* Z = (const bf16_t*)(c.ws + WS_Z); float* kmean = (float*)(c.ws + WS_KMEAN);
    for (int it = c.bid * 8 + c.wave; it < 512; it += c.nb * 8) {
        const int bh = it >> 3, n = it & 7, b = bh >> 2, h = bh & 3, d = c.lane;
        const bf16_t* p = Z + ((size_t)b * SEQ + n * 256) * DINP + ZC_MK + h * 64 + d; float s = 0.f;
        for (int i = 0; i < 256; ++i) s += bf2f(p[(size_t)i * DINP]);
        kmean[(size_t)it * 64 + d] = s * (1.f / 256.f);
    }
}
__device__ __forceinline__ void nv_moba(const Ctx& c_, int L) {
    Ctx c = c_; c.lane = (int)__builtin_amdgcn_mbcnt_hi(~0u, __builtin_amdgcn_mbcnt_lo(~0u, 0u)); asm volatile("" : "+v"(c.lane)); c.tid = c.wave * 64 + c.lane; asm volatile("" : "+s"(c.bid)); asm volatile("" : "+s"(c.ws));
    const bf16_t* Z = (const bf16_t*)(c.ws + WS_Z); const float* kmean = (const float*)(c.ws + WS_KMEAN); bf16_t* Y = (bf16_t*)(c.ws + WS_Y); const float* hg = c.head_g + (size_t)L * DM;
    float* base = (float*)(c.lds + c.wave * 4608); float* qs = base; float* sc = base + 64; float* gate = base + 64 + 1024; int* blks = (int*)(base + 64 + 1024 + 8); int* nblk_s = blks + 4;
    const int lane = c.lane;
    for (int idx = c.bid * 8 + c.wave; idx < MTOK * 4; idx += c.nb * 8) {
        const int h = idx & 3, m = idx >> 2, b = m / SEQ, t = m % SEQ, cur = t >> 8;
        wsync();
        qs[lane] = bf2f(Z[(size_t)m * DINP + ZC_MQ + h * 64 + lane]);
        wsync();
        for (int n = 0; n < cur; ++n) { const float g = wave_sum(qs[lane] * kmean[((size_t)(b * 4 + h) * 8 + n) * 64 + lane]); if (lane == 0) gate[n] = g; }
        wsync();
        if (lane == 0) {
            int nb = 0;
            if (cur <= 3) { for (int n = 0; n < cur; ++n) blks[nb++] = n; }
            else { unsigned used = 0; for (int k = 0; k < 3; ++k) { int best = -1; float bv = -INFINITY; for (int n = 0; n < cur; ++n) if (!((used >> n) & 1u) && gate[n] > bv) { bv = gate[n]; best = n; }
                    if (best < 0) { for (int n = 0; n < cur; ++n) if (!((used >> n) & 1u)) { best = n; break; } }
                    used |= 1u << best; blks[nb++] = best; } }
            *nblk_s = nb;
        }
        wsync();
        const int nb = *nblk_s, nown = t - cur * 256 + 1, total = nb * 256 + nown;
        const bf16_t* Kb = Z + (size_t)b * SEQ * DINP + ZC_MK + h * 64; const bf16_t* Vb = Z + (size_t)b * SEQ * DINP + ZC_MV + h * 64;
        float mx = -INFINITY;
        for (int kk = lane; kk < total; kk += 64) { const int bi = kk >> 8, blk = bi < nb ? blks[bi] : cur, key = blk * 256 + (kk & 255);
            const uint4* kr = (const uint4*)(Kb + (size_t)key * DINP); float s = 0.f;
#pragma unroll
            for (int cc = 0; cc < 8; ++cc) { const uint4 w = kr[cc]; const unsigned ww[4] = {w.x, w.y, w.z, w.w};
#pragma unroll
                for (int j = 0; j < 4; ++j) { s += qs[cc * 8 + 2 * j] * __uint_as_float(ww[j] << 16) + qs[cc * 8 + 2 * j + 1] * __uint_as_float(ww[j] & 0xffff0000u); } }
            s *= 0.125f; sc[kk] = s; mx = fmaxf(mx, s); }
        mx = wave_max(mx);
        float sum = 0.f;
        for (int kk = lane; kk < total; kk += 64) { const float p = __expf(sc[kk] - mx); sc[kk] = p; sum += p; }
        sum = wave_sum(sum);
        wsync();
        float acc = 0.f;
        for (int kk = 0; kk < total; ++kk) { const int bi = kk >> 8, blk = bi < nb ? blks[bi] : cur, key = blk * 256 + (kk & 255); acc += sc[kk] * bf2f(Vb[(size_t)key * DINP + lane]); }
        const float o = acc / sum;
        const float ss = wave_sum(o * o);
        Y[(size_t)m * DM + h * 64 + lane] = f2bf(o * rsqrtf(ss * (1.f / 64.f) + EPS) * hg[h * 64 + lane]);
    }
}

__device__ __forceinline__ void nv_cmp(const Ctx& c_, int L) {
    Ctx c = c_; c.lane = (int)__builtin_amdgcn_mbcnt_hi(~0u, __builtin_amdgcn_mbcnt_lo(~0u, 0u)); asm volatile("" : "+v"(c.lane)); c.tid = c.wave * 64 + c.lane; asm volatile("" : "+s"(c.bid)); asm volatile("" : "+s"(c.ws));
    const bf16_t* Z = (const bf16_t*)(c.ws + WS_Z); float* kcmp = (float*)(c.ws + WS_KCMP); float* vcmp = (float*)(c.ws + WS_VCMP);
    const int half = c.tid >> 8, tid = c.tid & 255;
    float* blk = (float*)(c.lds + half * 36864); float* hid = blk + 4 * 2048;
    for (int base = c.bid * 2; base < 1024; base += c.nb * 2) {
        const int item = base + half; const int g4 = item & 31, kv = (item >> 5) & 1, b = item >> 6;
        const int col = kv ? ZC_VC : ZC_KC; const float* pej = c.cmp_pe + ((size_t)L * 2 + kv) * 2048; const float* w1j = c.cmp_w1 + ((size_t)L * 2 + kv) * 2048 * 256; const float* w2j = c.cmp_w2 + ((size_t)L * 2 + kv) * 256 * 64;
        for (int i = tid; i < 4 * 2048; i += 256) { const int g = i >> 11, e = i & 2047, l = e >> 6, d = e & 63, n = g4 * 4 + g; const int t = 16 * n + l;
            blk[g * 2048 + e] = (n < 127) ? bf2f(Z[((size_t)b * SEQ + t) * DINP + col + d]) + pej[e] : 0.f; }
        __syncthreads();
        float a0 = 0.f, a1 = 0.f, a2 = 0.f, a3 = 0.f;
        for (int i = 0; i < 2048; ++i) { const float w = w1j[(size_t)i * 256 + tid]; a0 += blk[i] * w; a1 += blk[2048 + i] * w; a2 += blk[4096 + i] * w; a3 += blk[6144 + i] * w; }
        hid[tid] = gelu_tanh(a0); hid[256 + tid] = gelu_tanh(a1); hid[512 + tid] = gelu_tanh(a2); hid[768 + tid] = gelu_tanh(a3);
        __syncthreads();
        const int g = tid >> 6, d = tid & 63, n = g4 * 4 + g; float o = 0.f;
        for (int j = 0; j < 256; ++j) o += hid[g * 256 + j] * w2j[j * 64 + d];
        float* dst = kv ? vcmp : kcmp; dst[((size_t)b * 128 + n) * 64 + d] = (n < 127) ? o : 0.f;
        __syncthreads();
    }
}

__device__ __forceinline__ void nv_nsa(const Ctx& c_, int L) {
    Ctx c = c_; c.lane = (int)__builtin_amdgcn_mbcnt_hi(~0u, __builtin_amdgcn_mbcnt_lo(~0u, 0u)); asm volatile("" : "+v"(c.lane)); c.tid = c.wave * 64 + c.lane; asm volatile("" : "+s"(c.bid)); asm volatile("" : "+s"(c.ws));
    const bf16_t* Z = (const bf16_t*)(c.ws + WS_Z); const float* kcmp = (const float*)(c.ws + WS_KCMP); const float* vcmp = (const float*)(c.ws + WS_VCMP); bf16_t* Y = (bf16_t*)(c.ws + WS_Y); const float* hg = c.head_g + (size_t)L * DM;
    const int half = c.tid >> 8, tid = c.tid & 255, h = tid >> 6, lane = tid & 63;
    float* base = (float*)(c.lds + 40960 + half * 12288);
    float* qs = base;
    float* pc = base + 256;
    float* Psum = base + 768;
    float* pslc = base + 896;
    unsigned* selmask = (unsigned*)(base + 928);
    float* sc = base + 1024;
    for (int m0 = c.bid * 2; m0 < MTOK; m0 += c.nb * 2) {
        const int m = m0 + half, b = m / SEQ, t = m % SEQ, cur = t >> 6;
        const bf16_t* zr = Z + (size_t)m * DINP;
        qs[h * 64 + lane] = bf2f(zr[ZC_NQ + h * 64 + lane]);
        pc[h * 128 + lane] = 0.f; pc[h * 128 + lane + 64] = 0.f;
        __syncthreads();
        const int nvis = t >= 31 ? (t - 31) / 16 + 1 : 0;
        const float* kc = kcmp + (size_t)b * 128 * 64; const float* vc = vcmp + (size_t)b * 128 * 64;
        float o_cmp = 0.f;
        if (nvis > 0) {
            float s0 = -INFINITY, s1 = -INFINITY;
            if (lane < nvis) { float s = 0.f; for (int d = 0; d < 64; ++d) s += qs[h * 64 + d] * kc[lane * 64 + d]; s0 = s * 0.125f; }
            if (lane + 64 < nvis) { float s = 0.f; for (int d = 0; d < 64; ++d) s += qs[h * 64 + d] * kc[(lane + 64) * 64 + d]; s1 = s * 0.125f; }
            const float mx = wave_max(fmaxf(s0, s1));
            const float p0 = lane < nvis ? __expf(s0 - mx) : 0.f, p1 = lane + 64 < nvis ? __expf(s1 - mx) : 0.f;
            const float sum = wave_sum(p0 + p1);
            pc[h * 128 + lane] = p0 / sum; pc[h * 128 + lane + 64] = p1 / sum;
        }
        __syncthreads();
        if (nvis > 0) { for (int n = 0; n < nvis; ++n) o_cmp += pc[h * 128 + n] * vc[n * 64 + lane]; }
        if (tid < 128) Psum[tid] = pc[tid] + pc[128 + tid] + pc[256 + tid] + pc[384 + tid];
        __syncthreads();
        if (tid < 32) { const int j = tid; float s = 0.f;
            if (4 * j - 1 >= 0) s += 0.5f * Psum[4 * j - 1];
            s += Psum[4 * j]; s += Psum[4 * j + 1]; s += Psum[4 * j + 2];
            if (4 * j + 3 <= 126) s += 0.5f * Psum[4 * j + 3];
            pslc[j] = s; }
        __syncthreads();
        if (tid == 0) {
            unsigned mask;
            if (cur <= 7) mask = (2u << cur) - 1u;
            else { mask = 1u | (1u << cur) | (1u << (cur - 1));
                for (int k = 0; k < 5; ++k) { int best = -1; float bv = -INFINITY; for (int j = 1; j <= cur - 2; ++j) if (!((mask >> j) & 1u) && pslc[j] > bv) { bv = pslc[j]; best = j; }
                    if (best < 0) { for (int j = 1; j <= cur - 2; ++j) if (!((mask >> j) & 1u)) { best = j; break; } }
                    mask |= 1u << best; } }
            *selmask = mask;
        }
        __syncthreads();
        const unsigned mask = *selmask;
        const bf16_t* Zb = Z + (size_t)b * SEQ * DINP;
        float o_sel, o_win;
        {
            int cnt = 0; float mx = -INFINITY;
            for (int j = 0; j <= cur; ++j) if ((mask >> j) & 1u) { const int key = j * 64 + lane; float s = -INFINITY;
                if (key <= t) { const bf16_t* kr = Zb + (size_t)key * DINP + ZC_KSL; float a = 0.f; for (int d = 0; d < 64; ++d) a += qs[h * 64 + d] * bf2f(kr[d]); s = a * 0.125f; }
                sc[h * 512 + cnt * 64 + lane] = s; mx = fmaxf(mx, s); ++cnt; }
            mx = wave_max(mx); float sum = 0.f;
            for (int i = 0; i < cnt; ++i) { const float s = sc[h * 512 + i * 64 + lane]; const float p = (s == -INFINITY) ? 0.f : __expf(s - mx); sc[h * 512 + i * 64 + lane] = p; sum += p; }
            sum = wave_sum(sum);
            __syncthreads();
            float acc = 0.f; int i = 0;
            for (int j = 0; j <= cur; ++j) if ((mask >> j) & 1u) { for (int k = 0; k < 64; ++k) acc += sc[h * 512 + i * 64 + k] * bf2f(Zb[(size_t)(j * 64 + k) * DINP + ZC_VSL + lane]); ++i; }
            o_sel = acc / sum;
            __syncthreads();
        }
        {
            float mx = -INFINITY;
            for (int i = 0; i < 8; ++i) { const int key = t - 511 + i * 64 + lane; float s = -INFINITY;
                if (key >= 0) { const bf16_t* kr = Zb + (size_t)key * DINP + ZC_KWN; float a = 0.f; for (int d = 0; d < 64; ++d) a += qs[h * 64 + d] * bf2f(kr[d]); s = a * 0.125f; }
                sc[h * 512 + i * 64 + lane] = s; mx = fmaxf(mx, s); }
            mx = wave_max(mx); float sum = 0.f;
            for (int i = 0; i < 8; ++i) { const float s = sc[h * 512 + i * 64 + lane]; const float p = (s == -INFINITY) ? 0.f : __expf(s - mx); sc[h * 512 + i * 64 + lane] = p; sum += p; }
            sum = wave_sum(sum);
            __syncthreads();
            float acc = 0.f;
            for (int kk = 0; kk < 512; ++kk) { const int key = t - 511 + kk; if (key >= 0) acc += sc[h * 512 + kk] * bf2f(Zb[(size_t)key * DINP + ZC_VWN + lane]); }
            o_win = acc / sum;
        }
        const float g0 = sigmoidf_(bf2f(zr[ZC_NG + h * 3 + 0])), g1 = sigmoidf_(bf2f(zr[ZC_NG + h * 3 + 1])), g2 = sigmoidf_(bf2f(zr[ZC_NG + h * 3 + 2]));
        const float o = g0 * o_cmp + g1 * o_sel + g2 * o_win;
        const float ss = wave_sum(o * o);
        Y[(size_t)m * DM + 768 + h * 64 + lane] = f2bf(o * rsqrtf(ss * (1.f / 64.f) + EPS) * hg[768 + h * 64 + lane]);
        __syncthreads();
    }
}

__device__ __forceinline__ void nv_ml_conv(const Ctx& c_, int L) {
    Ctx c = c_; c.lane = (int)__builtin_amdgcn_mbcnt_hi(~0u, __builtin_amdgcn_mbcnt_lo(~0u, 0u)); asm volatile("" : "+v"(c.lane)); c.tid = c.wave * 64 + c.lane; asm volatile("" : "+s"(c.bid)); asm volatile("" : "+s"(c.ws));
    const bf16_t* Z = (const bf16_t*)(c.ws + WS_Z); bf16_t* QKC = (bf16_t*)(c.ws + WS_QKC); float* gates = (float*)(c.ws + WS_GATES);
    const float* cw = c.conv_w + (size_t)L * 4 * 512; const float* cb = c.conv_b + (size_t)L * 512; const float* gb = c.gate_b + (size_t)L * 8;
    const int tid = c.tid;
    for (int m = c.bid; m < MTOK; m += c.nb) { const int t = m % SEQ;
        float a = cb[tid];
#pragma unroll
        for (int j = 0; j < 4; ++j) { const int tt = t - 3 + j; if (tt >= 0) a += bf2f(Z[(size_t)(m - 3 + j) * DINP + ZC_LQ + tid]) * cw[j * 512 + tid]; }
        float y = a / (1.f + __expf(-a)); if (tid >= 256) y *= 0.125f;
        QKC[(size_t)m * 512 + tid] = f2bf(y);
        if (tid < 4) gates[(size_t)m * 8 + tid] = bf2f(Z[(size_t)m * DINP + ZC_LI + tid]) + gb[tid];
        else if (tid < 8) { const float x = bf2f(Z[(size_t)m * DINP + ZC_LF + (tid - 4)]) + gb[tid]; gates[(size_t)m * 8 + tid] = fminf(x, 0.f) - log1pf(__expf(-fabsf(x))); }
    }
}
__device__ __forceinline__ void nv_ml(const Ctx& c_) {
    Ctx c = c_; c.lane = (int)__builtin_amdgcn_mbcnt_hi(~0u, __builtin_amdgcn_mbcnt_lo(~0u, 0u)); asm volatile("" : "+v"(c.lane)); c.tid = c.wave * 64 + c.lane; asm volatile("" : "+s"(c.bid)); asm volatile("" : "+s"(c.ws));
    if (c.bid >= 64) return;
    const bf16_t* Z = (const bf16_t*)(c.ws + WS_Z); const bf16_t* QKC = (const bf16_t*)(c.ws + WS_QKC); const float* gates = (const float*)(c.ws + WS_GATES); float* HID = (float*)(c.ws + WS_HID);
    const int b = c.bid >> 2, h = c.bid & 3, tid = c.tid, v = tid >> 2, kq = (tid & 3) * 16;
    float C[16], nn[16];
#pragma unroll
    for (int j = 0; j < 16; ++j) { C[j] = 0.f; nn[j] = 0.f; }
    for (int t = 0; t < SEQ; ++t) { const size_t m = (size_t)b * SEQ + t;
        const float ig = gates[m * 8 + h], lf = gates[m * 8 + 4 + h]; const float f = __expf(lf), ii = __expf(ig), iv = ii * bf2f(Z[m * DINP + ZC_LV + h * 128 + v]);
        const uint4* qp = (const uint4*)(QKC + m * 512 + h * 64 + kq); const uint4* kp = (const uint4*)(QKC + m * 512 + 256 + h * 64 + kq);
        const uint4 q0 = qp[0], q1 = qp[1], k0 = kp[0], k1 = kp[1];
        const unsigned qw[8] = {q0.x, q0.y, q0.z, q0.w, q1.x, q1.y, q1.z, q1.w}, kw[8] = {k0.x, k0.y, k0.z, k0.w, k1.x, k1.y, k1.z, k1.w};
        float num = 0.f, den = 0.f;
#pragma unroll
        for (int j = 0; j < 8; ++j) { const float ka = __uint_as_float(kw[j] << 16), kb = __uint_as_float(kw[j] & 0xffff0000u), qa = __uint_as_float(qw[j] << 16), qb = __uint_as_float(qw[j] & 0xffff0000u);
            C[2 * j] = f * C[2 * j] + iv * ka; C[2 * j + 1] = f * C[2 * j + 1] + iv * kb; nn[2 * j] = f * nn[2 * j] + ii * ka; nn[2 * j + 1] = f * nn[2 * j + 1] + ii * kb;
            num += C[2 * j] * qa + C[2 * j + 1] * qb; den += nn[2 * j] * qa + nn[2 * j + 1] * qb; }
        num += __shfl_xor(num, 1); num += __shfl_xor(num, 2); den += __shfl_xor(den, 1); den += __shfl_xor(den, 2);
        if ((tid & 3) == 0) HID[m * 512 + h * 128 + v] = num / fmaxf(fabsf(den), 1.f);
    }
}
__device__ __forceinline__ void nv_ml_post(const Ctx& c_, int L) {
    Ctx c = c_; c.lane = (int)__builtin_amdgcn_mbcnt_hi(~0u, __builtin_amdgcn_mbcnt_lo(~0u, 0u)); asm volatile("" : "+v"(c.lane)); c.tid = c.wave * 64 + c.lane; asm volatile("" : "+s"(c.bid)); asm volatile("" : "+s"(c.ws));
    const bf16_t* Z = (const bf16_t*)(c.ws + WS_Z); const float* HID = (const float*)(c.ws + WS_HID); bf16_t* Y = (bf16_t*)(c.ws + WS_Y); const float* hg = c.head_g + (size_t)L * DM;
    float* part = (float*)(c.lds + 65536); const int tid = c.tid, w = c.wave;
    for (int m = c.bid; m < MTOK; m += c.nb) {
        const float x = HID[(size_t)m * 512 + tid]; const float s = wave_sum(x * x);
        if ((tid & 63) == 0) part[w] = s;
        __syncthreads();
        const float ss = part[(w & ~1)] + part[(w | 1)];
        const float lo = bf2f(Z[(size_t)m * DINP + ZC_LO + tid]);
        Y[(size_t)m * DM + 256 + tid] = f2bf(x * rsqrtf(ss * (1.f / 128.f) + EPS) * hg[256 + tid] * sigmoidf_(lo));
        __syncthreads();
    }
}

typedef float f32x16 __attribute__((ext_vector_type(16)));
typedef short bf16x8v __attribute__((ext_vector_type(8)));
typedef short s16x4v __attribute__((ext_vector_type(4)));
typedef unsigned u32x4v __attribute__((ext_vector_type(4)));
constexpr int AT_KROW = 144, AT_VROW = 192;
constexpr int AT_KTILE = 64 * AT_KROW, AT_VTILE = 64 * AT_VROW;
constexpr int AT_K0 = 0, AT_V0 = 2 * AT_KTILE, AT_MISC = AT_V0 + 2 * AT_VTILE;
constexpr float AT_C = 0.125f * 1.4426950408889634f;

__device__ __forceinline__ int crow16(int r, int hi) { return (r & 3) + 8 * (r >> 2) + 4 * hi; }
__device__ __forceinline__ unsigned cvtpk(float lo, float hi) { unsigned r; asm("v_cvt_pk_bf16_f32 %0, %1, %2" : "=v"(r) : "v"(lo), "v"(hi)); return r; }
__device__ __forceinline__ float xhalf_max(float v) { auto rr = __builtin_amdgcn_permlane32_swap(__float_as_uint(v), __float_as_uint(v), false, false); return fmaxf(__uint_as_float(rr[0]), __uint_as_float(rr[1])); }
__device__ __forceinline__ float xhalf_sum(float v) { auto rr = __builtin_amdgcn_permlane32_swap(__float_as_uint(v), __float_as_uint(v), false, false); return __uint_as_float(rr[0]) + __uint_as_float(rr[1]); }

struct AttnSt { f32x16 o0, o1; float m, l; };
__device__ __forceinline__ void attn_init(AttnSt& s) { s.o0 = (f32x16){}; s.o1 = (f32x16){}; s.m = -1e30f; s.l = 0.f; }

template <int BOUNDS  >
__device__ __forceinline__ void attn_tile(AttnSt& st, const bf16x8v (&qf)[4], const LAS unsigned char* Kt, const LAS unsigned char* Vt, int r32, int hi, int lane, bool rowsel, int kbase, int klo, int khi) {
    asm volatile("" : "+v"(r32), "+v"(hi), "+v"(lane));
    f32x16 p0 = (f32x16){}, p1 = (f32x16){};
    const LAS unsigned char* kp = Kt + r32 * AT_KROW + hi * 16;
#pragma unroll
    for (int d0 = 0; d0 < 4; ++d0) {
        const bf16x8v k0 = *(const LAS bf16x8v*)(kp + d0 * 32);
        const bf16x8v k1 = *(const LAS bf16x8v*)(kp + 32 * AT_KROW + d0 * 32);
        p0 = __builtin_amdgcn_mfma_f32_32x32x16_bf16(k0, qf[d0], p0, 0, 0, 0);
        p1 = __builtin_amdgcn_mfma_f32_32x32x16_bf16(k1, qf[d0], p1, 0, 0, 0);
    }
    if (BOUNDS) {
        const int hi_c = khi - kbase - 4 * hi, lo_c = klo - kbase - 4 * hi;
#pragma unroll
        for (int r = 0; r < 16; ++r) { const int cr = (r & 3) + 8 * (r >> 2);
            if (BOUNDS == 2) { if (cr > hi_c || cr < lo_c) p0[r] = -INFINITY; if (cr + 32 > hi_c || cr + 32 < lo_c) p1[r] = -INFINITY; }
            else { if (cr > hi_c) p0[r] = -INFINITY; if (cr + 32 > hi_c) p1[r] = -INFINITY; } }
    }
    float mx = fmaxf(p0[0], p1[0]);
#pragma unroll
    for (int r = 1; r < 16; ++r) mx = fmaxf(mx, fmaxf(p0[r], p1[r]));
    mx = xhalf_max(mx);
    if (!rowsel) mx = -INFINITY;
    const float mnew = fmaxf(st.m, mx);
    const float alpha = __builtin_amdgcn_exp2f((st.m - mnew) * AT_C);
    const float sub = rowsel ? mnew * AT_C : 1e30f;
    float ps = 0.f;
#pragma unroll
    for (int r = 0; r < 16; ++r) { p0[r] = __builtin_amdgcn_exp2f(__builtin_fmaf(p0[r], AT_C, -sub)); p1[r] = __builtin_amdgcn_exp2f(__builtin_fmaf(p1[r], AT_C, -sub)); ps += p0[r] + p1[r]; }
    st.l = st.l * alpha + ps; st.m = mnew;
#pragma unroll
    for (int r = 0; r < 16; ++r) { st.o0[r] *= alpha; st.o1[r] *= alpha; }
    bf16x8v pf[4];
    { u32x4v w;
      w = (u32x4v){cvtpk(p0[0], p0[1]), cvtpk(p0[2], p0[3]), cvtpk(p0[4], p0[5]), cvtpk(p0[6], p0[7])}; pf[0] = __builtin_bit_cast(bf16x8v, w);
      w = (u32x4v){cvtpk(p0[8], p0[9]), cvtpk(p0[10], p0[11]), cvtpk(p0[12], p0[13]), cvtpk(p0[14], p0[15])}; pf[1] = __builtin_bit_cast(bf16x8v, w);
      w = (u32x4v){cvtpk(p1[0], p1[1]), cvtpk(p1[2], p1[3]), cvtpk(p1[4], p1[5]), cvtpk(p1[6], p1[7])}; pf[2] = __builtin_bit_cast(bf16x8v, w);
      w = (u32x4v){cvtpk(p1[8], p1[9]), cvtpk(p1[10], p1[11]), cvtpk(p1[12], p1[13]), cvtpk(p1[14], p1[15])}; pf[3] = __builtin_bit_cast(bf16x8v, w); }
    const int li = lane & 15, g = lane >> 4;
    const LAS unsigned char* vp = Vt + (4 * (g >> 1) + (li >> 2)) * AT_VROW + (16 * (g & 1) + 4 * (li & 3)) * 2;
#pragma unroll
    for (int ks = 0; ks < 4; ++ks) {
#pragma unroll
        for (int dh = 0; dh < 2; ++dh) {
            const s16x4v a = __builtin_bit_cast(s16x4v, __builtin_amdgcn_ds_read_tr16_b64_v4i16((LAS s16x4v*)(vp + (16 * ks) * AT_VROW + dh * 64)));
            const s16x4v b = __builtin_bit_cast(s16x4v, __builtin_amdgcn_ds_read_tr16_b64_v4i16((LAS s16x4v*)(vp + (16 * ks + 8) * AT_VROW + dh * 64)));
            const bf16x8v vf = (bf16x8v){a[0], a[1], a[2], a[3], b[0], b[1], b[2], b[3]};
            if (dh == 0) st.o0 = __builtin_amdgcn_mfma_f32_32x32x16_bf16(vf, pf[ks], st.o0, 0, 0, 0);
            else         st.o1 = __builtin_amdgcn_mfma_f32_32x32x16_bf16(vf, pf[ks], st.o1, 0, 0, 0);
        }
    }
}

struct KVRegs { u32x4v k, v; };
__device__ __forceinline__ void kv_load(KVRegs& r, const bf16_t* Kg, const bf16_t* Vg, size_t pitch, int tid) {
    const size_t off = (size_t)(tid >> 3) * pitch + (tid & 7) * 8;
    r.k = *(const u32x4v*)(Kg + off); r.v = *(const u32x4v*)(Vg + off);
}
__device__ __forceinline__ void kv_store(const KVRegs& r, LAS unsigned char* Kt, LAS unsigned char* Vt, int tid) {
    *(LAS u32x4v*)(Kt + (tid >> 3) * AT_KROW + (tid & 7) * 16) = r.k;
    *(LAS u32x4v*)(Vt + (tid >> 3) * AT_VROW + (tid & 7) * 16) = r.v;
}

__device__ __forceinline__ void attn_store_headnorm(const f32x16& o0, const f32x16& o1, bf16_t* Yrow  , const float* g  , int hi) {
    float ss = 0.f;
#pragma unroll
    for (int r = 0; r < 16; ++r) ss += o0[r] * o0[r] + o1[r] * o1[r];
    ss = xhalf_sum(ss);
    const float rn = rsqrtf(ss * (1.f / 64.f) + EPS);
#pragma unroll
    for (int dh = 0; dh < 2; ++dh)
#pragma unroll
        for (int q4 = 0; q4 < 4; ++q4) { const int d = 32 * dh + 8 * q4 + 4 * hi; const float4 gg = *(const float4*)(g + d);
            const f32x16& o = dh ? o1 : o0;
            uint2 w; w.x = cvtpk(o[4 * q4] * rn * gg.x, o[4 * q4 + 1] * rn * gg.y); w.y = cvtpk(o[4 * q4 + 2] * rn * gg.z, o[4 * q4 + 3] * rn * gg.w);
            *(uint2*)(Yrow + d) = w; }
}

__device__ __forceinline__ void moba_unit(const Ctx& c, int L, int b, int h, int qb) {
    const bf16_t* Z = (const bf16_t*)(c.ws + WS_Z); bf16_t* Y = (bf16_t*)(c.ws + WS_Y);
    LAS unsigned char* lds = (LAS unsigned char*)c.lds;
    const int tid = c.tid, lane = c.lane, wave = c.wave, r32 = lane & 31, hi = lane >> 5;
    LAS float* km = (LAS float*)(lds + AT_MISC);
    { const float* kmg = (const float*)(c.ws + WS_KMEAN) + (size_t)(b * 4 + h) * 512; km[tid] = kmg[tid]; }
    const size_t rowq = (size_t)b * SEQ + 256 * qb + 32 * wave + r32;
    bf16x8v qf[4];
#pragma unroll
    for (int d0 = 0; d0 < 4; ++d0) qf[d0] = *(const bf16x8v*)(Z + rowq * DINP + ZC_MQ + h * 64 + 16 * d0 + 8 * hi);
    const bf16_t* Kg = Z + (size_t)b * SEQ * DINP + ZC_MK + h * 64; const bf16_t* Vg = Z + (size_t)b * SEQ * DINP + ZC_MV + h * 64;
    const int NT = 4 * (qb + 1);
    KVRegs kv; kv_load(kv, Kg, Vg, DINP, tid);
    __syncthreads();
    unsigned selbits;
    if (qb <= 3) selbits = (1u << qb) - 1u;
    else {
        float gt[7];
#pragma unroll
        for (int n = 0; n < 7; ++n) { float a = 0.f;
            if (n < qb) {
#pragma unroll
                for (int d0 = 0; d0 < 4; ++d0)
#pragma unroll
                    for (int j = 0; j < 8; ++j) a += bf2f((bf16_t)qf[d0][j]) * km[n * 64 + 16 * d0 + 8 * hi + j];
            }
            gt[n] = xhalf_sum(a); }
        selbits = 0u;
#pragma unroll
        for (int k = 0; k < 3; ++k) { int best = -1; float bv = -INFINITY;
#pragma unroll
            for (int n = 0; n < 7; ++n) if (n < qb && !((selbits >> n) & 1u) && gt[n] > bv) { bv = gt[n]; best = n; }
            if (best < 0) {
#pragma unroll
                for (int n = 6; n >= 0; --n) if (n < qb && !((selbits >> n) & 1u)) best = n; }
            selbits |= 1u << best; }
    }
    kv_store(kv, lds + AT_K0, lds + AT_V0, tid);
    __syncthreads();
    AttnSt st; attn_init(st);
    const int qrel = 32 * wave + r32;
    for (int ti = 0; ti < NT; ++ti) {
        const int buf = ti & 1;
        if (ti + 1 < NT) kv_load(kv, Kg + (size_t)(ti + 1) * 64 * DINP, Vg + (size_t)(ti + 1) * 64 * DINP, DINP, tid);
        const LAS unsigned char* Kt = lds + AT_K0 + buf * AT_KTILE; const LAS unsigned char* Vt = lds + AT_V0 + buf * AT_VTILE;
        const int j = ti >> 2;
        if (j < qb) attn_tile<0>(st, qf, Kt, Vt, r32, hi, lane, ((selbits >> j) & 1u) != 0u, 0, 0, 0);
        else { const int k0 = (ti & 3) * 64;
            if (k0 <= 32 * wave + 31) {
                if (k0 + 63 <= 32 * wave) attn_tile<0>(st, qf, Kt, Vt, r32, hi, lane, true, 0, 0, 0);
                else attn_tile<1>(st, qf, Kt, Vt, r32, hi, lane, true, k0, 0, qrel);
            } }
        if (ti + 1 < NT) kv_store(kv, lds + AT_K0 + (buf ^ 1) * AT_KTILE, lds + AT_V0 + (buf ^ 1) * AT_VTILE, tid);
        __syncthreads();
    }
    const float lt = xhalf_sum(st.l); const float inv = 1.f / lt;
#pragma unroll
    for (int r = 0; r < 16; ++r) { st.o0[r] *= inv; st.o1[r] *= inv; }
    attn_store_headnorm(st.o0, st.o1, Y + rowq * DM + h * 64, c.head_g + (size_t)L * DM + h * 64, hi);
}
__device__ __forceinline__ void ph_moba(const Ctx& c_, int L) {
    Ctx c = c_; c.lane = (int)__builtin_amdgcn_mbcnt_hi(~0u, __builtin_amdgcn_mbcnt_lo(~0u, 0u)); asm volatile("" : "+v"(c.lane)); c.tid = c.wave * 64 + c.lane; asm volatile("" : "+s"(c.bid)); asm volatile("" : "+s"(c.ws));
    for (int pi = c.bid; pi < 256; pi += c.nb) {
        const int bh = pi >> 2, s = pi & 3;
        moba_unit(c, L, bh >> 2, bh & 3, s);
        moba_unit(c, L, bh >> 2, bh & 3, 7 - s);
    }
}

constexpr size_t WS_KCB = 29 * MiB + 512 * 1024, WS_VCB = 29 * MiB + 768 * 1024;

__device__ __forceinline__ void ph_wconv_cmp(const Ctx& c_, int L) {
    Ctx c = c_; c.lane = (int)__builtin_amdgcn_mbcnt_hi(~0u, __builtin_amdgcn_mbcnt_lo(~0u, 0u)); asm volatile("" : "+v"(c.lane)); c.tid = c.wave * 64 + c.lane; asm volatile("" : "+s"(c.bid)); asm volatile("" : "+s"(c.ws));
    const int half = c.tid >> 8, t256 = c.tid & 255; float* tile = (float*)(c.lds) + half * (64 * 65);
    constexpr int T_1 = (2048 / 64) * (256 / 64), T_2 = (256 / 64) * 1, TOT = 2 * (T_1 + T_2);
    for (int base = c.bid * 2; base < TOT; base += c.nb * 2) {
        int it = base + half; const bool act = it < TOT; if (!act) it = 0;
        const int kv = it / (T_1 + T_2); it -= kv * (T_1 + T_2);
        const float* src; bf16_t* dst; int K, N;
        if (it < T_1) { src = c.cmp_w1 + ((size_t)L * 2 + kv) * 2048 * 256; dst = (bf16_t*)(c.ws + WS_CW1) + (size_t)kv * 256 * 2048; K = 2048; N = 256; }
        else { it -= T_1; src = c.cmp_w2 + ((size_t)L * 2 + kv) * 256 * 64; dst = (bf16_t*)(c.ws + WS_CW2) + (size_t)kv * 64 * 256; K = 256; N = 64; }
        wconv_tile(src, dst, K, N, N, it, t256, tile, act);
    }
    if (c.bid == c.nb - 1) {
        const int kv = c.tid >> 8, j = c.tid & 255; const float* pe = c.cmp_pe + ((size_t)L * 2 + kv) * 2048; const float* w = c.cmp_w1 + ((size_t)L * 2 + kv) * 2048 * 256 + j;
        float a = 0.f;
        for (int i = 0; i < 2048; ++i) a += pe[i] * w[(size_t)i * 256];
        ((float*)(c.ws + WS_CPE))[kv * 256 + j] = a;
    }
}

__device__ __forceinline__ void ph_cmp(const Ctx& c_, int L) {
    Ctx c = c_; c.lane = (int)__builtin_amdgcn_mbcnt_hi(~0u, __builtin_amdgcn_mbcnt_lo(~0u, 0u)); asm volatile("" : "+v"(c.lane)); c.tid = c.wave * 64 + c.lane; asm volatile("" : "+s"(c.bid)); asm volatile("" : "+s"(c.ws));
    const bf16_t* Z = (const bf16_t*)(c.ws + WS_Z); const bf16_t* W1t = (const bf16_t*)(c.ws + WS_CW1); const bf16_t* W2t = (const bf16_t*)(c.ws + WS_CW2); const float* cpe = (const float*)(c.ws + WS_CPE);
    LAS unsigned char* lds = (LAS unsigned char*)c.lds;
    const int lane = c.lane, w = c.wave, r32 = lane & 31, hi = lane >> 5;
    constexpr int HROW = 528;
    for (int item = c.bid; item < 128; item += c.nb) {
        const int b = item >> 3, kv = (item >> 2) & 1, mt = item & 3; const int col = kv ? ZC_VC : ZC_KC;
        const int n = 32 * mt + r32, nld = n < 127 ? n : 126;
        const bf16_t* arow = Z + ((size_t)b * SEQ + 16 * nld) * DINP + col + 8 * hi;
        const bf16_t* brow = W1t + ((size_t)kv * 256 + 32 * w + r32) * 2048 + 8 * hi;
        f32x16 acc = (f32x16){};
#pragma unroll 8
        for (int ks = 0; ks < 128; ++ks) {
            const bf16x8v a = *(const bf16x8v*)(arow + (size_t)(ks >> 2) * DINP + 16 * (ks & 3));
            const bf16x8v bb = *(const bf16x8v*)(brow + 16 * ks);
            acc = __builtin_amdgcn_mfma_f32_32x32x16_bf16(a, bb, acc, 0, 0, 0);
        }
        const float bias = cpe[kv * 256 + 32 * w + r32];
#pragma unroll
        for (int r = 0; r < 16; ++r) *(LAS bf16_t*)(lds + crow16(r, hi) * HROW + (32 * w + r32) * 2) = f2bf(gelu_tanh(acc[r] + bias));
        __syncthreads();
        if (w < 2) {
            f32x16 acc2 = (f32x16){};
            const bf16_t* b2 = W2t + ((size_t)kv * 64 + 32 * w + r32) * 256 + 8 * hi;
#pragma unroll
            for (int ks = 0; ks < 16; ++ks) {
                const bf16x8v a = *(const LAS bf16x8v*)(lds + r32 * HROW + (16 * ks + 8 * hi) * 2);
                const bf16x8v bb = *(const bf16x8v*)(b2 + 16 * ks);
                acc2 = __builtin_amdgcn_mfma_f32_32x32x16_bf16(a, bb, acc2, 0, 0, 0);
            }
            bf16_t* dst = (bf16_t*)(c.ws + (kv ? WS_VCB : WS_KCB)) + ((size_t)b * 128 + 32 * mt) * 64 + 32 * w + r32;
#pragma unroll
            for (int r = 0; r < 16; ++r) { const int nn = crow16(r, hi); dst[nn * 64] = (32 * mt + nn < 127) ? f2bf(acc2[r]) : (bf16_t)0; }
        }
        __syncthreads();
    }
}

constexpr int NS_A = AT_MISC, NS_B = NS_A + 4 * 64 * 33 * 4, NS_SEL = NS_B + 4 * 64 * 33 * 4;
static_assert(NS_SEL + 256 <= 131072, "NSA LDS map");

__device__ __forceinline__ void nsa_unit(const Ctx& c, int L, int b, int ch) {
    const bf16_t* Z = (const bf16_t*)(c.ws + WS_Z); bf16_t* Y = (bf16_t*)(c.ws + WS_Y);
    LAS unsigned char* lds = (LAS unsigned char*)c.lds;
    const int tid = c.tid, lane = c.lane, wave = c.wave, r32 = lane & 31, hi = lane >> 5, head = wave >> 1, tq = 32 * (wave & 1) + r32, t = 64 * ch + tq;
    const size_t rowq = (size_t)b * SEQ + t;
    bf16x8v qf[4];
#pragma unroll
    for (int d0 = 0; d0 < 4; ++d0) qf[d0] = *(const bf16x8v*)(Z + rowq * DINP + ZC_NQ + head * 64 + 16 * d0 + 8 * hi);
    const float g0 = sigmoidf_(bf2f(Z[rowq * DINP + ZC_NG + head * 3 + 0])), g1 = sigmoidf_(bf2f(Z[rowq * DINP + ZC_NG + head * 3 + 1])), g2 = sigmoidf_(bf2f(Z[rowq * DINP + ZC_NG + head * 3 + 2]));
    const bool two = ch >= 16;
    { const bf16_t* KC = (const bf16_t*)(c.ws + WS_KCB) + (size_t)b * 128 * 64; const bf16_t* VC = (const bf16_t*)(c.ws + WS_VCB) + (size_t)b * 128 * 64;
      KVRegs kv; kv_load(kv, KC, VC, 64, tid); kv_store(kv, lds + AT_K0, lds + AT_V0, tid);
      if (two) { kv_load(kv, KC + 64 * 64, VC + 64 * 64, 64, tid); kv_store(kv, lds + AT_K0 + AT_KTILE, lds + AT_V0 + AT_VTILE, tid); } }
    __syncthreads();
    f32x16 acc0, acc1;
    {
        const int nvis = t >= 31 ? (t - 31) / 16 + 1 : 0;
        f32x16 p[4];
#pragma unroll
        for (int i = 0; i < 4; ++i) p[i] = (f32x16){};
        { const LAS unsigned char* kp = lds + AT_K0 + r32 * AT_KROW + hi * 16;
#pragma unroll
          for (int d0 = 0; d0 < 4; ++d0) {
              p[0] = __builtin_amdgcn_mfma_f32_32x32x16_bf16(*(const LAS bf16x8v*)(kp + d0 * 32), qf[d0], p[0], 0, 0, 0);
              p[1] = __builtin_amdgcn_mfma_f32_32x32x16_bf16(*(const LAS bf16x8v*)(kp + 32 * AT_KROW + d0 * 32), qf[d0], p[1], 0, 0, 0); }
          if (two) {
#pragma unroll
              for (int d0 = 0; d0 < 4; ++d0) {
                  p[2] = __builtin_amdgcn_mfma_f32_32x32x16_bf16(*(const LAS bf16x8v*)(kp + AT_KTILE + d0 * 32), qf[d0], p[2], 0, 0, 0);
                  p[3] = __builtin_amdgcn_mfma_f32_32x32x16_bf16(*(const LAS bf16x8v*)(kp + AT_KTILE + 32 * AT_KROW + d0 * 32), qf[d0], p[3], 0, 0, 0); } } }
        float mx = -INFINITY; const int nlim = nvis - 4 * hi;
#pragma unroll
        for (int i = 0; i < 4; ++i)
#pragma unroll
            for (int r = 0; r < 16; ++r) { if (32 * i + (r & 3) + 8 * (r >> 2) >= nlim || (i >= 2 && !two)) p[i][r] = -INFINITY; mx = fmaxf(mx, p[i][r]); }
        mx = xhalf_max(mx);
        const float msub = nvis > 0 ? mx * AT_C : 0.f; float ps = 0.f;
#pragma unroll
        for (int i = 0; i < 4; ++i)
#pragma unroll
            for (int r = 0; r < 16; ++r) { p[i][r] = __builtin_amdgcn_exp2f(__builtin_fmaf(p[i][r], AT_C, -msub)); ps += p[i][r]; }
        ps = xhalf_sum(ps);
        const float inv = nvis > 0 ? 1.f / ps : 0.f;
        LAS float* Ab = (LAS float*)(lds + NS_A) + (head * 64 + tq) * 33; LAS float* Bb = (LAS float*)(lds + NS_B) + (head * 64 + tq) * 33;
#pragma unroll
        for (int i = 0; i < 4; ++i) {
#pragma unroll
            for (int r = 0; r < 16; ++r) p[i][r] *= inv;
#pragma unroll
            for (int g = 0; g < 4; ++g) { const int j = 8 * i + 2 * g + hi; const float hb = 0.5f * p[i][4 * g + 3];
                Ab[j] = p[i][4 * g] + p[i][4 * g + 1] + p[i][4 * g + 2] + hb; Bb[j] = hb; }
        }
        acc0 = (f32x16){}; acc1 = (f32x16){};
        const int li = lane & 15, g16 = lane >> 4;
        const LAS unsigned char* vp = lds + AT_V0 + (4 * (g16 >> 1) + (li >> 2)) * AT_VROW + (16 * (g16 & 1) + 4 * (li & 3)) * 2;
#pragma unroll
        for (int i = 0; i < 4; ++i) {
            if (i >= 2 && !two) break;
#pragma unroll
            for (int s = 0; s < 2; ++s) {
                const u32x4v wv = (u32x4v){cvtpk(p[i][8 * s], p[i][8 * s + 1]), cvtpk(p[i][8 * s + 2], p[i][8 * s + 3]), cvtpk(p[i][8 * s + 4], p[i][8 * s + 5]), cvtpk(p[i][8 * s + 6], p[i][8 * s + 7])};
                const bf16x8v pf = __builtin_bit_cast(bf16x8v, wv);
                const LAS unsigned char* vq = vp + (i >> 1) * AT_VTILE + (32 * (i & 1) + 16 * s) * AT_VROW;
#pragma unroll
                for (int dh = 0; dh < 2; ++dh) {
                    const s16x4v a = __builtin_bit_cast(s16x4v, __builtin_amdgcn_ds_read_tr16_b64_v4i16((LAS s16x4v*)(vq + dh * 64)));
                    const s16x4v bq = __builtin_bit_cast(s16x4v, __builtin_amdgcn_ds_read_tr16_b64_v4i16((LAS s16x4v*)(vq + 8 * AT_VROW + dh * 64)));
                    const bf16x8v vf = (bf16x8v){a[0], a[1], a[2], a[3], bq[0], bq[1], bq[2], bq[3]};
                    if (dh == 0) acc0 = __builtin_amdgcn_mfma_f32_32x32x16_bf16(vf, pf, acc0, 0, 0, 0);
                    else         acc1 = __builtin_amdgcn_mfma_f32_32x32x16_bf16(vf, pf, acc1, 0, 0, 0);
                }
            }
        }
#pragma unroll
        for (int r = 0; r < 16; ++r) { acc0[r] *= g0; acc1[r] *= g0; }
    }
    __syncthreads();
    if (tid < 64) {
        unsigned mask;
        if (ch <= 7) mask = (2u << ch) - 1u;
        else {
            LAS float* A0 = (LAS float*)(lds + NS_A) + tid * 33;
            for (int j = 1; j <= ch - 2; ++j) { float s = 0.f;
#pragma unroll
                for (int h = 0; h < 4; ++h) s += ((LAS float*)(lds + NS_A))[(h * 64 + tid) * 33 + j] + ((LAS float*)(lds + NS_B))[(h * 64 + tid) * 33 + j - 1];
                A0[j] = s; }
            mask = 1u | (1u << ch) | (1u << (ch - 1));
            for (int k = 0; k < 5; ++k) { int best = -1; float bv = -INFINITY;
                for (int j = 1; j <= ch - 2; ++j) { const float v = A0[j]; if (!((mask >> j) & 1u) && v > bv) { bv = v; best = j; } }
                if (best < 0) { for (int j = ch - 2; j >= 1; --j) if (!((mask >> j) & 1u)) best = j; }
                mask |= 1u << best; }
        }
        ((LAS unsigned*)(lds + NS_SEL))[tid] = mask;
    }
    __syncthreads();
    const unsigned selbits = ((LAS unsigned*)(lds + NS_SEL))[tq];
    const int wl = ch >= 8 ? ch - 8 : 0, nsel = ch + 1, ntot = nsel + (ch - wl + 1);
    const bf16_t* Zb = Z + (size_t)b * SEQ * DINP;
    KVRegs kv; kv_load(kv, Zb + ZC_KSL, Zb + ZC_VSL, DINP, tid); kv_store(kv, lds + AT_K0, lds + AT_V0, tid);
    __syncthreads();
    AttnSt st; attn_init(st);
    for (int s = 0; s < ntot; ++s) {
        const int buf = s & 1;
        if (s + 1 < ntot) { const int s1 = s + 1; const bool w1 = s1 >= nsel; const int j1 = w1 ? wl + (s1 - nsel) : s1;
            kv_load(kv, Zb + (size_t)j1 * 64 * DINP + (w1 ? ZC_KWN : ZC_KSL), Zb + (size_t)j1 * 64 * DINP + (w1 ? ZC_VWN : ZC_VSL), DINP, tid); }
        const LAS unsigned char* Kt = lds + AT_K0 + buf * AT_KTILE; const LAS unsigned char* Vt = lds + AT_V0 + buf * AT_VTILE;
        if (s == nsel) {
            const float inv = g1 / xhalf_sum(st.l);
#pragma unroll
            for (int r = 0; r < 16; ++r) { acc0[r] += st.o0[r] * inv; acc1[r] += st.o1[r] * inv; }
            attn_init(st);
        }
        if (s < nsel) { const int j = s;
            if (j == ch) attn_tile<1>(st, qf, Kt, Vt, r32, hi, lane, true, 64 * ch, 0, t);
            else attn_tile<0>(st, qf, Kt, Vt, r32, hi, lane, ((selbits >> j) & 1u) != 0u, 0, 0, 0);
        } else { const int j = wl + (s - nsel);
            if (j == ch) attn_tile<1>(st, qf, Kt, Vt, r32, hi, lane, true, 64 * ch, 0, t);
            else if (ch >= 8 && j == ch - 8) attn_tile<2>(st, qf, Kt, Vt, r32, hi, lane, true, 64 * j, t - 511, t);
            else attn_tile<0>(st, qf, Kt, Vt, r32, hi, lane, true, 0, 0, 0);
        }
        if (s + 1 < ntot) kv_store(kv, lds + AT_K0 + (buf ^ 1) * AT_KTILE, lds + AT_V0 + (buf ^ 1) * AT_VTILE, tid);
        __syncthreads();
    }
    { const float inv = g2 / xhalf_sum(st.l);
#pragma unroll
      for (int r = 0; r < 16; ++r) { acc0[r] += st.o0[r] * inv; acc1[r] += st.o1[r] * inv; } }
    attn_store_headnorm(acc0, acc1, Y + rowq * DM + 768 + head * 64, c.head_g + (size_t)L * DM + 768 + head * 64, hi);
}
__device__ __forceinline__ void ph_nsa(const Ctx& c_, int L) {
    Ctx c = c_; c.lane = (int)__builtin_amdgcn_mbcnt_hi(~0u, __builtin_amdgcn_mbcnt_lo(~0u, 0u)); asm volatile("" : "+v"(c.lane)); c.tid = c.wave * 64 + c.lane; asm volatile("" : "+s"(c.bid)); asm volatile("" : "+s"(c.ws));
    for (int pi = c.bid; pi < 256; pi += c.nb) {
        const int b = pi >> 4, s = pi & 15;
        nsa_unit(c, L, b, 31 - s);
        nsa_unit(c, L, b, s);
    }
}

constexpr size_t WS_SCAL = 29 * MiB;
constexpr size_t WS_NCH = 31 * MiB, WS_NPREV = 31 * MiB + 512 * 1024;
constexpr int ML_KROW = 192;
constexpr int ML_VROW = 320;
constexpr int ML_K = 0, ML_V = 64 * 192, ML_E = ML_V + 64 * ML_VROW, ML_MISC = ML_E + 1024;

__device__ __forceinline__ void ph_ml_chunk(const Ctx& c_, int L) {
    Ctx c = c_; c.lane = (int)__builtin_amdgcn_mbcnt_hi(~0u, __builtin_amdgcn_mbcnt_lo(~0u, 0u)); asm volatile("" : "+v"(c.lane)); c.tid = c.wave * 64 + c.lane; asm volatile("" : "+s"(c.bid)); asm volatile("" : "+s"(c.ws));
    const bf16_t* Z = (const bf16_t*)(c.ws + WS_Z); bf16_t* QKC = (bf16_t*)(c.ws + WS_QKC); float* gates = (float*)(c.ws + WS_GATES);
    float* scal = (float*)(c.ws + WS_SCAL); float* nch = (float*)(c.ws + WS_NCH); bf16_t* CC = (bf16_t*)(c.ws + WS_CC);
    const float* cw = c.conv_w + (size_t)L * 4 * 512; const float* cb = c.conv_b + (size_t)L * 512; const float* gb = c.gate_b + (size_t)L * 8;
    LAS unsigned char* lds = (LAS unsigned char*)c.lds;
    const int tid = c.tid, lane = c.lane, wave = c.wave, r32 = lane & 31, hi = lane >> 5;
    for (int item = c.bid; item < 2048; item += c.nb) {
        const int bh = item >> 5, ch = item & 31, b = bh >> 2, h = bh & 3;
        const size_t row0 = (size_t)b * SEQ + 64 * ch;
        { const int s = tid >> 3, c8 = 8 * (tid & 7), t = 64 * ch + s;
          float aq[8], ak[8];
#pragma unroll
          for (int i = 0; i < 8; ++i) { aq[i] = cb[64 * h + c8 + i]; ak[i] = cb[256 + 64 * h + c8 + i]; }
#pragma unroll
          for (int j = 0; j < 4; ++j) { if (t - 3 + j >= 0) {
              const bf16_t* zr = Z + (row0 + s - 3 + j) * DINP;
              const u32x4v xq = *(const u32x4v*)(zr + ZC_LQ + 64 * h + c8), xk = *(const u32x4v*)(zr + ZC_LK + 64 * h + c8);
#pragma unroll
              for (int i = 0; i < 4; ++i) {
                  aq[2 * i] += __uint_as_float(xq[i] << 16) * cw[j * 512 + 64 * h + c8 + 2 * i]; aq[2 * i + 1] += __uint_as_float(xq[i] & 0xffff0000u) * cw[j * 512 + 64 * h + c8 + 2 * i + 1];
                  ak[2 * i] += __uint_as_float(xk[i] << 16) * cw[j * 512 + 256 + 64 * h + c8 + 2 * i]; ak[2 * i + 1] += __uint_as_float(xk[i] & 0xffff0000u) * cw[j * 512 + 256 + 64 * h + c8 + 2 * i + 1]; } } }
          u32x4v oq, ok;
#pragma unroll
          for (int i = 0; i < 4; ++i) { const float q0 = aq[2 * i] * sigmoidf_(aq[2 * i]), q1 = aq[2 * i + 1] * sigmoidf_(aq[2 * i + 1]);
              const float k0 = 0.125f * ak[2 * i] * sigmoidf_(ak[2 * i]), k1 = 0.125f * ak[2 * i + 1] * sigmoidf_(ak[2 * i + 1]);
              oq[i] = cvtpk(q0, q1); ok[i] = cvtpk(k0, k1); }
          *(u32x4v*)(QKC + (row0 + s) * 512 + 64 * h + c8) = oq; *(u32x4v*)(QKC + (row0 + s) * 512 + 256 + 64 * h + c8) = ok;
          *(LAS u32x4v*)(lds + ML_K + s * ML_KROW + c8 * 2) = ok; }
        if (wave == 0) { const size_t m = row0 + lane;
            const float ig = bf2f(Z[m * DINP + ZC_LI + h]) + gb[h]; const float x = bf2f(Z[m * DINP + ZC_LF + h]) + gb[4 + h];
            float cs = fminf(x, 0.f) - log1pf(__expf(-fabsf(x)));
#pragma unroll
            for (int o = 1; o < 64; o <<= 1) { const float up = __shfl_up(cs, o); if (lane >= o) cs += up; }
            const float bend = __shfl(cs, 63); const float wend = bend - cs + ig; const float aend = wave_max(wend);
            ((LAS float*)(lds + ML_E))[lane] = __expf(wend - aend);
            gates[m * 8 + h] = ig; gates[m * 8 + 4 + h] = cs;
            if (lane == 0) { scal[item] = bend; scal[2048 + item] = aend; } }
        __syncthreads();
        { const int s = tid >> 3, v16 = 16 * (tid & 7); const float e = ((LAS float*)(lds + ML_E))[s];
          const bf16_t* zr = Z + (row0 + s) * DINP + ZC_LV + 128 * h + v16;
          const u32x4v x0 = *(const u32x4v*)zr, x1 = *(const u32x4v*)(zr + 8); u32x4v o0, o1;
#pragma unroll
          for (int i = 0; i < 4; ++i) { o0[i] = cvtpk(__uint_as_float(x0[i] << 16) * e, __uint_as_float(x0[i] & 0xffff0000u) * e); o1[i] = cvtpk(__uint_as_float(x1[i] << 16) * e, __uint_as_float(x1[i] & 0xffff0000u) * e); }
          *(LAS u32x4v*)(lds + ML_V + s * ML_VROW + v16 * 2) = o0; *(LAS u32x4v*)(lds + ML_V + s * ML_VROW + v16 * 2 + 16) = o1; }
        __syncthreads();
        { const int vt = wave >> 1, kt = wave & 1, li = lane & 15, g16 = lane >> 4;
          const LAS unsigned char* ap = lds + ML_V + (4 * (g16 >> 1) + (li >> 2)) * ML_VROW + (32 * vt + 16 * (g16 & 1) + 4 * (li & 3)) * 2;
          const LAS unsigned char* bp = lds + ML_K + (4 * (g16 >> 1) + (li >> 2)) * ML_KROW + (32 * kt + 16 * (g16 & 1) + 4 * (li & 3)) * 2;
          f32x16 acc = (f32x16){};
#pragma unroll
          for (int ks = 0; ks < 4; ++ks) {
              const s16x4v a0 = __builtin_bit_cast(s16x4v, __builtin_amdgcn_ds_read_tr16_b64_v4i16((LAS s16x4v*)(ap + (16 * ks) * ML_VROW)));
              const s16x4v a1 = __builtin_bit_cast(s16x4v, __builtin_amdgcn_ds_read_tr16_b64_v4i16((LAS s16x4v*)(ap + (16 * ks + 8) * ML_VROW)));
              const s16x4v b0 = __builtin_bit_cast(s16x4v, __builtin_amdgcn_ds_read_tr16_b64_v4i16((LAS s16x4v*)(bp + (16 * ks) * ML_KROW)));
              const s16x4v b1 = __builtin_bit_cast(s16x4v, __builtin_amdgcn_ds_read_tr16_b64_v4i16((LAS s16x4v*)(bp + (16 * ks + 8) * ML_KROW)));
              acc = __builtin_amdgcn_mfma_f32_32x32x16_bf16((bf16x8v){a0[0], a0[1], a0[2], a0[3], a1[0], a1[1], a1[2], a1[3]}, (bf16x8v){b0[0], b0[1], b0[2], b0[3], b1[0], b1[1], b1[2], b1[3]}, acc, 0, 0, 0);
          }
          bf16_t* dst = CC + (size_t)item * 8192 + (size_t)(32 * vt) * 64 + 32 * kt + r32;
#pragma unroll
          for (int r = 0; r < 16; ++r) dst[crow16(r, hi) * 64] = f2bf(acc[r]); }
        if (tid < 64) { float a = 0.f;
            for (int s = 0; s < 64; ++s) a += ((LAS float*)(lds + ML_E))[s] * bf2f(*(LAS bf16_t*)(lds + ML_K + s * ML_KROW + tid * 2));
            nch[(size_t)item * 64 + tid] = a; }
        __syncthreads();
    }
}

__device__ __forceinline__ void ph_ml_scan(const Ctx& c_) {
    Ctx c = c_; c.lane = (int)__builtin_amdgcn_mbcnt_hi(~0u, __builtin_amdgcn_mbcnt_lo(~0u, 0u)); asm volatile("" : "+v"(c.lane)); c.tid = c.wave * 64 + c.lane; asm volatile("" : "+s"(c.bid)); asm volatile("" : "+s"(c.ws));
    const bf16_t* CC = (const bf16_t*)(c.ws + WS_CC); bf16_t* CP = (bf16_t*)(c.ws + WS_CPREV); float* scal = (float*)(c.ws + WS_SCAL);
    const float* nch = (const float*)(c.ws + WS_NCH); float* npv = (float*)(c.ws + WS_NPREV);
    for (int sl = c.bid; sl < 256; sl += c.nb) {
        const int bh = sl >> 2, qt = sl & 3; const size_t e0 = (size_t)qt * 2048 + 4 * c.tid;
        float C0 = 0.f, C1 = 0.f, C2 = 0.f, C3 = 0.f, m = 0.f, nst = 0.f;
        const bool do_n = (qt == 0 && c.tid < 64);
        uint2 nx = *(const uint2*)(CC + (size_t)(bh * 32) * 8192 + e0);
        for (int ch = 0; ch < 32; ++ch) { const int item = bh * 32 + ch;
            const uint2 cur = nx;
            if (ch + 1 < 32) nx = *(const uint2*)(CC + (size_t)(item + 1) * 8192 + e0);
            uint2 o; o.x = cvtpk(C0, C1); o.y = cvtpk(C2, C3);
            *(uint2*)(CP + (size_t)item * 8192 + e0) = o;
            if (do_n) npv[(size_t)item * 64 + c.tid] = nst;
            if (qt == 0 && c.tid == 0) scal[4096 + item] = m;
            const float be = scal[item], ae = scal[2048 + item];
            const float mn = fmaxf(be + m, ae), dec = __expf(be + m - mn), inj = __expf(ae - mn);
            C0 = dec * C0 + inj * __uint_as_float(cur.x << 16); C1 = dec * C1 + inj * __uint_as_float(cur.x & 0xffff0000u);
            C2 = dec * C2 + inj * __uint_as_float(cur.y << 16); C3 = dec * C3 + inj * __uint_as_float(cur.y & 0xffff0000u);
            if (do_n) nst = dec * nst + inj * nch[(size_t)item * 64 + c.tid];
            m = mn; }
    }
}

constexpr int M3_K = 0, M3_V = 64 * AT_KROW, M3_VEC = M3_V + 64 * ML_VROW, M3_SS = M3_VEC + 2048;
__device__ __forceinline__ void ph_ml_out(const Ctx& c_, int L) {
    Ctx c = c_; c.lane = (int)__builtin_amdgcn_mbcnt_hi(~0u, __builtin_amdgcn_mbcnt_lo(~0u, 0u)); asm volatile("" : "+v"(c.lane)); c.tid = c.wave * 64 + c.lane; asm volatile("" : "+s"(c.bid)); asm volatile("" : "+s"(c.ws));
    const bf16_t* Z = (const bf16_t*)(c.ws + WS_Z); const bf16_t* QKC = (const bf16_t*)(c.ws + WS_QKC); const float* gates = (const float*)(c.ws + WS_GATES);
    const float* scal = (const float*)(c.ws + WS_SCAL); const float* npv = (const float*)(c.ws + WS_NPREV); const bf16_t* CP = (const bf16_t*)(c.ws + WS_CPREV); bf16_t* Y = (bf16_t*)(c.ws + WS_Y);
    const float* hg = c.head_g + (size_t)L * DM + 256;
    LAS unsigned char* lds = (LAS unsigned char*)c.lds;
    const int tid = c.tid, lane = c.lane, wave = c.wave, r32 = lane & 31, hi = lane >> 5, th = wave & 1, vq = wave >> 1;
    LAS float* uvec = (LAS float*)(lds + M3_VEC); LAS float* pmv = uvec + 64; LAS float* bcv = uvec + 128; LAS float* npl = uvec + 192; LAS float* ssl = (LAS float*)(lds + M3_SS);
    for (int item = c.bid; item < 2048; item += c.nb) {
        const int bh = item >> 5, ch = item & 31, b = bh >> 2, h = bh & 3;
        const size_t row0 = (size_t)b * SEQ + 64 * ch;
        { const int s = tid >> 3, c8 = 8 * (tid & 7);
          *(LAS u32x4v*)(lds + M3_K + s * AT_KROW + c8 * 2) = *(const u32x4v*)(QKC + (row0 + s) * 512 + 256 + 64 * h + c8);
          const bf16_t* zr = Z + (row0 + s) * DINP + ZC_LV + 128 * h + 2 * c8;
          *(LAS u32x4v*)(lds + M3_V + s * ML_VROW + c8 * 4) = *(const u32x4v*)zr; *(LAS u32x4v*)(lds + M3_V + s * ML_VROW + c8 * 4 + 16) = *(const u32x4v*)(zr + 8); }
        if (wave == 0) { const size_t m = row0 + lane; const float ig = gates[m * 8 + h], bc = gates[m * 8 + 4 + h]; const float u = ig - bc;
            float pm = u;
#pragma unroll
            for (int o = 1; o < 64; o <<= 1) { const float up = __shfl_up(pm, o); if (lane >= o) pm = fmaxf(pm, up); }
            uvec[lane] = u; pmv[lane] = pm; bcv[lane] = bc; npl[lane] = npv[(size_t)item * 64 + lane]; }
        const float mprev = scal[4096 + item];
        const int tl = 32 * th + r32; const size_t mrow = row0 + tl;
        bf16x8v qf[4];
#pragma unroll
        for (int d0 = 0; d0 < 4; ++d0) qf[d0] = *(const bf16x8v*)(QKC + mrow * 512 + 64 * h + 16 * d0 + 8 * hi);
        f32x16 acc2 = (f32x16){};
        { const bf16_t* cp = CP + (size_t)item * 8192 + (size_t)(32 * vq + r32) * 64 + 8 * hi;
#pragma unroll
          for (int d0 = 0; d0 < 4; ++d0) acc2 = __builtin_amdgcn_mfma_f32_32x32x16_bf16(*(const bf16x8v*)(cp + 16 * d0), qf[d0], acc2, 0, 0, 0); }
        __syncthreads();
        f32x16 p0 = (f32x16){}, p1 = (f32x16){};
        { const LAS unsigned char* kp = lds + M3_K + r32 * AT_KROW + hi * 16;
#pragma unroll
          for (int d0 = 0; d0 < 4; ++d0) {
              p0 = __builtin_amdgcn_mfma_f32_32x32x16_bf16(*(const LAS bf16x8v*)(kp + d0 * 32), qf[d0], p0, 0, 0, 0);
              p1 = __builtin_amdgcn_mfma_f32_32x32x16_bf16(*(const LAS bf16x8v*)(kp + 32 * AT_KROW + d0 * 32), qf[d0], p1, 0, 0, 0); } }
        const float bct = bcv[tl], mt = bct + fmaxf(mprev, pmv[tl]);
        const float eb = bct - mt;
        const int tlim = tl - 4 * hi; float dsum = 0.f;
#pragma unroll
        for (int r = 0; r < 16; ++r) { const int cr = (r & 3) + 8 * (r >> 2);
            const float w0 = (cr <= tlim) ? __expf(eb + uvec[cr + 4 * hi]) : 0.f, w1 = (cr + 32 <= tlim) ? __expf(eb + uvec[cr + 32 + 4 * hi]) : 0.f;
            p0[r] *= w0; p1[r] *= w1; dsum += p0[r] + p1[r]; }
        dsum = xhalf_sum(dsum);
        const float winter = __expf(bct + mprev - mt);
        float qn = 0.f;
#pragma unroll
        for (int d0 = 0; d0 < 4; ++d0)
#pragma unroll
            for (int j = 0; j < 8; ++j) qn += bf2f((bf16_t)qf[d0][j]) * npl[16 * d0 + 8 * hi + j];
        qn = xhalf_sum(qn);
        const float den = dsum + winter * qn;
        const float rden = 1.f / fmaxf(fabsf(den), __expf(-mt));
        f32x16 acc1 = (f32x16){};
        { bf16x8v pf[4]; u32x4v w;
          w = (u32x4v){cvtpk(p0[0], p0[1]), cvtpk(p0[2], p0[3]), cvtpk(p0[4], p0[5]), cvtpk(p0[6], p0[7])}; pf[0] = __builtin_bit_cast(bf16x8v, w);
          w = (u32x4v){cvtpk(p0[8], p0[9]), cvtpk(p0[10], p0[11]), cvtpk(p0[12], p0[13]), cvtpk(p0[14], p0[15])}; pf[1] = __builtin_bit_cast(bf16x8v, w);
          w = (u32x4v){cvtpk(p1[0], p1[1]), cvtpk(p1[2], p1[3]), cvtpk(p1[4], p1[5]), cvtpk(p1[6], p1[7])}; pf[2] = __builtin_bit_cast(bf16x8v, w);
          w = (u32x4v){cvtpk(p1[8], p1[9]), cvtpk(p1[10], p1[11]), cvtpk(p1[12], p1[13]), cvtpk(p1[14], p1[15])}; pf[3] = __builtin_bit_cast(bf16x8v, w);
          const int li = lane & 15, g16 = lane >> 4;
          const LAS unsigned char* vp = lds + M3_V + (4 * (g16 >> 1) + (li >> 2)) * ML_VROW + (32 * vq + 16 * (g16 & 1) + 4 * (li & 3)) * 2;
#pragma unroll
          for (int ks = 0; ks < 4; ++ks) {
              const s16x4v a0 = __builtin_bit_cast(s16x4v, __builtin_amdgcn_ds_read_tr16_b64_v4i16((LAS s16x4v*)(vp + (16 * ks) * ML_VROW)));
              const s16x4v a1 = __builtin_bit_cast(s16x4v, __builtin_amdgcn_ds_read_tr16_b64_v4i16((LAS s16x4v*)(vp + (16 * ks + 8) * ML_VROW)));
              acc1 = __builtin_amdgcn_mfma_f32_32x32x16_bf16((bf16x8v){a0[0], a0[1], a0[2], a0[3], a1[0], a1[1], a1[2], a1[3]}, pf[ks], acc1, 0, 0, 0); } }
        float ss = 0.f;
#pragma unroll
        for (int r = 0; r < 16; ++r) { acc1[r] = (acc1[r] + winter * acc2[r]) * rden; ss += acc1[r] * acc1[r]; }
        ss = xhalf_sum(ss);
        if (hi == 0) ssl[vq * 64 + tl] = ss;
        __syncthreads();
        const float sst = ssl[tl] + ssl[64 + tl] + ssl[128 + tl] + ssl[192 + tl];
        const float rn = rsqrtf(sst * (1.f / 128.f) + EPS);
#pragma unroll
        for (int q4 = 0; q4 < 4; ++q4) { const int v = 32 * vq + 8 * q4 + 4 * hi;
            const float4 gg = *(const float4*)(hg + 128 * h + v); const uint2 lo = *(const uint2*)(Z + mrow * DINP + ZC_LO + 128 * h + v);
            const float y0 = acc1[4 * q4] * rn * gg.x * sigmoidf_(__uint_as_float(lo.x << 16)), y1 = acc1[4 * q4 + 1] * rn * gg.y * sigmoidf_(__uint_as_float(lo.x & 0xffff0000u));
            const float y2 = acc1[4 * q4 + 2] * rn * gg.z * sigmoidf_(__uint_as_float(lo.y << 16)), y3 = acc1[4 * q4 + 3] * rn * gg.w * sigmoidf_(__uint_as_float(lo.y & 0xffff0000u));
            uint2 w; w.x = cvtpk(y0, y1); w.y = cvtpk(y2, y3);
            *(uint2*)(Y + mrow * DM + 256 + 128 * h + v) = w; }
        __syncthreads();
    }
}

constexpr int LDS_BYTES = 147456;
constexpr int LDSCTL_OFF = 131072, MISC_OFF = LDSCTL_OFF + 320;
struct Args { const float* in[13]; float* out; unsigned char* ws; };

__global__ void __launch_bounds__(512, 2) mega_fwd(Args args) {
    extern __shared__ __attribute__((aligned(16))) unsigned char lds[];
    Ctx c;
    c.x_in = args.in[0]; c.norm_g = args.in[1]; c.w_in = args.in[2]; c.conv_w = args.in[3]; c.conv_b = args.in[4]; c.gate_b = args.in[5]; c.cmp_pe = args.in[6];
    c.cmp_w1 = args.in[7]; c.cmp_w2 = args.in[8]; c.head_g = args.in[9]; c.w_out = args.in[10]; c.w1 = args.in[11]; c.w2 = args.in[12];
    c.xo = args.out; c.ws = args.ws; c.lds = lds;
    c.tid = threadIdx.x; c.lane = c.tid & 63; c.wave = __builtin_amdgcn_readfirstlane(c.tid >> 6); asm volatile("" : "+s"(c.wave)); c.bid = blockIdx.x; c.nb = gridDim.x;
    for (int u = c.tid; u < (LDS_BYTES - LDSCTL_OFF) / 4; u += 512) ((LAS unsigned*)((LAS unsigned char*)lds + LDSCTL_OFF))[u] = 0u;
    __syncthreads();
    unsigned* ctl = (unsigned*)(c.ws + WS_CTL);
    XcdBarrier bar = xcd_barrier_post(ctl + CW_BAR, (volatile LAS unsigned*)((LAS unsigned char*)lds + MISC_OFF) + 8);
#define GRID_BAR() xcd_barrier(bar)
    bf16_t* Win_t = (bf16_t*)(c.ws + WS_WIN); bf16_t* Wout_t = (bf16_t*)(c.ws + WS_WOUT); bf16_t* W1_t = (bf16_t*)(c.ws + WS_W1); bf16_t* W2_t = (bf16_t*)(c.ws + WS_W2);
    bf16_t* HN = (bf16_t*)(c.ws + WS_HN); bf16_t* Z = (bf16_t*)(c.ws + WS_Z); bf16_t* Y = (bf16_t*)(c.ws + WS_Y); bf16_t* H = (bf16_t*)(c.ws + WS_H); float* T = (float*)(c.ws + WS_T); float* T2 = (float*)(c.ws + WS_T2);

    ph_wconv(c, 0); ph_wconv_cmp(c, 0);
    ph_resid_norm(c, c.x_in, nullptr, nullptr, nullptr, c.norm_g, HN);
    GRID_BAR();
    for (int L = 0; L < DEPTH; ++L) {
        const float* ng = c.norm_g + (size_t)L * 4 * DM;
        { pg8::Gemm g{HN, Win_t, MTOK, DINP, DM, 0}; pg8::StaticOrder S; S.init(MTOK, DINP, c.nb, c.bid); pg8::EpiBf16<0> E{Z, DINP, 0};
          pg8::gemm_phase<pg8::EpiBf16<0>, pg8::StaticOrder, true, true>((PG8_LAS unsigned char*)lds, g, S, E, c.wave); }
        GRID_BAR();
        nv_kmean(c); ph_cmp(c, L); ph_ml_chunk(c, L);
        GRID_BAR();
        ph_ml_scan(c); ph_moba(c, L);
        GRID_BAR();
        ph_ml_out(c, L); ph_nsa(c, L);
        GRID_BAR();
        { pg8::Gemm g{Y, Wout_t, MTOK, DM, DM, 0}; pg8::StaticOrder S; S.init(MTOK, DM, c.nb, c.bid); pg8::EpiF32 E{T, nullptr, DM, 0};
          pg8::gemm_phase<pg8::EpiF32, pg8::StaticOrder, true, true>((PG8_LAS unsigned char*)lds, g, S, E, c.wave); }
        GRID_BAR();
        ph_resid_norm(c, L == 0 ? c.x_in : (const float*)c.xo, T, c.xo, ng + DM, ng + 2 * DM, HN);
        GRID_BAR();
        { pg8::Gemm g{HN, W1_t, MTOK, DFF, DM, 0}; pg8::StaticOrder S; S.init(MTOK, DFF, c.nb, c.bid); pg8::EpiBf16<1> E{H, DFF, 0};
          pg8::gemm_phase<pg8::EpiBf16<1>, pg8::StaticOrder, true, true>((PG8_LAS unsigned char*)lds, g, S, E, c.wave); }
        GRID_BAR();
        { pg8::Gemm g{H, W2_t, MTOK, DM, DFF, 0}; pg8::StaticOrder S; S.init(MTOK, DM, c.nb, c.bid); pg8::EpiF32 E{T2, nullptr, DM, 0};
          pg8::gemm_phase<pg8::EpiF32, pg8::StaticOrder, true, true>((PG8_LAS unsigned char*)lds, g, S, E, c.wave); }
        GRID_BAR();
        if (L + 1 < DEPTH) { ph_resid_norm(c, c.xo, T2, c.xo, ng + 3 * DM, c.norm_g + (size_t)(L + 1) * 4 * DM, HN); ph_wconv(c, L + 1); ph_wconv_cmp(c, L + 1); GRID_BAR(); }
        else ph_resid_norm(c, c.xo, T2, c.xo, ng + 3 * DM, nullptr, nullptr);
    }
#undef GRID_BAR
}

extern "C" void kernel_launch(void* const* d_in, const int* in_sizes, int n_in, void* d_out, int out_size, void* d_ws, size_t ws_size, hipStream_t stream) {
    static int grid = 0;
    if (grid == 0) {
        if (n_in != 13 || in_sizes[0] != MTOK * DM || out_size != MTOK * DM || ws_size < WS_END) { fprintf(stderr, "kernel_launch: unexpected shapes / workspace (%zu)\n", ws_size); grid = -1; return; }
        int dev = 0, cus = 0, per_cu = 0;
        if (hipGetDevice(&dev) != hipSuccess || hipDeviceGetAttribute(&cus, hipDeviceAttributeMultiprocessorCount, dev) != hipSuccess) { grid = -1; return; }
        if (hipFuncSetAttribute((const void*)mega_fwd, hipFuncAttributeMaxDynamicSharedMemorySize, LDS_BYTES) != hipSuccess) { fprintf(stderr, "hipFuncSetAttribute failed\n"); grid = -1; return; }
        if (hipOccupancyMaxActiveBlocksPerMultiprocessor(&per_cu, (const void*)mega_fwd, 512, LDS_BYTES) != hipSuccess || per_cu < 1) { fprintf(stderr, "occupancy query: %d\n", per_cu); (void)hipGetLastError(); }
        grid = cus;
    }
    if (grid < 0) return;
    if (hipMemsetAsync((char*)d_ws + WS_CTL, 0, CTL_ZERO_BYTES, stream) != hipSuccess) return;
    Args a{};
    for (int i = 0; i < 13; ++i) a.in[i] = (const float*)d_in[i];
    a.out = (float*)d_out; a.ws = (unsigned char*)d_ws;
    hipLaunchKernelGGL(mega_fwd, dim3(grid), dim3(512), LDS_BYTES, stream, a);
}
```

```cpp
#include <hip/hip_runtime.h>
#include <cstdio>
#include <cstdint>

namespace pg8 {
#define PG8_LAS __attribute__((address_space(3)))
typedef unsigned short bf16_t;
typedef short bf16x8 __attribute__((ext_vector_type(8)));
typedef float f32x4 __attribute__((ext_vector_type(4)));
typedef unsigned u32x4 __attribute__((ext_vector_type(4)));
constexpr int BM = 256, BK = 64, HALF = 128, HTB = HALF * BK * 2  , STAGE_BYTES = 8 * HTB, NXCD = 8, WGM = 8;

__host__ __device__ __forceinline__ int lds_byte(int r, int c) { const int st = (r >> 4) * 2 + (c >> 5), rr = r & 15, cc = c & 31, ob = rr * 64 + cc * 2; return st * 1024 + (ob ^ (((ob >> 9) & 1) << 5)); }
__host__ __device__ __forceinline__ void stage_rc(int b, int& R, int& C) { const int st = b / 1024, sb = b % 1024, swz = sb ^ (((sb >> 9) & 1) << 5); R = (st >> 1) * 16 + swz / 64; C = (st & 1) * 32 + (swz % 64) / 2; }
__host__ __device__ __forceinline__ int perm32(int rho) { const int n = rho >> 4, i = rho & 15; return 8 * (i >> 2) + 4 * n + (i & 3); }

struct Unit { int pm, pn; };
struct Gemm { const bf16_t* A; const bf16_t* Bt; int M, N, K, pad; };

struct StaticOrder {
    int nM, nN, nwg, G, c;
    __host__ __device__ void init(int M, int N, int G_, int c_) { nM = M / BM; nN = N / BM; nwg = nM * nN; G = G_; c = c_; }
    __host__ __device__ bool next(int i, Unit& u) const {
        const long L = (long)i * G + c; if (L >= nwg) return false;
        int wgid = (int)L; { const int q = nwg / NXCD, r = nwg % NXCD, xcd = wgid % NXCD, off = wgid / NXCD; wgid = (xcd < r ? xcd * (q + 1) : r * (q + 1) + (xcd - r) * q) + off; }
        const int nig = WGM * nN, gid = wgid / nig, fm = gid * WGM, gsz = (nM - fm) < WGM ? (nM - fm) : WGM;
        u.pm = fm + ((wgid % nig) % gsz); u.pn = (wgid % nig) / gsz; return true;
    }
    __device__ __forceinline__ void a_ready(const Unit&) const {}
    __device__ __forceinline__ void done(const Unit&) const {}
};

__device__ __forceinline__ unsigned cvt_pk_bf16(float lo, float hi) { unsigned r; asm volatile("v_cvt_pk_bf16_f32 %0, %1, %2" : "=v"(r) : "v"(lo), "v"(hi)); return r; }
typedef float f32x2 __attribute__((ext_vector_type(2)));
struct EpiF32 {
    static constexpr bool PERM = false, AFTER_DRAIN = false;
    float* C; const float* bias; int ldc, pad;
    __device__ __forceinline__ void operator()(const f32x4 (&acc)[2][2][4][2], const Unit& u, int wr, int wc, int fr, int fq) const {
        const int row0 = u.pm * BM + wr * 64 + fr, col0 = u.pn * BM + wc * 32 + 4 * fq;
        f32x4 bv[2][2];
#pragma unroll
        for (int bj = 0; bj < 2; ++bj)
#pragma unroll
            for (int n = 0; n < 2; ++n) bv[bj][n] = bias ? *(const f32x4*)(bias + col0 + bj * HALF + n * 16) : (f32x4){0.f, 0.f, 0.f, 0.f};
#pragma unroll
        for (int ai = 0; ai < 2; ++ai)
#pragma unroll
            for (int m = 0; m < 4; ++m) { float* rowp = C + (size_t)(row0 + ai * HALF + m * 16) * ldc + col0;
#pragma unroll
                for (int bj = 0; bj < 2; ++bj)
#pragma unroll
                    for (int n = 0; n < 2; ++n) *(f32x4*)(rowp + bj * HALF + n * 16) = acc[ai][bj][m][n] + bv[bj][n]; }
    }
};
template <int ACT> struct EpiBf16 {
    static constexpr bool PERM = true, AFTER_DRAIN = false;
    bf16_t* O; int ldc, pad;
    __device__ __forceinline__ void operator()(const f32x4 (&acc)[2][2][4][2], const Unit& u, int wr, int wc, int fr, int fq) const {
        const int row0 = u.pm * BM + wr * 64 + fr; const int col0 = u.pn * BM + wc * 32 + 8 * fq;
#pragma unroll
        for (int ai = 0; ai < 2; ++ai)
#pragma unroll
            for (int m = 0; m < 4; ++m) { bf16_t* rowp = O + (size_t)(row0 + ai * HALF + m * 16) * ldc + col0;
#pragma unroll
                for (int bj = 0; bj < 2; ++bj) { f32x4 v0 = acc[ai][bj][m][0], v1 = acc[ai][bj][m][1];
                    if (ACT == 1) {
#pragma unroll
                        for (int j = 0; j < 4; ++j) { const float a = fmaxf(v0[j], 0.f), b = fmaxf(v1[j], 0.f); v0[j] = a * a; v1[j] = b * b; } }
                    u32x4 w; w.x = cvt_pk_bf16(v0[0], v0[1]); w.y = cvt_pk_bf16(v0[2], v0[3]); w.z = cvt_pk_bf16(v1[0], v1[1]); w.w = cvt_pk_bf16(v1[2], v1[3]);
                    *(u32x4*)(rowp + bj * HALF) = w; } }
    }
};
template <class Epi, class Sched, bool ALIGN_EPI = false, bool SP2 = false>
__device__ __forceinline__ void gemm_phase(PG8_LAS unsigned char* lds, const Gemm g, const Sched& S, const Epi& E, int wave_id  ) {
    int tid_ = wave_id * 64 + (int)__builtin_amdgcn_mbcnt_hi(~0u, __builtin_amdgcn_mbcnt_lo(~0u, 0u)); asm volatile("" : "+v"(tid_));
    const int tid = tid_, wid = __builtin_amdgcn_readfirstlane(tid >> 6), lane = tid & 63, wr = wid >> 2, wc = wid & 3, fr = lane & 15, fq = lane >> 4;
    const int K = g.K, nt = K / BK;
    unsigned voffA[2], voffB[2];
#pragma unroll
    for (int i = 0; i < 2; ++i) { int R, C; stage_rc(tid * 16 + i * 8192, R, C); const int Rb = Epi::PERM ? ((R & ~31) + perm32(R & 31)) : R;
        voffA[i] = (unsigned)(R * K + C) * 2u; voffB[i] = (unsigned)(Rb * K + C) * 2u; }
    const size_t kstep = (size_t)(BK * 2);
    const size_t hstep = (size_t)HALF * K * 2;
    const size_t tstep = 2 * hstep;
    const unsigned ldsw = (unsigned)wid * 1024u;
    const int aoff = lds_byte(wr * 64 + fr, fq * 8), boff = lds_byte(wc * 32 + fr, fq * 8);
#define PG8_SA(b, h) (((b) * 2 + (h)) * HTB)
#define PG8_SB(b, h) ((4 + (b) * 2 + (h)) * HTB)
#define PG8_STAGE(bufoff, gbase, voff) do { _Pragma("unroll") for (int _i = 0; _i < 2; ++_i) \
        __builtin_amdgcn_global_load_lds((const unsigned*)((const char*)(gbase) + (voff)[_i]), (PG8_LAS unsigned*)(lds + (bufoff) + ldsw + _i * 8192), 16, 0, 0); } while (0)
#define PG8_LDA(dst, b, h) do { _Pragma("unroll") for (int m = 0; m < 4; ++m) _Pragma("unroll") for (int k = 0; k < 2; ++k) dst[m][k] = *(const PG8_LAS bf16x8*)(lds + PG8_SA(b, h) + aoff + m * 2048 + k * 1024); } while (0)
#define PG8_LDB(dst, b, h) do { _Pragma("unroll") for (int n = 0; n < 2; ++n) _Pragma("unroll") for (int k = 0; k < 2; ++k) dst[n][k] = *(const PG8_LAS bf16x8*)(lds + PG8_SB(b, h) + boff + n * 2048 + k * 1024); } while (0)
#define PG8_MMA(ai, bj, At, Bt) do { __builtin_amdgcn_s_setprio(1); _Pragma("unroll") for (int m = 0; m < 4; ++m) _Pragma("unroll") for (int n = 0; n < 2; ++n) _Pragma("unroll") for (int k = 0; k < 2; ++k) \
        acc[ai][bj][m][n] = __builtin_amdgcn_mfma_f32_16x16x32_bf16(Bt[n][k], At[m][k], acc[ai][bj][m][n], 0, 0, 0); __builtin_amdgcn_s_setprio(0); } while (0)
#define PG8_WAIT_V(n) asm volatile("s_waitcnt vmcnt(" #n ")" ::: "memory")
#define PG8_WAIT_L(n) asm volatile("s_waitcnt lgkmcnt(" #n ")" ::: "memory")
#define PG8_BAR __builtin_amdgcn_s_barrier()
#define PG8_SCHED __builtin_amdgcn_sched_barrier(0)
    Unit cur, nxt; int ui = 0;
    if (!S.next(0, cur)) return;
    f32x4 acc[2][2][4][2];
#pragma unroll
    for (int a = 0; a < 2; ++a)
#pragma unroll
        for (int b = 0; b < 2; ++b)
#pragma unroll
            for (int m = 0; m < 4; ++m)
#pragma unroll
                for (int n = 0; n < 2; ++n) acc[a][b][m][n] = (f32x4){0.f, 0.f, 0.f, 0.f};
    bf16x8 At[4][2], B0[2][2], B1[2][2];
    const char* cA = (const char*)g.A + (size_t)cur.pm * tstep; const char* cB = (const char*)g.Bt + (size_t)cur.pn * tstep;
    S.a_ready(cur);
    if constexpr (SP2) {
        PG8_STAGE(PG8_SB(0, 0), cB, voffB); PG8_STAGE(PG8_SB(0, 1), cB + hstep, voffB); PG8_STAGE(PG8_SA(0, 0), cA, voffA); PG8_STAGE(PG8_SA(0, 1), cA + hstep, voffA);
        if (wr == 1) PG8_BAR;
        PG8_WAIT_V(2); PG8_BAR;
        PG8_STAGE(PG8_SB(1, 0), cB + kstep, voffB); PG8_STAGE(PG8_SA(1, 0), cA + kstep, voffA); PG8_STAGE(PG8_SB(1, 1), cB + hstep + kstep, voffB);
        PG8_WAIT_V(6); PG8_BAR;
    } else {
        PG8_STAGE(PG8_SB(0, 0), cB, voffB); PG8_STAGE(PG8_SA(0, 0), cA, voffA); PG8_STAGE(PG8_SB(0, 1), cB + hstep, voffB); PG8_STAGE(PG8_SA(0, 1), cA + hstep, voffA);
        if (wr == 1) PG8_BAR;
        PG8_WAIT_V(4); PG8_BAR;
        PG8_STAGE(PG8_SB(1, 0), cB + kstep, voffB); PG8_STAGE(PG8_SA(1, 0), cA + kstep, voffA); PG8_STAGE(PG8_SB(1, 1), cB + hstep + kstep, voffB);
        PG8_WAIT_V(6); PG8_BAR;
    }
    for (;;) {
        const bool has_next = S.next(ui + 1, nxt);
        const char* nA = has_next ? (const char*)g.A + (size_t)nxt.pm * tstep : cA; const char* nB = has_next ? (const char*)g.Bt + (size_t)nxt.pn * tstep : cB;
        for (int t = 0; t < nt; t += 2) {
            const bool last = (t == nt - 2);
            const char* a1 = cA + (size_t)(t + 1) * kstep;
            const char* a2 = last ? nA : cA + (size_t)(t + 2) * kstep; const char* b2 = last ? nB : cB + (size_t)(t + 2) * kstep;
            const char* a3 = a2 + kstep; const char* b3 = b2 + kstep;
            if (last && has_next) S.a_ready(nxt);
            if constexpr (SP2) {
            PG8_LDB(B0, 0, 0); PG8_LDB(B1, 0, 1); PG8_SCHED; PG8_LDA(At, 0, 0); PG8_STAGE(PG8_SA(1, 1), a1 + hstep, voffA);
            PG8_WAIT_V(8); PG8_WAIT_L(0); PG8_BAR; PG8_MMA(0, 0, At, B0); PG8_MMA(0, 1, At, B1); PG8_BAR; PG8_SCHED;
            PG8_LDA(At, 0, 1); PG8_STAGE(PG8_SB(0, 0), b2, voffB); PG8_STAGE(PG8_SB(0, 1), b2 + hstep, voffB); PG8_STAGE(PG8_SA(0, 0), a2, voffA);
            PG8_WAIT_V(8); PG8_WAIT_L(0); PG8_BAR; PG8_MMA(1, 0, At, B0); PG8_MMA(1, 1, At, B1); PG8_BAR; PG8_SCHED;
            PG8_LDB(B0, 1, 0); PG8_LDB(B1, 1, 1); PG8_SCHED; PG8_LDA(At, 1, 0); PG8_STAGE(PG8_SA(0, 1), a2 + hstep, voffA);
            PG8_WAIT_V(8); PG8_WAIT_L(0); PG8_BAR; PG8_MMA(0, 0, At, B0); PG8_MMA(0, 1, At, B1); PG8_BAR; PG8_SCHED;
            PG8_LDA(At, 1, 1); PG8_STAGE(PG8_SB(1, 0), b3, voffB); PG8_STAGE(PG8_SB(1, 1), b3 + hstep, voffB); PG8_STAGE(PG8_SA(1, 0), a3, voffA);
            PG8_WAIT_V(8); PG8_WAIT_L(0); PG8_BAR; PG8_MMA(1, 0, At, B0); PG8_MMA(1, 1, At, B1); PG8_BAR; PG8_SCHED;
            } else {
            PG8_LDB(B0, 0, 0); PG8_SCHED; PG8_LDA(At, 0, 0); PG8_STAGE(PG8_SA(1, 1), a1 + hstep, voffA);
            PG8_WAIT_L(8); PG8_BAR; PG8_WAIT_L(0); PG8_MMA(0, 0, At, B0); PG8_BAR; PG8_SCHED;
            PG8_LDB(B1, 0, 1); PG8_STAGE(PG8_SB(0, 0), b2, voffB);
            PG8_BAR; PG8_WAIT_L(0); PG8_MMA(0, 1, At, B1); PG8_BAR;
            PG8_LDA(At, 0, 1); PG8_STAGE(PG8_SA(0, 0), a2, voffA);
            PG8_BAR; PG8_WAIT_L(0); PG8_MMA(1, 0, At, B0); PG8_BAR; PG8_SCHED;
            PG8_STAGE(PG8_SB(0, 1), b2 + hstep, voffB);
            PG8_WAIT_V(6); PG8_BAR; PG8_MMA(1, 1, At, B1); PG8_BAR;
            PG8_LDB(B0, 1, 0); PG8_SCHED; PG8_LDA(At, 1, 0); PG8_STAGE(PG8_SA(0, 1), a2 + hstep, voffA);
            PG8_WAIT_L(8); PG8_BAR; PG8_WAIT_L(0); PG8_MMA(0, 0, At, B0); PG8_BAR; PG8_SCHED;
            PG8_LDB(B1, 1, 1); PG8_STAGE(PG8_SB(1, 0), b3, voffB);
            PG8_BAR; PG8_WAIT_L(0); PG8_MMA(0, 1, At, B1); PG8_BAR;
            PG8_LDA(At, 1, 1); PG8_STAGE(PG8_SA(1, 0), a3, voffA);
            PG8_BAR; PG8_WAIT_L(0); PG8_MMA(1, 0, At, B0); PG8_BAR; PG8_SCHED;
            PG8_STAGE(PG8_SB(1, 1), b3 + hstep, voffB);
            PG8_WAIT_V(6); PG8_BAR; PG8_MMA(1, 1, At, B1); PG8_BAR;
            }
        }
        if constexpr (ALIGN_EPI) { if (wr == 0) PG8_BAR; }
        if constexpr (!Epi::AFTER_DRAIN) { E(acc, cur, wr, wc, fr, fq); S.done(cur); }
        if (!has_next) break;
#pragma unroll
        for (int a = 0; a < 2; ++a)
#pragma unroll
            for (int b = 0; b < 2; ++b)
#pragma unroll
                for (int m = 0; m < 4; ++m)
#pragma unroll
                    for (int n = 0; n < 2; ++n) acc[a][b][m][n] = (f32x4){0.f, 0.f, 0.f, 0.f};
        cur = nxt; cA = nA; cB = nB; ++ui;
        if constexpr (ALIGN_EPI) { if (wr == 1) PG8_BAR; }
    }
    PG8_WAIT_V(0);
    if constexpr (!ALIGN_EPI) { if (wr == 0) PG8_BAR; }
    PG8_BAR;
    if constexpr (Epi::AFTER_DRAIN) { E.fused(acc, cur, wr, wc, fr, fq, lds, wid, lane); S.done(cur); }
#undef PG8_SA
#undef PG8_SB
#undef PG8_STAGE
#undef PG8_LDA
#undef PG8_LDB
#undef PG8_MMA
#undef PG8_WAIT_V
#undef PG8_WAIT_L
#undef PG8_BAR
#undef PG8_SCHED
}
}
#define GAS __attribute__((address_space(1)))
#define LAS __attribute__((address_space(3)))

typedef unsigned v4u __attribute__((ext_vector_type(4)));


typedef GAS unsigned gu32;
typedef GAS unsigned long long gu64;
#define RLX_AGENT __ATOMIC_RELAXED, __HIP_MEMORY_SCOPE_AGENT
#define LDS_WAIT() asm volatile("s_waitcnt lgkmcnt(0)" ::: "memory")
#define VM_WAIT() asm volatile("s_waitcnt vmcnt(0)" ::: "memory")
#define XB_TMO      128
#define XB_XCNT(j)  (256  + 64 * (j))
#define XB_XSUB(j)  (1280 + 64 * (j))
#define XB_XGEN(j)  (2304 + 64 * (j))
#define XB_TOP      3328
#define XB_TOPGEN   3392
#define XCD_BAR_WORDS 3456
#define XB_SPIN_CAP (1u << 18)

__device__ __forceinline__ unsigned xb_ld(unsigned* p)              { return __hip_atomic_load(p, __ATOMIC_RELAXED, __HIP_MEMORY_SCOPE_AGENT); }
__device__ __forceinline__ unsigned xb_add(unsigned* p, unsigned v) { return __hip_atomic_fetch_add(p, v, __ATOMIC_RELAXED, __HIP_MEMORY_SCOPE_AGENT); }
__device__ __forceinline__ unsigned xb_xcc_id() { return (unsigned)__builtin_amdgcn_s_getreg((3 << 11) | 20) & 0xFu; }
#define XB_SPIN(cond, bar) do { unsigned _sp = 0; while (cond) { __builtin_amdgcn_s_sleep(1); \
    if ((++_sp & 255u) == 0u) { if (xb_ld(&(bar)[XB_TMO])) break; if (_sp > XB_SPIN_CAP) { atomicAdd(&(bar)[XB_TMO], 1u); break; } } } } while (0)

struct XcdBarrier {
    unsigned* bar; unsigned x;
    volatile LAS unsigned* st;
};

__device__ __forceinline__ XcdBarrier xcd_barrier_post(unsigned* bar, volatile LAS unsigned* st) {
    XcdBarrier b; b.bar = bar; b.x = xb_xcc_id(); b.st = st;
    if (threadIdx.x == 0) (void)xb_add(&bar[XB_XCNT(b.x)], 1u);
    return b;
}
__device__ __forceinline__ void xcd_barrier_complete(unsigned* bar, unsigned x, unsigned& nloc, unsigned& nx) {
    const unsigned G = gridDim.x * gridDim.y * gridDim.z;
    unsigned sum, cnt, mine, sp = 0u;
    for (;;) {
        sum = 0u; cnt = 0u; mine = 0u;
#pragma unroll
        for (unsigned j = 0; j < 16; ++j) { const unsigned c = xb_ld(&bar[XB_XCNT(j)]); sum += c; cnt += (c > 0u) ? 1u : 0u; mine = (j == x) ? c : mine; }
        if (sum == G) break;
        __builtin_amdgcn_s_sleep(1);
        if ((++sp & 255u) == 0u) { if (xb_ld(&bar[XB_TMO])) break; if (sp > XB_SPIN_CAP) { atomicAdd(&bar[XB_TMO], 1u); break; } }
    }
    nloc = mine > 0u ? mine : 1u; nx = cnt > 0u ? cnt : 1u;
}

__device__ __forceinline__ void xcd_barrier(const XcdBarrier& b) {
    asm volatile("s_waitcnt vmcnt(0)" ::: "memory");
    __syncthreads();
    if (threadIdx.x == 0) {
        unsigned* bar = b.bar; asm volatile("" : "+s"(bar)); unsigned bx = b.x; asm volatile("" : "+s"(bx));
        __builtin_amdgcn_s_waitcnt(0);
        unsigned nloc = b.st[0], nx = b.st[1];
        if (nloc == 0u) { xcd_barrier_complete(bar, bx, nloc, nx); b.st[0] = nloc; b.st[1] = nx; }
        const unsigned old = xb_add(&bar[XB_XSUB(bx)], 1u);
        const unsigned gen = old / nloc;
        if (old + 1u == (gen + 1u) * nloc) {
            __builtin_amdgcn_fence(__ATOMIC_RELEASE, "agent");
            asm volatile("s_waitcnt vmcnt(0)" ::: "memory");
            const unsigned og = xb_add(&bar[XB_TOP], 1u);
            const unsigned tg = og / nx;
            if (og + 1u == (tg + 1u) * nx) xb_add(&bar[XB_TOPGEN], 1u);
            else XB_SPIN(xb_ld(&bar[XB_TOPGEN]) == tg, bar);
            __builtin_amdgcn_fence(__ATOMIC_ACQUIRE, "agent");
            xb_add(&bar[XB_XGEN(bx)], 1u);
            asm volatile("s_waitcnt vmcnt(0)" ::: "memory");
        } else {
            XB_SPIN(xb_ld(&bar[XB_XGEN(bx)]) == gen, bar);
            __builtin_amdgcn_fence(__ATOMIC_ACQUIRE, "agent");
            asm volatile("s_waitcnt vmcnt(0)" ::: "memory");
        }
    }
    __syncthreads();
}

typedef unsigned short bf16_t;
constexpr int NB = 16, SEQ = 2048, DM = 1024, MTOK = NB * SEQ, DEPTH = 4, DIN = 2964, DINP = 3072, DFF = 4096;
constexpr int ZC_MQ = 0, ZC_MK = 256, ZC_MV = 512, ZC_LQ = 768, ZC_LK = 1024, ZC_LV = 1280, ZC_LO = 1792, ZC_LI = 2304, ZC_LF = 2308,
              ZC_NQ = 2312, ZC_KC = 2568, ZC_VC = 2632, ZC_KSL = 2696, ZC_VSL = 2760, ZC_KWN = 2824, ZC_VWN = 2888, ZC_NG = 2952;
constexpr float EPS = 1e-6f;
constexpr size_t MiB = 1u << 20;
constexpr size_t WS_CTL = 0, CTL_ZERO_BYTES = 1 * MiB;
constexpr size_t WS_WIN = 1 * MiB, WS_WOUT = 7 * MiB, WS_W1 = 9 * MiB, WS_W2 = 17 * MiB;
constexpr size_t WS_CW1 = 25 * MiB;
constexpr size_t WS_CW2 = 27 * MiB;
constexpr size_t WS_CPE = 27 * MiB + 65536;
constexpr size_t WS_KMEAN = 28 * MiB, WS_KCMP = 28 * MiB + 256 * 1024, WS_VCMP = 28 * MiB + 768 * 1024;
constexpr size_t WS_GATES = 30 * MiB;
constexpr size_t WS_T2 = 32 * MiB;
constexpr size_t WS_QKC = 96 * MiB;
constexpr size_t WS_CC = 128 * MiB, WS_CPREV = 160 * MiB;
constexpr size_t WS_HID = 128 * MiB;
constexpr size_t WS_BIG = 192 * MiB;
constexpr size_t WS_Z = WS_BIG, WS_Y = WS_BIG + 192 * MiB, WS_H = WS_BIG, WS_T = WS_BIG;
constexpr size_t WS_HN = 448 * MiB;
constexpr size_t WS_END = 512 * MiB;
constexpr int CW_BAR = 4096;

__device__ __forceinline__ float bf2f(bf16_t v) { return __uint_as_float(((unsigned)v) << 16); }
__device__ __forceinline__ bf16_t f2bf(float f) { unsigned u = __float_as_uint(f); u += 0x7fffu + ((u >> 16) & 1u); return (bf16_t)(u >> 16); }
__device__ __forceinline__ unsigned pk2bf(float lo, float hi) { return (unsigned)f2bf(lo) | ((unsigned)f2bf(hi) << 16); }
__device__ __forceinline__ float wave_sum(float v) {
#pragma unroll
    for (int o = 1; o < 64; o <<= 1) v += __shfl_xor(v, o);
    return v;
}
__device__ __forceinline__ float wave_max(float v) {
#pragma unroll
    for (int o = 1; o < 64; o <<= 1) v = fmaxf(v, __shfl_xor(v, o));
    return v;
}
__device__ __forceinline__ float sigmoidf_(float x) { return 1.f / (1.f + __expf(-x)); }
__device__ __forceinline__ float gelu_tanh(float x) { const float u = 0.7978845608028654f * (x + 0.044715f * x * x * x); return 0.5f * x * (1.f + tanhf(u)); }

struct Ctx {
    const float *x_in, *norm_g, *w_in, *conv_w, *conv_b, *gate_b, *cmp_pe, *cmp_w1, *cmp_w2, *head_g, *w_out, *w1, *w2;
    float* xo; unsigned char* ws; unsigned char* lds;
    int tid, lane, wave, bid, nb;
};

__device__ __forceinline__ void wconv_tile(const float* __restrict__ src, bf16_t* __restrict__ dst, int K, int N, int Npad, int it, int t256, float* tile  , bool active) {
    const int ntn = Npad / 64, tk = it / ntn, tn = it % ntn, k0 = tk * 64, n0 = tn * 64;
    if (active) {
#pragma unroll 4
        for (int i = 0; i < 16; ++i) { const int kk = i * 4 + (t256 >> 6), nn = t256 & 63; const int n = n0 + nn;
            tile[kk * 65 + nn] = (n < N) ? src[(size_t)(k0 + kk) * N + n] : 0.f; }
    }
    __syncthreads();
    if (active) {
        const int nn = t256 >> 2, ks = (t256 & 3) * 16;
        unsigned w[8];
#pragma unroll
        for (int j = 0; j < 8; ++j) w[j] = pk2bf(tile[(ks + 2 * j) * 65 + nn], tile[(ks + 2 * j + 1) * 65 + nn]);
        uint4* o = (uint4*)(dst + (size_t)(n0 + nn) * K + k0 + ks);
        o[0] = make_uint4(w[0], w[1], w[2], w[3]); o[1] = make_uint4(w[4], w[5], w[6], w[7]);
    }
    __syncthreads();
}
__device__ __forceinline__ void ph_wconv(const Ctx& c_, int L) {
    Ctx c = c_; c.lane = (int)__builtin_amdgcn_mbcnt_hi(~0u, __builtin_amdgcn_mbcnt_lo(~0u, 0u)); asm volatile("" : "+v"(c.lane)); c.tid = c.wave * 64 + c.lane; asm volatile("" : "+s"(c.bid)); asm volatile("" : "+s"(c.ws));
    const int half = c.tid >> 8, t256 = c.tid & 255; float* tile = (float*)(c.lds) + half * (64 * 65);
    constexpr int T_IN = (DM / 64) * (DINP / 64), T_OUT = (DM / 64) * (DM / 64), T_1 = (DM / 64) * (DFF / 64), T_2 = (DFF / 64) * (DM / 64), TOT = T_IN + T_OUT + T_1 + T_2;
    for (int base = c.bid * 2; base < TOT; base += c.nb * 2) {
        int it = base + half; const bool act = it < TOT;
        if (!act) it = 0;
        const float* src; bf16_t* dst; int K, N, Np;
        if (it < T_IN) { src = c.w_in + (size_t)L * DM * DIN; dst = (bf16_t*)(c.ws + WS_WIN); K = DM; N = DIN; Np = DINP; }
        else if ((it -= T_IN) < T_OUT) { src = c.w_out + (size_t)L * DM * DM; dst = (bf16_t*)(c.ws + WS_WOUT); K = DM; N = DM; Np = DM; }
        else if ((it -= T_OUT) < T_1) { src = c.w1 + (size_t)L * DM * DFF; dst = (bf16_t*)(c.ws + WS_W1); K = DM; N = DFF; Np = DFF; }
        else { it -= T_1; src = c.w2 + (size_t)L * DFF * DM; dst = (bf16_t*)(c.ws + WS_W2); K = DFF; N = DM; Np = DM; }
        wconv_tile(src, dst, K, N, Np, it, t256, tile, act);
    }
}

__device__ __forceinline__ void ph_resid_norm(const Ctx& c_, const float* __restrict__ xsrc, const bf16_t* __restrict__ T, float* xdst, const float* __restrict__ ga, const float* __restrict__ gb, bf16_t* HN) {
    Ctx c = c_; c.lane = (int)__builtin_amdgcn_mbcnt_hi(~0u, __builtin_amdgcn_mbcnt_lo(~0u, 0u)); asm volatile("" : "+v"(c.lane)); c.tid = c.wave * 64 + c.lane; asm volatile("" : "+s"(c.bid)); asm volatile("" : "+s"(c.ws));
    const int lane = c.lane;
    for (int row = c.bid * 8 + c.wave; row < MTOK; row += c.nb * 8) {
        const float4* xr = (const float4*)(xsrc + (size_t)row * DM) + lane;
        float4 v[4];
#pragma unroll
        for (int j = 0; j < 4; ++j) v[j] = xr[64 * j];
        if (T) {
            const uint2* tr = (const uint2*)(T + (size_t)row * DM) + lane; float4 t[4]; float ss = 0.f;
#pragma unroll
            for (int j = 0; j < 4; ++j) { const uint2 w = tr[64 * j]; t[j].x = __uint_as_float(w.x << 16); t[j].y = __uint_as_float(w.x & 0xffff0000u); t[j].z = __uint_as_float(w.y << 16); t[j].w = __uint_as_float(w.y & 0xffff0000u);
                ss += t[j].x * t[j].x + t[j].y * t[j].y + t[j].z * t[j].z + t[j].w * t[j].w; }
            const float r = rsqrtf(wave_sum(ss) * (1.f / DM) + EPS);
#pragma unroll
            for (int j = 0; j < 4; ++j) { const float4 g = ((const float4*)ga)[lane + 64 * j];
                v[j].x += t[j].x * r * g.x; v[j].y += t[j].y * r * g.y; v[j].z += t[j].z * r * g.z; v[j].w += t[j].w * r * g.w; }
        }
        if (xdst) { float4* xo = (float4*)(xdst + (size_t)row * DM) + lane;
#pragma unroll
            for (int j = 0; j < 4; ++j) xo[64 * j] = v[j]; }
        if (HN) {
            float ss = 0.f;
#pragma unroll
            for (int j = 0; j < 4; ++j) ss += v[j].x * v[j].x + v[j].y * v[j].y + v[j].z * v[j].z + v[j].w * v[j].w;
            const float r = rsqrtf(wave_sum(ss) * (1.f / DM) + EPS);
            uint2* o = (uint2*)(HN + (size_t)row * DM) + lane;
#pragma unroll
            for (int j = 0; j < 4; ++j) { const float4 g = ((const float4*)gb)[lane + 64 * j];
                uint2 w; w.x = pk2bf(v[j].x * r * g.x, v[j].y * r * g.y); w.y = pk2bf(v[j].z * r * g.z, v[j].w * r * g.w);
                o[64 * j] = w; }
        }
    }
}

__device__ __forceinline__ void wsync() { asm volatile("s_waitcnt lgkmcnt(0)" ::: "memory"); }

__device__ __forceinline__ void nv_kmean(const Ctx& c_) {
    Ctx c = c_; c.lane = (int)__builtin_amdgcn_mbcnt_hi(~0u, __builtin_amdgcn_mbcnt_lo(~0u, 0u)); asm volatile("" : "+v"(c.lane)); c.tid = c.wave * 64 + c.lane; asm volatile("" : "+s"(c.bid)); asm volatile("" : "+s"(c.ws));
    const bf16_t* Z = (const bf16_t*)(c.ws + WS_Z); float* kmean = (float*)(c.ws + WS_KMEAN);
    for (int it = c.bid * 8 + c.wave; it < 512; it += c.nb * 8) {
        const int bh = it >> 3, n = it & 7, b = bh >> 2, h = bh & 3, d = c.lane;
        const bf16_t* p = Z + ((size_t)b * SEQ + n * 256) * DINP + ZC_MK + h * 64 + d; float s = 0.f;
        for (int i = 0; i < 256; ++i) s += bf2f(p[(size_t)i * DINP]);
        kmean[(size_t)it * 64 + d] = s * (1.f / 256.f);
    }
}
__device__ __forceinline__ void nv_moba(const Ctx& c_, int L) {
    Ctx c = c_; c.lane = (int)__builtin_amdgcn_mbcnt_hi(~0u, __builtin_amdgcn_mbcnt_lo(~0u, 0u)); asm volatile("" : "+v"(c.lane)); c.tid = c.wave * 64 + c.lane; asm volatile("" : "+s"(c.bid)); asm volatile("" : "+s"(c.ws));
    const bf16_t* Z = (const bf16_t*)(c.ws + WS_Z); const float* kmean = (const float*)(c.ws + WS_KMEAN); bf16_t* Y = (bf16_t*)(c.ws + WS_Y); const float* hg = c.head_g + (size_t)L * DM;
    float* base = (float*)(c.lds + c.wave * 4608); float* qs = base; float* sc = base + 64; float* gate = base + 64 + 1024; int* blks = (int*)(base + 64 + 1024 + 8); int* nblk_s = blks + 4;
    const int lane = c.lane;
    for (int idx = c.bid * 8 + c.wave; idx < MTOK * 4; idx += c.nb * 8) {
        const int h = idx & 3, m = idx >> 2, b = m / SEQ, t = m % SEQ, cur = t >> 8;
        wsync();
        qs[lane] = bf2f(Z[(size_t)m * DINP + ZC_MQ + h * 64 + lane]);
        wsync();
        for (int n = 0; n < cur; ++n) { const float g = wave_sum(qs[lane] * kmean[((size_t)(b * 4 + h) * 8 + n) * 64 + lane]); if (lane == 0) gate[n] = g; }
        wsync();
        if (lane == 0) {
            int nb = 0;
            if (cur <= 3) { for (int n = 0; n < cur; ++n) blks[nb++] = n; }
            else { unsigned used = 0; for (int k = 0; k < 3; ++k) { int best = -1; float bv = -INFINITY; for (int n = 0; n < cur; ++n) if (!((used >> n) & 1u) && gate[n] > bv) { bv = gate[n]; best = n; }
                    if (best < 0) { for (int n = 0; n < cur; ++n) if (!((used >> n) & 1u)) { best = n; break; } }
                    used |= 1u << best; blks[nb++] = best; } }
            *nblk_s = nb;
        }
        wsync();
        const int nb = *nblk_s, nown = t - cur * 256 + 1, total = nb * 256 + nown;
        const bf16_t* Kb = Z + (size_t)b * SEQ * DINP + ZC_MK + h * 64; const bf16_t* Vb = Z + (size_t)b * SEQ * DINP + ZC_MV + h * 64;
        float mx = -INFINITY;
        for (int kk = lane; kk < total; kk += 64) { const int bi = kk >> 8, blk = bi < nb ? blks[bi] : cur, key = blk * 256 + (kk & 255);
            const uint4* kr = (const uint4*)(Kb + (size_t)key * DINP); float s = 0.f;
#pragma unroll
            for (int cc = 0; cc < 8; ++cc) { const uint4 w = kr[cc]; const unsigned ww[4] = {w.x, w.y, w.z, w.w};
#pragma unroll
                for (int j = 0; j < 4; ++j) { s += qs[cc * 8 + 2 * j] * __uint_as_float(ww[j] << 16) + qs[cc * 8 + 2 * j + 1] * __uint_as_float(ww[j] & 0xffff0000u); } }
            s *= 0.125f; sc[kk] = s; mx = fmaxf(mx, s); }
        mx = wave_max(mx);
        float sum = 0.f;
        for (int kk = lane; kk < total; kk += 64) { const float p = __expf(sc[kk] - mx); sc[kk] = p; sum += p; }
        sum = wave_sum(sum);
        wsync();
        float acc = 0.f;
        for (int kk = 0; kk < total; ++kk) { const int bi = kk >> 8, blk = bi < nb ? blks[bi] : cur, key = blk * 256 + (kk & 255); acc += sc[kk] * bf2f(Vb[(size_t)key * DINP + lane]); }
        const float o = acc / sum;
        const float ss = wave_sum(o * o);
        Y[(size_t)m * DM + h * 64 + lane] = f2bf(o * rsqrtf(ss * (1.f / 64.f) + EPS) * hg[h * 64 + lane]);
    }
}

__device__ __forceinline__ void nv_cmp(const Ctx& c_, int L) {
    Ctx c = c_; c.lane = (int)__builtin_amdgcn_mbcnt_hi(~0u, __builtin_amdgcn_mbcnt_lo(~0u, 0u)); asm volatile("" : "+v"(c.lane)); c.tid = c.wave * 64 + c.lane; asm volatile("" : "+s"(c.bid)); asm volatile("" : "+s"(c.ws));
    const bf16_t* Z = (const bf16_t*)(c.ws + WS_Z); float* kcmp = (float*)(c.ws + WS_KCMP); float* vcmp = (float*)(c.ws + WS_VCMP);
    const int half = c.tid >> 8, tid = c.tid & 255;
    float* blk = (float*)(c.lds + half * 36864); float* hid = blk + 4 * 2048;
    for (int base = c.bid * 2; base < 1024; base += c.nb * 2) {
        const int item = base + half; const int g4 = item & 31, kv = (item >> 5) & 1, b = item >> 6;
        const int col = kv ? ZC_VC : ZC_KC; const float* pej = c.cmp_pe + ((size_t)L * 2 + kv) * 2048; const float* w1j = c.cmp_w1 + ((size_t)L * 2 + kv) * 2048 * 256; const float* w2j = c.cmp_w2 + ((size_t)L * 2 + kv) * 256 * 64;
        for (int i = tid; i < 4 * 2048; i += 256) { const int g = i >> 11, e = i & 2047, l = e >> 6, d = e & 63, n = g4 * 4 + g; const int t = 16 * n + l;
            blk[g * 2048 + e] = (n < 127) ? bf2f(Z[((size_t)b * SEQ + t) * DINP + col + d]) + pej[e] : 0.f; }
        __syncthreads();
        float a0 = 0.f, a1 = 0.f, a2 = 0.f, a3 = 0.f;
        for (int i = 0; i < 2048; ++i) { const float w = w1j[(size_t)i * 256 + tid]; a0 += blk[i] * w; a1 += blk[2048 + i] * w; a2 += blk[4096 + i] * w; a3 += blk[6144 + i] * w; }
        hid[tid] = gelu_tanh(a0); hid[256 + tid] = gelu_tanh(a1); hid[512 + tid] = gelu_tanh(a2); hid[768 + tid] = gelu_tanh(a3);
        __syncthreads();
        const int g = tid >> 6, d = tid & 63, n = g4 * 4 + g; float o = 0.f;
        for (int j = 0; j < 256; ++j) o += hid[g * 256 + j] * w2j[j * 64 + d];
        float* dst = kv ? vcmp : kcmp; dst[((size_t)b * 128 + n) * 64 + d] = (n < 127) ? o : 0.f;
        __syncthreads();
    }
}

__device__ __forceinline__ void nv_nsa(const Ctx& c_, int L) {
    Ctx c = c_; c.lane = (int)__builtin_amdgcn_mbcnt_hi(~0u, __builtin_amdgcn_mbcnt_lo(~0u, 0u)); asm volatile("" : "+v"(c.lane)); c.tid = c.wave * 64 + c.lane; asm volatile("" : "+s"(c.bid)); asm volatile("" : "+s"(c.ws));
    const bf16_t* Z = (const bf16_t*)(c.ws + WS_Z); const float* kcmp = (const float*)(c.ws + WS_KCMP); const float* vcmp = (const float*)(c.ws + WS_VCMP); bf16_t* Y = (bf16_t*)(c.ws + WS_Y); const float* hg = c.head_g + (size_t)L * DM;
    const int half = c.tid >> 8, tid = c.tid & 255, h = tid >> 6, lane = tid & 63;
    float* base = (float*)(c.lds + 40960 + half * 12288);
    float* qs = base;
    float* pc = base + 256;
    float* Psum = base + 768;
    float* pslc = base + 896;
    unsigned* selmask = (unsigned*)(base + 928);
    float* sc = base + 1024;
    for (int m0 = c.bid * 2; m0 < MTOK; m0 += c.nb * 2) {
        const int m = m0 + half, b = m / SEQ, t = m % SEQ, cur = t >> 6;
        const bf16_t* zr = Z + (size_t)m * DINP;
        qs[h * 64 + lane] = bf2f(zr[ZC_NQ + h * 64 + lane]);
        pc[h * 128 + lane] = 0.f; pc[h * 128 + lane + 64] = 0.f;
        __syncthreads();
        const int nvis = t >= 31 ? (t - 31) / 16 + 1 : 0;
        const float* kc = kcmp + (size_t)b * 128 * 64; const float* vc = vcmp + (size_t)b * 128 * 64;
        float o_cmp = 0.f;
        if (nvis > 0) {
            float s0 = -INFINITY, s1 = -INFINITY;
            if (lane < nvis) { float s = 0.f; for (int d = 0; d < 64; ++d) s += qs[h * 64 + d] * kc[lane * 64 + d]; s0 = s * 0.125f; }
            if (lane + 64 < nvis) { float s = 0.f; for (int d = 0; d < 64; ++d) s += qs[h * 64 + d] * kc[(lane + 64) * 64 + d]; s1 = s * 0.125f; }
            const float mx = wave_max(fmaxf(s0, s1));
            const float p0 = lane < nvis ? __expf(s0 - mx) : 0.f, p1 = lane + 64 < nvis ? __expf(s1 - mx) : 0.f;
            const float sum = wave_sum(p0 + p1);
            pc[h * 128 + lane] = p0 / sum; pc[h * 128 + lane + 64] = p1 / sum;
        }
        __syncthreads();
        if (nvis > 0) { for (int n = 0; n < nvis; ++n) o_cmp += pc[h * 128 + n] * vc[n * 64 + lane]; }
        if (tid < 128) Psum[tid] = pc[tid] + pc[128 + tid] + pc[256 + tid] + pc[384 + tid];
        __syncthreads();
        if (tid < 32) { const int j = tid; float s = 0.f;
            if (4 * j - 1 >= 0) s += 0.5f * Psum[4 * j - 1];
            s += Psum[4 * j]; s += Psum[4 * j + 1]; s += Psum[4 * j + 2];
            if (4 * j + 3 <= 126) s += 0.5f * Psum[4 * j + 3];
            pslc[j] = s; }
        __syncthreads();
        if (tid == 0) {
            unsigned mask;
            if (cur <= 7) mask = (2u << cur) - 1u;
            else { mask = 1u | (1u << cur) | (1u << (cur - 1));
                for (int k = 0; k < 5; ++k) { int best = -1; float bv = -INFINITY; for (int j = 1; j <= cur - 2; ++j) if (!((mask >> j) & 1u) && pslc[j] > bv) { bv = pslc[j]; best = j; }
                    if (best < 0) { for (int j = 1; j <= cur - 2; ++j) if (!((mask >> j) & 1u)) { best = j; break; } }
                    mask |= 1u << best; } }
            *selmask = mask;
        }
        __syncthreads();
        const unsigned mask = *selmask;
        const bf16_t* Zb = Z + (size_t)b * SEQ * DINP;
        float o_sel, o_win;
        {
            int cnt = 0; float mx = -INFINITY;
            for (int j = 0; j <= cur; ++j) if ((mask >> j) & 1u) { const int key = j * 64 + lane; float s = -INFINITY;
                if (key <= t) { const bf16_t* kr = Zb + (size_t)key * DINP + ZC_KSL; float a = 0.f; for (int d = 0; d < 64; ++d) a += qs[h * 64 + d] * bf2f(kr[d]); s = a * 0.125f; }
                sc[h * 512 + cnt * 64 + lane] = s; mx = fmaxf(mx, s); ++cnt; }
            mx = wave_max(mx); float sum = 0.f;
            for (int i = 0; i < cnt; ++i) { const float s = sc[h * 512 + i * 64 + lane]; const float p = (s == -INFINITY) ? 0.f : __expf(s - mx); sc[h * 512 + i * 64 + lane] = p; sum += p; }
            sum = wave_sum(sum);
            __syncthreads();
            float acc = 0.f; int i = 0;
            for (int j = 0; j <= cur; ++j) if ((mask >> j) & 1u) { for (int k = 0; k < 64; ++k) acc += sc[h * 512 + i * 64 + k] * bf2f(Zb[(size_t)(j * 64 + k) * DINP + ZC_VSL + lane]); ++i; }
            o_sel = acc / sum;
            __syncthreads();
        }
        {
            float mx = -INFINITY;
            for (int i = 0; i < 8; ++i) { const int key = t - 511 + i * 64 + lane; float s = -INFINITY;
                if (key >= 0) { const bf16_t* kr = Zb + (size_t)key * DINP + ZC_KWN; float a = 0.f; for (int d = 0; d < 64; ++d) a += qs[h * 64 + d] * bf2f(kr[d]); s = a * 0.125f; }
                sc[h * 512 + i * 64 + lane] = s; mx = fmaxf(mx, s); }
            mx = wave_max(mx); float sum = 0.f;
            for (int i = 0; i < 8; ++i) { const float s = sc[h * 512 + i * 64 + lane]; const float p = (s == -INFINITY) ? 0.f : __expf(s - mx); sc[h * 512 + i * 64 + lane] = p; sum += p; }
            sum = wave_sum(sum);
            __syncthreads();
            float acc = 0.f;
            for (int kk = 0; kk < 512; ++kk) { const int key = t - 511 + kk; if (key >= 0) acc += sc[h * 512 + kk] * bf2f(Zb[(size_t)key * DINP + ZC_VWN + lane]); }
            o_win = acc / sum;
        }
        const float g0 = sigmoidf_(bf2f(zr[ZC_NG + h * 3 + 0])), g1 = sigmoidf_(bf2f(zr[ZC_NG + h * 3 + 1])), g2 = sigmoidf_(bf2f(zr[ZC_NG + h * 3 + 2]));
        const float o = g0 * o_cmp + g1 * o_sel + g2 * o_win;
        const float ss = wave_sum(o * o);
        Y[(size_t)m * DM + 768 + h * 64 + lane] = f2bf(o * rsqrtf(ss * (1.f / 64.f) + EPS) * hg[768 + h * 64 + lane]);
        __syncthreads();
    }
}

__device__ __forceinline__ void nv_ml_conv(const Ctx& c_, int L) {
    Ctx c = c_; c.lane = (int)__builtin_amdgcn_mbcnt_hi(~0u, __builtin_amdgcn_mbcnt_lo(~0u, 0u)); asm volatile("" : "+v"(c.lane)); c.tid = c.wave * 64 + c.lane; asm volatile("" : "+s"(c.bid)); asm volatile("" : "+s"(c.ws));
    const bf16_t* Z = (const bf16_t*)(c.ws + WS_Z); bf16_t* QKC = (bf16_t*)(c.ws + WS_QKC); float* gates = (float*)(c.ws + WS_GATES);
    const float* cw = c.conv_w + (size_t)L * 4 * 512; const float* cb = c.conv_b + (size_t)L * 512; const float* gb = c.gate_b + (size_t)L * 8;
    const int tid = c.tid;
    for (int m = c.bid; m < MTOK; m += c.nb) { const int t = m % SEQ;
        float a = cb[tid];
#pragma unroll
        for (int j = 0; j < 4; ++j) { const int tt = t - 3 + j; if (tt >= 0) a += bf2f(Z[(size_t)(m - 3 + j) * DINP + ZC_LQ + tid]) * cw[j * 512 + tid]; }
        float y = a / (1.f + __expf(-a)); if (tid >= 256) y *= 0.125f;
        QKC[(size_t)m * 512 + tid] = f2bf(y);
        if (tid < 4) gates[(size_t)m * 8 + tid] = bf2f(Z[(size_t)m * DINP + ZC_LI + tid]) + gb[tid];
        else if (tid < 8) { const float x = bf2f(Z[(size_t)m * DINP + ZC_LF + (tid - 4)]) + gb[tid]; gates[(size_t)m * 8 + tid] = fminf(x, 0.f) - log1pf(__expf(-fabsf(x))); }
    }
}
__device__ __forceinline__ void nv_ml(const Ctx& c_) {
    Ctx c = c_; c.lane = (int)__builtin_amdgcn_mbcnt_hi(~0u, __builtin_amdgcn_mbcnt_lo(~0u, 0u)); asm volatile("" : "+v"(c.lane)); c.tid = c.wave * 64 + c.lane; asm volatile("" : "+s"(c.bid)); asm volatile("" : "+s"(c.ws));
    if (c.bid >= 64) return;
    const bf16_t* Z = (const bf16_t*)(c.ws + WS_Z); const bf16_t* QKC = (const bf16_t*)(c.ws + WS_QKC); const float* gates = (const float*)(c.ws + WS_GATES); float* HID = (float*)(c.ws + WS_HID);
    const int b = c.bid >> 2, h = c.bid & 3, tid = c.tid, v = tid >> 2, kq = (tid & 3) * 16;
    float C[16], nn[16];
#pragma unroll
    for (int j = 0; j < 16; ++j) { C[j] = 0.f; nn[j] = 0.f; }
    for (int t = 0; t < SEQ; ++t) { const size_t m = (size_t)b * SEQ + t;
        const float ig = gates[m * 8 + h], lf = gates[m * 8 + 4 + h]; const float f = __expf(lf), ii = __expf(ig), iv = ii * bf2f(Z[m * DINP + ZC_LV + h * 128 + v]);
        const uint4* qp = (const uint4*)(QKC + m * 512 + h * 64 + kq); const uint4* kp = (const uint4*)(QKC + m * 512 + 256 + h * 64 + kq);
        const uint4 q0 = qp[0], q1 = qp[1], k0 = kp[0], k1 = kp[1];
        const unsigned qw[8] = {q0.x, q0.y, q0.z, q0.w, q1.x, q1.y, q1.z, q1.w}, kw[8] = {k0.x, k0.y, k0.z, k0.w, k1.x, k1.y, k1.z, k1.w};
        float num = 0.f, den = 0.f;
#pragma unroll
        for (int j = 0; j < 8; ++j) { const float ka = __uint_as_float(kw[j] << 16), kb = __uint_as_float(kw[j] & 0xffff0000u), qa = __uint_as_float(qw[j] << 16), qb = __uint_as_float(qw[j] & 0xffff0000u);
            C[2 * j] = f * C[2 * j] + iv * ka; C[2 * j + 1] = f * C[2 * j + 1] + iv * kb; nn[2 * j] = f * nn[2 * j] + ii * ka; nn[2 * j + 1] = f * nn[2 * j + 1] + ii * kb;
            num += C[2 * j] * qa + C[2 * j + 1] * qb; den += nn[2 * j] * qa + nn[2 * j + 1] * qb; }
        num += __shfl_xor(num, 1); num += __shfl_xor(num, 2); den += __shfl_xor(den, 1); den += __shfl_xor(den, 2);
        if ((tid & 3) == 0) HID[m * 512 + h * 128 + v] = num / fmaxf(fabsf(den), 1.f);
    }
}
__device__ __forceinline__ void nv_ml_post(const Ctx& c_, int L) {
    Ctx c = c_; c.lane = (int)__builtin_amdgcn_mbcnt_hi(~0u, __builtin_amdgcn_mbcnt_lo(~0u, 0u)); asm volatile("" : "+v"(c.lane)); c.tid = c.wave * 64 + c.lane; asm volatile("" : "+s"(c.bid)); asm volatile("" : "+s"(c.ws));
    const bf16_t* Z = (const bf16_t*)(c.ws + WS_Z); const float* HID = (const float*)(c.ws + WS_HID); bf16_t* Y = (bf16_t*)(c.ws + WS_Y); const float* hg = c.head_g + (size_t)L * DM;
    float* part = (float*)(c.lds + 65536); const int tid = c.tid, w = c.wave;
    for (int m = c.bid; m < MTOK; m += c.nb) {
        const float x = HID[(size_t)m * 512 + tid]; const float s = wave_sum(x * x);
        if ((tid & 63) == 0) part[w] = s;
        __syncthreads();
        const float ss = part[(w & ~1)] + part[(w | 1)];
        const float lo = bf2f(Z[(size_t)m * DINP + ZC_LO + tid]);
        Y[(size_t)m * DM + 256 + tid] = f2bf(x * rsqrtf(ss * (1.f / 128.f) + EPS) * hg[256 + tid] * sigmoidf_(lo));
        __syncthreads();
    }
}

typedef float f32x16 __attribute__((ext_vector_type(16)));
typedef short bf16x8v __attribute__((ext_vector_type(8)));
typedef short s16x4v __attribute__((ext_vector_type(4)));
typedef unsigned u32x4v __attribute__((ext_vector_type(4)));
constexpr int AT_KROW = 144, AT_VROW = 192;
constexpr int AT_KTILE = 64 * AT_KROW, AT_VTILE = 64 * AT_VROW;
constexpr int AT_K0 = 0, AT_V0 = 2 * AT_KTILE, AT_MISC = AT_V0 + 2 * AT_VTILE;
constexpr float AT_C = 0.125f * 1.4426950408889634f;

__device__ __forceinline__ int crow16(int r, int hi) { return (r & 3) + 8 * (r >> 2) + 4 * hi; }
__device__ __forceinline__ unsigned cvtpk(float lo, float hi) { unsigned r; asm("v_cvt_pk_bf16_f32 %0, %1, %2" : "=v"(r) : "v"(lo), "v"(hi)); return r; }
__device__ __forceinline__ float xhalf_max(float v) { auto rr = __builtin_amdgcn_permlane32_swap(__float_as_uint(v), __float_as_uint(v), false, false); return fmaxf(__uint_as_float(rr[0]), __uint_as_float(rr[1])); }
__device__ __forceinline__ float xhalf_sum(float v) { auto rr = __builtin_amdgcn_permlane32_swap(__float_as_uint(v), __float_as_uint(v), false, false); return __uint_as_float(rr[0]) + __uint_as_float(rr[1]); }

struct AttnSt { f32x16 o0, o1; float m, l; };
__device__ __forceinline__ void attn_init(AttnSt& s) { s.o0 = (f32x16){}; s.o1 = (f32x16){}; s.m = -1e30f; s.l = 0.f; }

template <int BOUNDS  >
__device__ __forceinline__ void attn_tile(AttnSt& st, const bf16x8v (&qf)[4], const LAS unsigned char* Kt, const LAS unsigned char* Vt, int r32, int hi, int lane, bool rowsel, int kbase, int klo, int khi) {
    asm volatile("" : "+v"(r32), "+v"(hi), "+v"(lane));
    f32x16 p0 = (f32x16){}, p1 = (f32x16){};
    const LAS unsigned char* kp = Kt + r32 * AT_KROW + hi * 16;
#pragma unroll
    for (int d0 = 0; d0 < 4; ++d0) {
        const bf16x8v k0 = *(const LAS bf16x8v*)(kp + d0 * 32);
        const bf16x8v k1 = *(const LAS bf16x8v*)(kp + 32 * AT_KROW + d0 * 32);
        p0 = __builtin_amdgcn_mfma_f32_32x32x16_bf16(k0, qf[d0], p0, 0, 0, 0);
        p1 = __builtin_amdgcn_mfma_f32_32x32x16_bf16(k1, qf[d0], p1, 0, 0, 0);
    }
    if (BOUNDS) {
        const int hi_c = khi - kbase - 4 * hi, lo_c = klo - kbase - 4 * hi;
#pragma unroll
        for (int r = 0; r < 16; ++r) { const int cr = (r & 3) + 8 * (r >> 2);
            if (BOUNDS == 2) { if (cr > hi_c || cr < lo_c) p0[r] = -INFINITY; if (cr + 32 > hi_c || cr + 32 < lo_c) p1[r] = -INFINITY; }
            else { if (cr > hi_c) p0[r] = -INFINITY; if (cr + 32 > hi_c) p1[r] = -INFINITY; } }
    }
    float mx = fmaxf(p0[0], p1[0]);
#pragma unroll
    for (int r = 1; r < 16; ++r) mx = fmaxf(mx, fmaxf(p0[r], p1[r]));
    mx = xhalf_max(mx);
    if (!rowsel) mx = -INFINITY;
    const float mnew = fmaxf(st.m, mx);
    const float alpha = __builtin_amdgcn_exp2f((st.m - mnew) * AT_C);
    const float sub = rowsel ? mnew * AT_C : 1e30f;
    float ps = 0.f;
#pragma unroll
    for (int r = 0; r < 16; ++r) { p0[r] = __builtin_amdgcn_exp2f(__builtin_fmaf(p0[r], AT_C, -sub)); p1[r] = __builtin_amdgcn_exp2f(__builtin_fmaf(p1[r], AT_C, -sub)); ps += p0[r] + p1[r]; }
    st.l = st.l * alpha + ps; st.m = mnew;
#pragma unroll
    for (int r = 0; r < 16; ++r) { st.o0[r] *= alpha; st.o1[r] *= alpha; }
    bf16x8v pf[4];
    { u32x4v w;
      w = (u32x4v){cvtpk(p0[0], p0[1]), cvtpk(p0[2], p0[3]), cvtpk(p0[4], p0[5]), cvtpk(p0[6], p0[7])}; pf[0] = __builtin_bit_cast(bf16x8v, w);
      w = (u32x4v){cvtpk(p0[8], p0[9]), cvtpk(p0[10], p0[11]), cvtpk(p0[12], p0[13]), cvtpk(p0[14], p0[15])}; pf[1] = __builtin_bit_cast(bf16x8v, w);
      w = (u32x4v){cvtpk(p1[0], p1[1]), cvtpk(p1[2], p1[3]), cvtpk(p1[4], p1[5]), cvtpk(p1[6], p1[7])}; pf[2] = __builtin_bit_cast(bf16x8v, w);
      w = (u32x4v){cvtpk(p1[8], p1[9]), cvtpk(p1[10], p1[11]), cvtpk(p1[12], p1[13]), cvtpk(p1[14], p1[15])}; pf[3] = __builtin_bit_cast(bf16x8v, w); }
    const int li = lane & 15, g = lane >> 4;
    const LAS unsigned char* vp = Vt + (4 * (g >> 1) + (li >> 2)) * AT_VROW + (16 * (g & 1) + 4 * (li & 3)) * 2;
#pragma unroll
    for (int ks = 0; ks < 4; ++ks) {
#pragma unroll
        for (int dh = 0; dh < 2; ++dh) {
            const s16x4v a = __builtin_bit_cast(s16x4v, __builtin_amdgcn_ds_read_tr16_b64_v4i16((LAS s16x4v*)(vp + (16 * ks) * AT_VROW + dh * 64)));
            const s16x4v b = __builtin_bit_cast(s16x4v, __builtin_amdgcn_ds_read_tr16_b64_v4i16((LAS s16x4v*)(vp + (16 * ks + 8) * AT_VROW + dh * 64)));
            const bf16x8v vf = (bf16x8v){a[0], a[1], a[2], a[3], b[0], b[1], b[2], b[3]};
            if (dh == 0) st.o0 = __builtin_amdgcn_mfma_f32_32x32x16_bf16(vf, pf[ks], st.o0, 0, 0, 0);
            else         st.o1 = __builtin_amdgcn_mfma_f32_32x32x16_bf16(vf, pf[ks], st.o1, 0, 0, 0);
        }
    }
}

struct KVRegs { u32x4v k, v; };
__device__ __forceinline__ void kv_load(KVRegs& r, const bf16_t* Kg, const bf16_t* Vg, size_t pitch, int tid) {
    const size_t off = (size_t)(tid >> 3) * pitch + (tid & 7) * 8;
    r.k = *(const u32x4v*)(Kg + off); r.v = *(const u32x4v*)(Vg + off);
}
__device__ __forceinline__ void kv_store(const KVRegs& r, LAS unsigned char* Kt, LAS unsigned char* Vt, int tid) {
    *(LAS u32x4v*)(Kt + (tid >> 3) * AT_KROW + (tid & 7) * 16) = r.k;
    *(LAS u32x4v*)(Vt + (tid >> 3) * AT_VROW + (tid & 7) * 16) = r.v;
}

__device__ __forceinline__ void attn_store_headnorm(const f32x16& o0, const f32x16& o1, bf16_t* Yrow  , const float* g  , int hi) {
    float ss = 0.f;
#pragma unroll
    for (int r = 0; r < 16; ++r) ss += o0[r] * o0[r] + o1[r] * o1[r];
    ss = xhalf_sum(ss);
    const float rn = rsqrtf(ss * (1.f / 64.f) + EPS);
#pragma unroll
    for (int dh = 0; dh < 2; ++dh)
#pragma unroll
        for (int q4 = 0; q4 < 4; ++q4) { const int d = 32 * dh + 8 * q4 + 4 * hi; const float4 gg = *(const float4*)(g + d);
            const f32x16& o = dh ? o1 : o0;
            uint2 w; w.x = cvtpk(o[4 * q4] * rn * gg.x, o[4 * q4 + 1] * rn * gg.y); w.y = cvtpk(o[4 * q4 + 2] * rn * gg.z, o[4 * q4 + 3] * rn * gg.w);
            *(uint2*)(Yrow + d) = w; }
}

__device__ __forceinline__ void ph_kmean(const Ctx& c_) {
    Ctx c = c_; c.lane = (int)__builtin_amdgcn_mbcnt_hi(~0u, __builtin_amdgcn_mbcnt_lo(~0u, 0u)); asm volatile("" : "+v"(c.lane)); c.tid = c.wave * 64 + c.lane; asm volatile("" : "+s"(c.bid)); asm volatile("" : "+s"(c.ws));
    const bf16_t* Z = (const bf16_t*)(c.ws + WS_Z); float* kmean = (float*)(c.ws + WS_KMEAN); LAS float* red = (LAS float*)((LAS unsigned char*)c.lds);
    for (int it = c.bid; it < 512; it += c.nb) {
        const int bh = it >> 3, n = it & 7, b = bh >> 2, h = bh & 3;
        const bf16_t* p = Z + ((size_t)b * SEQ + n * 256 + c.wave * 32) * DINP + ZC_MK + h * 64 + c.lane; float s = 0.f;
#pragma unroll 8
        for (int i = 0; i < 32; ++i) s += bf2f(p[(size_t)i * DINP]);
        red[c.tid] = s;
        __syncthreads();
        if (c.wave == 0) { float t = 0.f;
#pragma unroll
            for (int k = 0; k < 8; ++k) t += red[k * 64 + c.lane];
            kmean[(size_t)it * 64 + c.lane] = t * (1.f / 256.f); }
        __syncthreads();
    }
}

__device__ __forceinline__ void moba_unit(const Ctx& c, int L, int b, int h, int qb) {
    const bf16_t* Z = (const bf16_t*)(c.ws + WS_Z); bf16_t* Y = (bf16_t*)(c.ws + WS_Y);
    LAS unsigned char* lds = (LAS unsigned char*)c.lds;
    const int tid = c.tid, lane = c.lane, wave = c.wave, r32 = lane & 31, hi = lane >> 5;
    LAS float* km = (LAS float*)(lds + AT_MISC);
    { const float* kmg = (const float*)(c.ws + WS_KMEAN) + (size_t)(b * 4 + h) * 512; km[tid] = kmg[tid]; }
    const size_t rowq = (size_t)b * SEQ + 256 * qb + 32 * wave + r32;
    bf16x8v qf[4];
#pragma unroll
    for (int d0 = 0; d0 < 4; ++d0) qf[d0] = *(const bf16x8v*)(Z + rowq * DINP + ZC_MQ + h * 64 + 16 * d0 + 8 * hi);
    const bf16_t* Kg = Z + (size_t)b * SEQ * DINP + ZC_MK + h * 64; const bf16_t* Vg = Z + (size_t)b * SEQ * DINP + ZC_MV + h * 64;
    const int NT = 4 * (qb + 1);
    KVRegs kv; kv_load(kv, Kg, Vg, DINP, tid);
    __syncthreads();
    unsigned selbits;
    if (qb <= 3) selbits = (1u << qb) - 1u;
    else {
        float gt[7];
#pragma unroll
        for (int n = 0; n < 7; ++n) { float a = 0.f;
            if (n < qb) {
#pragma unroll
                for (int d0 = 0; d0 < 4; ++d0)
#pragma unroll
                    for (int j = 0; j < 8; ++j) a += bf2f((bf16_t)qf[d0][j]) * km[n * 64 + 16 * d0 + 8 * hi + j];
            }
            gt[n] = xhalf_sum(a); }
        selbits = 0u;
#pragma unroll
        for (int k = 0; k < 3; ++k) { int best = -1; float bv = -INFINITY;
#pragma unroll
            for (int n = 0; n < 7; ++n) if (n < qb && !((selbits >> n) & 1u) && gt[n] > bv) { bv = gt[n]; best = n; }
            if (best < 0) {
#pragma unroll
                for (int n = 6; n >= 0; --n) if (n < qb && !((selbits >> n) & 1u)) best = n; }
            selbits |= 1u << best; }
    }
    kv_store(kv, lds + AT_K0, lds + AT_V0, tid);
    __syncthreads();
    AttnSt st; attn_init(st);
    const int qrel = 32 * wave + r32;
    for (int ti = 0; ti < NT; ++ti) {
        const int buf = ti & 1;
        if (ti + 1 < NT) kv_load(kv, Kg + (size_t)(ti + 1) * 64 * DINP, Vg + (size_t)(ti + 1) * 64 * DINP, DINP, tid);
        const LAS unsigned char* Kt = lds + AT_K0 + buf * AT_KTILE; const LAS unsigned char* Vt = lds + AT_V0 + buf * AT_VTILE;
        const int j = ti >> 2;
        if (j < qb) attn_tile<0>(st, qf, Kt, Vt, r32, hi, lane, ((selbits >> j) & 1u) != 0u, 0, 0, 0);
        else { const int k0 = (ti & 3) * 64;
            if (k0 <= 32 * wave + 31) {
                if (k0 + 63 <= 32 * wave) attn_tile<0>(st, qf, Kt, Vt, r32, hi, lane, true, 0, 0, 0);
                else attn_tile<1>(st, qf, Kt, Vt, r32, hi, lane, true, k0, 0, qrel);
            } }
        if (ti + 1 < NT) kv_store(kv, lds + AT_K0 + (buf ^ 1) * AT_KTILE, lds + AT_V0 + (buf ^ 1) * AT_VTILE, tid);
        __syncthreads();
    }
    const float lt = xhalf_sum(st.l); const float inv = 1.f / lt;
#pragma unroll
    for (int r = 0; r < 16; ++r) { st.o0[r] *= inv; st.o1[r] *= inv; }
    attn_store_headnorm(st.o0, st.o1, Y + rowq * DM + h * 64, c.head_g + (size_t)L * DM + h * 64, hi);
}
__device__ __forceinline__ void ph_moba(const Ctx& c_, int L) {
    Ctx c = c_; c.lane = (int)__builtin_amdgcn_mbcnt_hi(~0u, __builtin_amdgcn_mbcnt_lo(~0u, 0u)); asm volatile("" : "+v"(c.lane)); c.tid = c.wave * 64 + c.lane; asm volatile("" : "+s"(c.bid)); asm volatile("" : "+s"(c.ws));
    for (int pi = c.bid; pi < 256; pi += c.nb) {
        const int bh = pi >> 2, s = pi & 3;
        moba_unit(c, L, bh >> 2, bh & 3, s);
        moba_unit(c, L, bh >> 2, bh & 3, 7 - s);
    }
}

constexpr size_t WS_KCB = 29 * MiB + 512 * 1024, WS_VCB = 29 * MiB + 768 * 1024;

__device__ __forceinline__ void ph_wconv_cmp(const Ctx& c_, int L) {
    Ctx c = c_; c.lane = (int)__builtin_amdgcn_mbcnt_hi(~0u, __builtin_amdgcn_mbcnt_lo(~0u, 0u)); asm volatile("" : "+v"(c.lane)); c.tid = c.wave * 64 + c.lane; asm volatile("" : "+s"(c.bid)); asm volatile("" : "+s"(c.ws));
    const int half = c.tid >> 8, t256 = c.tid & 255; float* tile = (float*)(c.lds) + half * (64 * 65);
    constexpr int T_1 = (2048 / 64) * (256 / 64), T_2 = (256 / 64) * 1, TOT = 2 * (T_1 + T_2);
    for (int base = c.bid * 2; base < TOT; base += c.nb * 2) {
        int it = base + half; const bool act = it < TOT; if (!act) it = 0;
        const int kv = it / (T_1 + T_2); it -= kv * (T_1 + T_2);
        const float* src; bf16_t* dst; int K, N;
        if (it < T_1) { src = c.cmp_w1 + ((size_t)L * 2 + kv) * 2048 * 256; dst = (bf16_t*)(c.ws + WS_CW1) + (size_t)kv * 256 * 2048; K = 2048; N = 256; }
        else { it -= T_1; src = c.cmp_w2 + ((size_t)L * 2 + kv) * 256 * 64; dst = (bf16_t*)(c.ws + WS_CW2) + (size_t)kv * 64 * 256; K = 256; N = 64; }
        wconv_tile(src, dst, K, N, N, it, t256, tile, act);
    }
}

__device__ __forceinline__ void ph_cpe_all(const Ctx& c_) {
    Ctx c = c_; c.lane = (int)__builtin_amdgcn_mbcnt_hi(~0u, __builtin_amdgcn_mbcnt_lo(~0u, 0u)); asm volatile("" : "+v"(c.lane)); c.tid = c.wave * 64 + c.lane; asm volatile("" : "+s"(c.bid)); asm volatile("" : "+s"(c.ws));
    float* red = (float*)(c.lds + 40960);
    for (int item = c.bid; item < DEPTH * 2 * 16; item += c.nb) {
        const int lk = item >> 4, j0 = (item & 15) * 16, jj = c.tid & 15, ig = c.tid >> 4;
        const float* pe = c.cmp_pe + (size_t)lk * 2048; const float* w = c.cmp_w1 + (size_t)lk * 2048 * 256 + j0 + jj;
        float a = 0.f;
#pragma unroll 8
        for (int i = ig; i < 2048; i += 32) a += pe[i] * w[(size_t)i * 256];
        red[c.tid] = a;
        __syncthreads();
        if (c.tid < 16) { float s = 0.f; for (int k = 0; k < 32; ++k) s += red[k * 16 + c.tid]; ((float*)(c.ws + WS_CPE))[lk * 256 + j0 + c.tid] = s; }
        __syncthreads();
    }
}

__device__ __forceinline__ void ph_cmp(const Ctx& c_, int L) {
    Ctx c = c_; c.lane = (int)__builtin_amdgcn_mbcnt_hi(~0u, __builtin_amdgcn_mbcnt_lo(~0u, 0u)); asm volatile("" : "+v"(c.lane)); c.tid = c.wave * 64 + c.lane; asm volatile("" : "+s"(c.bid)); asm volatile("" : "+s"(c.ws));
    const bf16_t* Z = (const bf16_t*)(c.ws + WS_Z); const bf16_t* W1t = (const bf16_t*)(c.ws + WS_CW1); const bf16_t* W2t = (const bf16_t*)(c.ws + WS_CW2); const float* cpe = (const float*)(c.ws + WS_CPE);
    LAS unsigned char* lds = (LAS unsigned char*)c.lds;
    const int lane = c.lane, w = c.wave, r32 = lane & 31, hi = lane >> 5;
    constexpr int HROW = 528;
    for (int item = c.bid; item < 128; item += c.nb) {
        const int b = item >> 3, kv = (item >> 2) & 1, mt = item & 3; const int col = kv ? ZC_VC : ZC_KC;
        const int n = 32 * mt + r32, nld = n < 127 ? n : 126;
        const bf16_t* arow = Z + ((size_t)b * SEQ + 16 * nld) * DINP + col + 8 * hi;
        const bf16_t* brow = W1t + ((size_t)kv * 256 + 32 * w + r32) * 2048 + 8 * hi;
        f32x16 acc = (f32x16){};
#pragma unroll 8
        for (int ks = 0; ks < 128; ++ks) {
            const bf16x8v a = *(const bf16x8v*)(arow + (size_t)(ks >> 2) * DINP + 16 * (ks & 3));
            const bf16x8v bb = *(const bf16x8v*)(brow + 16 * ks);
            acc = __builtin_amdgcn_mfma_f32_32x32x16_bf16(a, bb, acc, 0, 0, 0);
        }
        const float bias = cpe[(L * 2 + kv) * 256 + 32 * w + r32];
#pragma unroll
        for (int r = 0; r < 16; ++r) *(LAS bf16_t*)(lds + crow16(r, hi) * HROW + (32 * w + r32) * 2) = f2bf(gelu_tanh(acc[r] + bias));
        __syncthreads();
        if (w < 2) {
            f32x16 acc2 = (f32x16){};
            const bf16_t* b2 = W2t + ((size_t)kv * 64 + 32 * w + r32) * 256 + 8 * hi;
#pragma unroll
            for (int ks = 0; ks < 16; ++ks) {
                const bf16x8v a = *(const LAS bf16x8v*)(lds + r32 * HROW + (16 * ks + 8 * hi) * 2);
                const bf16x8v bb = *(const bf16x8v*)(b2 + 16 * ks);
                acc2 = __builtin_amdgcn_mfma_f32_32x32x16_bf16(a, bb, acc2, 0, 0, 0);
            }
            bf16_t* dst = (bf16_t*)(c.ws + (kv ? WS_VCB : WS_KCB)) + ((size_t)b * 128 + 32 * mt) * 64 + 32 * w + r32;
#pragma unroll
            for (int r = 0; r < 16; ++r) { const int nn = crow16(r, hi); dst[nn * 64] = (32 * mt + nn < 127) ? f2bf(acc2[r]) : (bf16_t)0; }
        }
        __syncthreads();
    }
}

constexpr int NS_A = AT_MISC, NS_B = NS_A + 4 * 64 * 33 * 4, NS_SEL = NS_B + 4 * 64 * 33 * 4;
static_assert(NS_SEL + 256 <= 131072, "NSA LDS map");

__device__ __forceinline__ void nsa_unit(const Ctx& c, int L, int b, int ch) {
    const bf16_t* Z = (const bf16_t*)(c.ws + WS_Z); bf16_t* Y = (bf16_t*)(c.ws + WS_Y);
    LAS unsigned char* lds = (LAS unsigned char*)c.lds;
    const int tid = c.tid, lane = c.lane, wave = c.wave, r32 = lane & 31, hi = lane >> 5, head = wave >> 1, tq = 32 * (wave & 1) + r32, t = 64 * ch + tq;
    const size_t rowq = (size_t)b * SEQ + t;
    bf16x8v qf[4];
#pragma unroll
    for (int d0 = 0; d0 < 4; ++d0) qf[d0] = *(const bf16x8v*)(Z + rowq * DINP + ZC_NQ + head * 64 + 16 * d0 + 8 * hi);
    const float g0 = sigmoidf_(bf2f(Z[rowq * DINP + ZC_NG + head * 3 + 0])), g1 = sigmoidf_(bf2f(Z[rowq * DINP + ZC_NG + head * 3 + 1])), g2 = sigmoidf_(bf2f(Z[rowq * DINP + ZC_NG + head * 3 + 2]));
    const bool two = ch >= 16;
    { const bf16_t* KC = (const bf16_t*)(c.ws + WS_KCB) + (size_t)b * 128 * 64; const bf16_t* VC = (const bf16_t*)(c.ws + WS_VCB) + (size_t)b * 128 * 64;
      KVRegs kv; kv_load(kv, KC, VC, 64, tid); kv_store(kv, lds + AT_K0, lds + AT_V0, tid);
      if (two) { kv_load(kv, KC + 64 * 64, VC + 64 * 64, 64, tid); kv_store(kv, lds + AT_K0 + AT_KTILE, lds + AT_V0 + AT_VTILE, tid); } }
    __syncthreads();
    f32x16 acc0, acc1;
    {
        const int nvis = t >= 31 ? (t - 31) / 16 + 1 : 0;
        f32x16 p[4];
#pragma unroll
        for (int i = 0; i < 4; ++i) p[i] = (f32x16){};
        { const LAS unsigned char* kp = lds + AT_K0 + r32 * AT_KROW + hi * 16;
#pragma unroll
          for (int d0 = 0; d0 < 4; ++d0) {
              p[0] = __builtin_amdgcn_mfma_f32_32x32x16_bf16(*(const LAS bf16x8v*)(kp + d0 * 32), qf[d0], p[0], 0, 0, 0);
              p[1] = __builtin_amdgcn_mfma_f32_32x32x16_bf16(*(const LAS bf16x8v*)(kp + 32 * AT_KROW + d0 * 32), qf[d0], p[1], 0, 0, 0); }
          if (two) {
#pragma unroll
              for (int d0 = 0; d0 < 4; ++d0) {
                  p[2] = __builtin_amdgcn_mfma_f32_32x32x16_bf16(*(const LAS bf16x8v*)(kp + AT_KTILE + d0 * 32), qf[d0], p[2], 0, 0, 0);
                  p[3] = __builtin_amdgcn_mfma_f32_32x32x16_bf16(*(const LAS bf16x8v*)(kp + AT_KTILE + 32 * AT_KROW + d0 * 32), qf[d0], p[3], 0, 0, 0); } } }
        float mx = -INFINITY; const int nlim = nvis - 4 * hi;
#pragma unroll
        for (int i = 0; i < 4; ++i)
#pragma unroll
            for (int r = 0; r < 16; ++r) { if (32 * i + (r & 3) + 8 * (r >> 2) >= nlim || (i >= 2 && !two)) p[i][r] = -INFINITY; mx = fmaxf(mx, p[i][r]); }
        mx = xhalf_max(mx);
        const float msub = nvis > 0 ? mx * AT_C : 0.f; float ps = 0.f;
#pragma unroll
        for (int i = 0; i < 4; ++i)
#pragma unroll
            for (int r = 0; r < 16; ++r) { p[i][r] = __builtin_amdgcn_exp2f(__builtin_fmaf(p[i][r], AT_C, -msub)); ps += p[i][r]; }
        ps = xhalf_sum(ps);
        const float inv = nvis > 0 ? 1.f / ps : 0.f;
        LAS float* Ab = (LAS float*)(lds + NS_A) + (head * 64 + tq) * 33; LAS float* Bb = (LAS float*)(lds + NS_B) + (head * 64 + tq) * 33;
#pragma unroll
        for (int i = 0; i < 4; ++i) {
#pragma unroll
            for (int r = 0; r < 16; ++r) p[i][r] *= inv;
#pragma unroll
            for (int g = 0; g < 4; ++g) { const int j = 8 * i + 2 * g + hi; const float hb = 0.5f * p[i][4 * g + 3];
                Ab[j] = p[i][4 * g] + p[i][4 * g + 1] + p[i][4 * g + 2] + hb; Bb[j] = hb; }
        }
        acc0 = (f32x16){}; acc1 = (f32x16){};
        const int li = lane & 15, g16 = lane >> 4;
        const LAS unsigned char* vp = lds + AT_V0 + (4 * (g16 >> 1) + (li >> 2)) * AT_VROW + (16 * (g16 & 1) + 4 * (li & 3)) * 2;
#pragma unroll
        for (int i = 0; i < 4; ++i) {
            if (i >= 2 && !two) break;
#pragma unroll
            for (int s = 0; s < 2; ++s) {
                const u32x4v wv = (u32x4v){cvtpk(p[i][8 * s], p[i][8 * s + 1]), cvtpk(p[i][8 * s + 2], p[i][8 * s + 3]), cvtpk(p[i][8 * s + 4], p[i][8 * s + 5]), cvtpk(p[i][8 * s + 6], p[i][8 * s + 7])};
                const bf16x8v pf = __builtin_bit_cast(bf16x8v, wv);
                const LAS unsigned char* vq = vp + (i >> 1) * AT_VTILE + (32 * (i & 1) + 16 * s) * AT_VROW;
#pragma unroll
                for (int dh = 0; dh < 2; ++dh) {
                    const s16x4v a = __builtin_bit_cast(s16x4v, __builtin_amdgcn_ds_read_tr16_b64_v4i16((LAS s16x4v*)(vq + dh * 64)));
                    const s16x4v bq = __builtin_bit_cast(s16x4v, __builtin_amdgcn_ds_read_tr16_b64_v4i16((LAS s16x4v*)(vq + 8 * AT_VROW + dh * 64)));
                    const bf16x8v vf = (bf16x8v){a[0], a[1], a[2], a[3], bq[0], bq[1], bq[2], bq[3]};
                    if (dh == 0) acc0 = __builtin_amdgcn_mfma_f32_32x32x16_bf16(vf, pf, acc0, 0, 0, 0);
                    else         acc1 = __builtin_amdgcn_mfma_f32_32x32x16_bf16(vf, pf, acc1, 0, 0, 0);
                }
            }
        }
#pragma unroll
        for (int r = 0; r < 16; ++r) { acc0[r] *= g0; acc1[r] *= g0; }
    }
    __syncthreads();
    if (tid < 64) {
        unsigned mask;
        if (ch <= 7) mask = (2u << ch) - 1u;
        else {
            LAS float* A0 = (LAS float*)(lds + NS_A) + tid * 33;
            for (int j = 1; j <= ch - 2; ++j) { float s = 0.f;
#pragma unroll
                for (int h = 0; h < 4; ++h) s += ((LAS float*)(lds + NS_A))[(h * 64 + tid) * 33 + j] + ((LAS float*)(lds + NS_B))[(h * 64 + tid) * 33 + j - 1];
                A0[j] = s; }
            mask = 1u | (1u << ch) | (1u << (ch - 1));
            for (int k = 0; k < 5; ++k) { int best = -1; float bv = -INFINITY;
                for (int j = 1; j <= ch - 2; ++j) { const float v = A0[j]; if (!((mask >> j) & 1u) && v > bv) { bv = v; best = j; } }
                if (best < 0) { for (int j = ch - 2; j >= 1; --j) if (!((mask >> j) & 1u)) best = j; }
                mask |= 1u << best; }
        }
        ((LAS unsigned*)(lds + NS_SEL))[tid] = mask;
    }
    __syncthreads();
    const unsigned selbits = ((LAS unsigned*)(lds + NS_SEL))[tq];
    const int wl = ch >= 8 ? ch - 8 : 0, nsel = ch + 1, ntot = nsel + (ch - wl + 1);
    const bf16_t* Zb = Z + (size_t)b * SEQ * DINP;
    KVRegs kv; kv_load(kv, Zb + ZC_KSL, Zb + ZC_VSL, DINP, tid); kv_store(kv, lds + AT_K0, lds + AT_V0, tid);
    __syncthreads();
    AttnSt st; attn_init(st);
    for (int s = 0; s < ntot; ++s) {
        const int buf = s & 1;
        if (s + 1 < ntot) { const int s1 = s + 1; const bool w1 = s1 >= nsel; const int j1 = w1 ? wl + (s1 - nsel) : s1;
            kv_load(kv, Zb + (size_t)j1 * 64 * DINP + (w1 ? ZC_KWN : ZC_KSL), Zb + (size_t)j1 * 64 * DINP + (w1 ? ZC_VWN : ZC_VSL), DINP, tid); }
        const LAS unsigned char* Kt = lds + AT_K0 + buf * AT_KTILE; const LAS unsigned char* Vt = lds + AT_V0 + buf * AT_VTILE;
        if (s == nsel) {
            const float inv = g1 / xhalf_sum(st.l);
#pragma unroll
            for (int r = 0; r < 16; ++r) { acc0[r] += st.o0[r] * inv; acc1[r] += st.o1[r] * inv; }
            attn_init(st);
        }
        if (s < nsel) { const int j = s;
            if (j == ch) attn_tile<1>(st, qf, Kt, Vt, r32, hi, lane, true, 64 * ch, 0, t);
            else attn_tile<0>(st, qf, Kt, Vt, r32, hi, lane, ((selbits >> j) & 1u) != 0u, 0, 0, 0);
        } else { const int j = wl + (s - nsel);
            if (j == ch) attn_tile<1>(st, qf, Kt, Vt, r32, hi, lane, true, 64 * ch, 0, t);
            else if (ch >= 8 && j == ch - 8) attn_tile<2>(st, qf, Kt, Vt, r32, hi, lane, true, 64 * j, t - 511, t);
            else attn_tile<0>(st, qf, Kt, Vt, r32, hi, lane, true, 0, 0, 0);
        }
        if (s + 1 < ntot) kv_store(kv, lds + AT_K0 + (buf ^ 1) * AT_KTILE, lds + AT_V0 + (buf ^ 1) * AT_VTILE, tid);
        __syncthreads();
    }
    { const float inv = g2 / xhalf_sum(st.l);
#pragma unroll
      for (int r = 0; r < 16; ++r) { acc0[r] += st.o0[r] * inv; acc1[r] += st.o1[r] * inv; } }
    attn_store_headnorm(acc0, acc1, Y + rowq * DM + 768 + head * 64, c.head_g + (size_t)L * DM + 768 + head * 64, hi);
}
__device__ __forceinline__ void ph_nsa(const Ctx& c_, int L) {
    Ctx c = c_; c.lane = (int)__builtin_amdgcn_mbcnt_hi(~0u, __builtin_amdgcn_mbcnt_lo(~0u, 0u)); asm volatile("" : "+v"(c.lane)); c.tid = c.wave * 64 + c.lane; asm volatile("" : "+s"(c.bid)); asm volatile("" : "+s"(c.ws));
    for (int pi = c.bid; pi < 256; pi += c.nb) {
        const int b = pi >> 4, s = pi & 15;
        nsa_unit(c, L, b, 31 - s);
        nsa_unit(c, L, b, s);
    }
}

constexpr size_t WS_SCAL = 29 * MiB;
constexpr size_t WS_NCH = 31 * MiB, WS_NPREV = 31 * MiB + 512 * 1024;
constexpr int ML_KROW = 192;
constexpr int ML_VROW = 320;
constexpr int ML_K = 0, ML_V = 64 * 192, ML_E = ML_V + 64 * ML_VROW, ML_MISC = ML_E + 1024;

__device__ __forceinline__ void ph_ml_chunk(const Ctx& c_, int L) {
    Ctx c = c_; c.lane = (int)__builtin_amdgcn_mbcnt_hi(~0u, __builtin_amdgcn_mbcnt_lo(~0u, 0u)); asm volatile("" : "+v"(c.lane)); c.tid = c.wave * 64 + c.lane; asm volatile("" : "+s"(c.bid)); asm volatile("" : "+s"(c.ws));
    const bf16_t* Z = (const bf16_t*)(c.ws + WS_Z); bf16_t* QKC = (bf16_t*)(c.ws + WS_QKC); float* gates = (float*)(c.ws + WS_GATES);
    float* scal = (float*)(c.ws + WS_SCAL); float* nch = (float*)(c.ws + WS_NCH); bf16_t* CC = (bf16_t*)(c.ws + WS_CC);
    const float* cw = c.conv_w + (size_t)L * 4 * 512; const float* cb = c.conv_b + (size_t)L * 512; const float* gb = c.gate_b + (size_t)L * 8;
    LAS unsigned char* lds = (LAS unsigned char*)c.lds;
    const int tid = c.tid, lane = c.lane, wave = c.wave, r32 = lane & 31, hi = lane >> 5;
    for (int item = c.bid; item < 2048; item += c.nb) {
        const int bh = item >> 5, ch = item & 31, b = bh >> 2, h = bh & 3;
        const size_t row0 = (size_t)b * SEQ + 64 * ch;
        { const int s = tid >> 3, c8 = 8 * (tid & 7), t = 64 * ch + s;
          float aq[8], ak[8];
#pragma unroll
          for (int i = 0; i < 8; ++i) { aq[i] = cb[64 * h + c8 + i]; ak[i] = cb[256 + 64 * h + c8 + i]; }
#pragma unroll
          for (int j = 0; j < 4; ++j) { if (t - 3 + j >= 0) {
              const bf16_t* zr = Z + (row0 + s - 3 + j) * DINP;
              const u32x4v xq = *(const u32x4v*)(zr + ZC_LQ + 64 * h + c8), xk = *(const u32x4v*)(zr + ZC_LK + 64 * h + c8);
#pragma unroll
              for (int i = 0; i < 4; ++i) {
                  aq[2 * i] += __uint_as_float(xq[i] << 16) * cw[j * 512 + 64 * h + c8 + 2 * i]; aq[2 * i + 1] += __uint_as_float(xq[i] & 0xffff0000u) * cw[j * 512 + 64 * h + c8 + 2 * i + 1];
                  ak[2 * i] += __uint_as_float(xk[i] << 16) * cw[j * 512 + 256 + 64 * h + c8 + 2 * i]; ak[2 * i + 1] += __uint_as_float(xk[i] & 0xffff0000u) * cw[j * 512 + 256 + 64 * h + c8 + 2 * i + 1]; } } }
          u32x4v oq, ok;
#pragma unroll
          for (int i = 0; i < 4; ++i) { const float q0 = aq[2 * i] * sigmoidf_(aq[2 * i]), q1 = aq[2 * i + 1] * sigmoidf_(aq[2 * i + 1]);
              const float k0 = 0.125f * ak[2 * i] * sigmoidf_(ak[2 * i]), k1 = 0.125f * ak[2 * i + 1] * sigmoidf_(ak[2 * i + 1]);
              oq[i] = cvtpk(q0, q1); ok[i] = cvtpk(k0, k1); }
          *(u32x4v*)(QKC + (row0 + s) * 512 + 64 * h + c8) = oq; *(u32x4v*)(QKC + (row0 + s) * 512 + 256 + 64 * h + c8) = ok;
          *(LAS u32x4v*)(lds + ML_K + s * ML_KROW + c8 * 2) = ok; }
        if (wave == 0) { const size_t m = row0 + lane;
            const float ig = bf2f(Z[m * DINP + ZC_LI + h]) + gb[h]; const float x = bf2f(Z[m * DINP + ZC_LF + h]) + gb[4 + h];
            float cs = fminf(x, 0.f) - log1pf(__expf(-fabsf(x)));
#pragma unroll
            for (int o = 1; o < 64; o <<= 1) { const float up = __shfl_up(cs, o); if (lane >= o) cs += up; }
            const float bend = __shfl(cs, 63); const float wend = bend - cs + ig; const float aend = wave_max(wend);
            ((LAS float*)(lds + ML_E))[lane] = __expf(wend - aend);
            gates[m * 8 + h] = ig; gates[m * 8 + 4 + h] = cs;
            if (lane == 0) { scal[item] = bend; scal[2048 + item] = aend; } }
        __syncthreads();
        { const int s = tid >> 3, v16 = 16 * (tid & 7); const float e = ((LAS float*)(lds + ML_E))[s];
          const bf16_t* zr = Z + (row0 + s) * DINP + ZC_LV + 128 * h + v16;
          const u32x4v x0 = *(const u32x4v*)zr, x1 = *(const u32x4v*)(zr + 8); u32x4v o0, o1;
#pragma unroll
          for (int i = 0; i < 4; ++i) { o0[i] = cvtpk(__uint_as_float(x0[i] << 16) * e, __uint_as_float(x0[i] & 0xffff0000u) * e); o1[i] = cvtpk(__uint_as_float(x1[i] << 16) * e, __uint_as_float(x1[i] & 0xffff0000u) * e); }
          *(LAS u32x4v*)(lds + ML_V + s * ML_VROW + v16 * 2) = o0; *(LAS u32x4v*)(lds + ML_V + s * ML_VROW + v16 * 2 + 16) = o1; }
        __syncthreads();
        { const int vt = wave >> 1, kt = wave & 1, li = lane & 15, g16 = lane >> 4;
          const LAS unsigned char* ap = lds + ML_V + (4 * (g16 >> 1) + (li >> 2)) * ML_VROW + (32 * vt + 16 * (g16 & 1) + 4 * (li & 3)) * 2;
          const LAS unsigned char* bp = lds + ML_K + (4 * (g16 >> 1) + (li >> 2)) * ML_KROW + (32 * kt + 16 * (g16 & 1) + 4 * (li & 3)) * 2;
          f32x16 acc = (f32x16){};
#pragma unroll
          for (int ks = 0; ks < 4; ++ks) {
              const s16x4v a0 = __builtin_bit_cast(s16x4v, __builtin_amdgcn_ds_read_tr16_b64_v4i16((LAS s16x4v*)(ap + (16 * ks) * ML_VROW)));
              const s16x4v a1 = __builtin_bit_cast(s16x4v, __builtin_amdgcn_ds_read_tr16_b64_v4i16((LAS s16x4v*)(ap + (16 * ks + 8) * ML_VROW)));
              const s16x4v b0 = __builtin_bit_cast(s16x4v, __builtin_amdgcn_ds_read_tr16_b64_v4i16((LAS s16x4v*)(bp + (16 * ks) * ML_KROW)));
              const s16x4v b1 = __builtin_bit_cast(s16x4v, __builtin_amdgcn_ds_read_tr16_b64_v4i16((LAS s16x4v*)(bp + (16 * ks + 8) * ML_KROW)));
              acc = __builtin_amdgcn_mfma_f32_32x32x16_bf16((bf16x8v){a0[0], a0[1], a0[2], a0[3], a1[0], a1[1], a1[2], a1[3]}, (bf16x8v){b0[0], b0[1], b0[2], b0[3], b1[0], b1[1], b1[2], b1[3]}, acc, 0, 0, 0);
          }
          bf16_t* dst = CC + (size_t)item * 8192 + (size_t)(32 * vt) * 64 + 32 * kt + r32;
#pragma unroll
          for (int r = 0; r < 16; ++r) dst[crow16(r, hi) * 64] = f2bf(acc[r]); }
        if (tid < 64) { float a = 0.f;
            for (int s = 0; s < 64; ++s) a += ((LAS float*)(lds + ML_E))[s] * bf2f(*(LAS bf16_t*)(lds + ML_K + s * ML_KROW + tid * 2));
            nch[(size_t)item * 64 + tid] = a; }
        __syncthreads();
    }
}

__device__ __forceinline__ void ph_ml_scan(const Ctx& c_) {
    Ctx c = c_; c.lane = (int)__builtin_amdgcn_mbcnt_hi(~0u, __builtin_amdgcn_mbcnt_lo(~0u, 0u)); asm volatile("" : "+v"(c.lane)); c.tid = c.wave * 64 + c.lane; asm volatile("" : "+s"(c.bid)); asm volatile("" : "+s"(c.ws));
    const bf16_t* CC = (const bf16_t*)(c.ws + WS_CC); bf16_t* CP = (bf16_t*)(c.ws + WS_CPREV); float* scal = (float*)(c.ws + WS_SCAL);
    const float* nch = (const float*)(c.ws + WS_NCH); float* npv = (float*)(c.ws + WS_NPREV);
    for (int sl = c.bid; sl < 256; sl += c.nb) {
        const int bh = sl >> 2, qt = sl & 3; const size_t e0 = (size_t)qt * 2048 + 4 * c.tid;
        float C0 = 0.f, C1 = 0.f, C2 = 0.f, C3 = 0.f, m = 0.f, nst = 0.f;
        const bool do_n = (qt == 0 && c.tid < 64);
        uint2 nx = *(const uint2*)(CC + (size_t)(bh * 32) * 8192 + e0);
        for (int ch = 0; ch < 32; ++ch) { const int item = bh * 32 + ch;
            const uint2 cur = nx;
            if (ch + 1 < 32) nx = *(const uint2*)(CC + (size_t)(item + 1) * 8192 + e0);
            uint2 o; o.x = cvtpk(C0, C1); o.y = cvtpk(C2, C3);
            *(uint2*)(CP + (size_t)item * 8192 + e0) = o;
            if (do_n) npv[(size_t)item * 64 + c.tid] = nst;
            if (qt == 0 && c.tid == 0) scal[4096 + item] = m;
            const float be = scal[item], ae = scal[2048 + item];
            const float mn = fmaxf(be + m, ae), dec = __expf(be + m - mn), inj = __expf(ae - mn);
            C0 = dec * C0 + inj * __uint_as_float(cur.x << 16); C1 = dec * C1 + inj * __uint_as_float(cur.x & 0xffff0000u);
            C2 = dec * C2 + inj * __uint_as_float(cur.y << 16); C3 = dec * C3 + inj * __uint_as_float(cur.y & 0xffff0000u);
            if (do_n) nst = dec * nst + inj * nch[(size_t)item * 64 + c.tid];
            m = mn; }
    }
}

constexpr int M3_K = 0, M3_V = 64 * AT_KROW, M3_VEC = M3_V + 64 * ML_VROW, M3_SS = M3_VEC + 2048;
__device__ __forceinline__ void ph_ml_out(const Ctx& c_, int L) {
    Ctx c = c_; c.lane = (int)__builtin_amdgcn_mbcnt_hi(~0u, __builtin_amdgcn_mbcnt_lo(~0u, 0u)); asm volatile("" : "+v"(c.lane)); c.tid = c.wave * 64 + c.lane; asm volatile("" : "+s"(c.bid)); asm volatile("" : "+s"(c.ws));
    const bf16_t* Z = (const bf16_t*)(c.ws + WS_Z); const bf16_t* QKC = (const bf16_t*)(c.ws + WS_QKC); const float* gates = (const float*)(c.ws + WS_GATES);
    const float* scal = (const float*)(c.ws + WS_SCAL); const float* npv = (const float*)(c.ws + WS_NPREV); const bf16_t* CP = (const bf16_t*)(c.ws + WS_CPREV); bf16_t* Y = (bf16_t*)(c.ws + WS_Y);
    const float* hg = c.head_g + (size_t)L * DM + 256;
    LAS unsigned char* lds = (LAS unsigned char*)c.lds;
    const int tid = c.tid, lane = c.lane, wave = c.wave, r32 = lane & 31, hi = lane >> 5, th = wave & 1, vq = wave >> 1;
    LAS float* uvec = (LAS float*)(lds + M3_VEC); LAS float* pmv = uvec + 64; LAS float* bcv = uvec + 128; LAS float* npl = uvec + 192; LAS float* ssl = (LAS float*)(lds + M3_SS);
    for (int item = c.bid; item < 2048; item += c.nb) {
        const int bh = item >> 5, ch = item & 31, b = bh >> 2, h = bh & 3;
        const size_t row0 = (size_t)b * SEQ + 64 * ch;
        { const int s = tid >> 3, c8 = 8 * (tid & 7);
          *(LAS u32x4v*)(lds + M3_K + s * AT_KROW + c8 * 2) = *(const u32x4v*)(QKC + (row0 + s) * 512 + 256 + 64 * h + c8);
          const bf16_t* zr = Z + (row0 + s) * DINP + ZC_LV + 128 * h + 2 * c8;
          *(LAS u32x4v*)(lds + M3_V + s * ML_VROW + c8 * 4) = *(const u32x4v*)zr; *(LAS u32x4v*)(lds + M3_V + s * ML_VROW + c8 * 4 + 16) = *(const u32x4v*)(zr + 8); }
        if (wave == 0) { const size_t m = row0 + lane; const float ig = gates[m * 8 + h], bc = gates[m * 8 + 4 + h]; const float u = ig - bc;
            float pm = u;
#pragma unroll
            for (int o = 1; o < 64; o <<= 1) { const float up = __shfl_up(pm, o); if (lane >= o) pm = fmaxf(pm, up); }
            uvec[lane] = u; pmv[lane] = pm; bcv[lane] = bc; npl[lane] = npv[(size_t)item * 64 + lane]; }
        const float mprev = scal[4096 + item];
        const int tl = 32 * th + r32; const size_t mrow = row0 + tl;
        bf16x8v qf[4];
#pragma unroll
        for (int d0 = 0; d0 < 4; ++d0) qf[d0] = *(const bf16x8v*)(QKC + mrow * 512 + 64 * h + 16 * d0 + 8 * hi);
        f32x16 acc2 = (f32x16){};
        { const bf16_t* cp = CP + (size_t)item * 8192 + (size_t)(32 * vq + r32) * 64 + 8 * hi;
#pragma unroll
          for (int d0 = 0; d0 < 4; ++d0) acc2 = __builtin_amdgcn_mfma_f32_32x32x16_bf16(*(const bf16x8v*)(cp + 16 * d0), qf[d0], acc2, 0, 0, 0); }
        __syncthreads();
        f32x16 p0 = (f32x16){}, p1 = (f32x16){};
        { const LAS unsigned char* kp = lds + M3_K + r32 * AT_KROW + hi * 16;
#pragma unroll
          for (int d0 = 0; d0 < 4; ++d0) {
              p0 = __builtin_amdgcn_mfma_f32_32x32x16_bf16(*(const LAS bf16x8v*)(kp + d0 * 32), qf[d0], p0, 0, 0, 0);
              p1 = __builtin_amdgcn_mfma_f32_32x32x16_bf16(*(const LAS bf16x8v*)(kp + 32 * AT_KROW + d0 * 32), qf[d0], p1, 0, 0, 0); } }
        const float bct = bcv[tl], mt = bct + fmaxf(mprev, pmv[tl]);
        const float eb = bct - mt;
        const int tlim = tl - 4 * hi; float dsum = 0.f;
#pragma unroll
        for (int r = 0; r < 16; ++r) { const int cr = (r & 3) + 8 * (r >> 2);
            const float w0 = (cr <= tlim) ? __expf(eb + uvec[cr + 4 * hi]) : 0.f, w1 = (cr + 32 <= tlim) ? __expf(eb + uvec[cr + 32 + 4 * hi]) : 0.f;
            p0[r] *= w0; p1[r] *= w1; dsum += p0[r] + p1[r]; }
        dsum = xhalf_sum(dsum);
        const float winter = __expf(bct + mprev - mt);
        float qn = 0.f;
#pragma unroll
        for (int d0 = 0; d0 < 4; ++d0)
#pragma unroll
            for (int j = 0; j < 8; ++j) qn += bf2f((bf16_t)qf[d0][j]) * npl[16 * d0 + 8 * hi + j];
        qn = xhalf_sum(qn);
        const float den = dsum + winter * qn;
        const float rden = 1.f / fmaxf(fabsf(den), __expf(-mt));
        f32x16 acc1 = (f32x16){};
        { bf16x8v pf[4]; u32x4v w;
          w = (u32x4v){cvtpk(p0[0], p0[1]), cvtpk(p0[2], p0[3]), cvtpk(p0[4], p0[5]), cvtpk(p0[6], p0[7])}; pf[0] = __builtin_bit_cast(bf16x8v, w);
          w = (u32x4v){cvtpk(p0[8], p0[9]), cvtpk(p0[10], p0[11]), cvtpk(p0[12], p0[13]), cvtpk(p0[14], p0[15])}; pf[1] = __builtin_bit_cast(bf16x8v, w);
          w = (u32x4v){cvtpk(p1[0], p1[1]), cvtpk(p1[2], p1[3]), cvtpk(p1[4], p1[5]), cvtpk(p1[6], p1[7])}; pf[2] = __builtin_bit_cast(bf16x8v, w);
          w = (u32x4v){cvtpk(p1[8], p1[9]), cvtpk(p1[10], p1[11]), cvtpk(p1[12], p1[13]), cvtpk(p1[14], p1[15])}; pf[3] = __builtin_bit_cast(bf16x8v, w);
          const int li = lane & 15, g16 = lane >> 4;
          const LAS unsigned char* vp = lds + M3_V + (4 * (g16 >> 1) + (li >> 2)) * ML_VROW + (32 * vq + 16 * (g16 & 1) + 4 * (li & 3)) * 2;
#pragma unroll
          for (int ks = 0; ks < 4; ++ks) {
              const s16x4v a0 = __builtin_bit_cast(s16x4v, __builtin_amdgcn_ds_read_tr16_b64_v4i16((LAS s16x4v*)(vp + (16 * ks) * ML_VROW)));
              const s16x4v a1 = __builtin_bit_cast(s16x4v, __builtin_amdgcn_ds_read_tr16_b64_v4i16((LAS s16x4v*)(vp + (16 * ks + 8) * ML_VROW)));
              acc1 = __builtin_amdgcn_mfma_f32_32x32x16_bf16((bf16x8v){a0[0], a0[1], a0[2], a0[3], a1[0], a1[1], a1[2], a1[3]}, pf[ks], acc1, 0, 0, 0); } }
        float ss = 0.f;
#pragma unroll
        for (int r = 0; r < 16; ++r) { acc1[r] = (acc1[r] + winter * acc2[r]) * rden; ss += acc1[r] * acc1[r]; }
        ss = xhalf_sum(ss);
        if (hi == 0) ssl[vq * 64 + tl] = ss;
        __syncthreads();
        const float sst = ssl[tl] + ssl[64 + tl] + ssl[128 + tl] + ssl[192 + tl];
        const float rn = rsqrtf(sst * (1.f / 128.f) + EPS);
#pragma unroll
        for (int q4 = 0; q4 < 4; ++q4) { const int v = 32 * vq + 8 * q4 + 4 * hi;
            const float4 gg = *(const float4*)(hg + 128 * h + v); const uint2 lo = *(const uint2*)(Z + mrow * DINP + ZC_LO + 128 * h + v);
            const float y0 = acc1[4 * q4] * rn * gg.x * sigmoidf_(__uint_as_float(lo.x << 16)), y1 = acc1[4 * q4 + 1] * rn * gg.y * sigmoidf_(__uint_as_float(lo.x & 0xffff0000u));
            const float y2 = acc1[4 * q4 + 2] * rn * gg.z * sigmoidf_(__uint_as_float(lo.y << 16)), y3 = acc1[4 * q4 + 3] * rn * gg.w * sigmoidf_(__uint_as_float(lo.y & 0xffff0000u));
            uint2 w; w.x = cvtpk(y0, y1); w.y = cvtpk(y2, y3);
            *(uint2*)(Y + mrow * DM + 256 + 128 * h + v) = w; }
        __syncthreads();
    }
}

#ifndef REP_P2
#define REP_P2 1
#endif
#ifndef REP_P3
#define REP_P3 1
#endif
#ifndef REP_P3B
#define REP_P3B 1
#endif
#ifndef REP_GEMM
#define REP_GEMM 1
#endif
constexpr int LDS_BYTES = 147456;
constexpr int LDSCTL_OFF = 131072, MISC_OFF = LDSCTL_OFF + 320;
struct Args { const float* in[13]; float* out; unsigned char* ws; };

__global__ void __launch_bounds__(512, 2) mega_fwd(Args args) {
    extern __shared__ __attribute__((aligned(16))) unsigned char lds[];
    Ctx c;
    c.x_in = args.in[0]; c.norm_g = args.in[1]; c.w_in = args.in[2]; c.conv_w = args.in[3]; c.conv_b = args.in[4]; c.gate_b = args.in[5]; c.cmp_pe = args.in[6];
    c.cmp_w1 = args.in[7]; c.cmp_w2 = args.in[8]; c.head_g = args.in[9]; c.w_out = args.in[10]; c.w1 = args.in[11]; c.w2 = args.in[12];
    c.xo = args.out; c.ws = args.ws; c.lds = lds;
    c.tid = threadIdx.x; c.lane = c.tid & 63; c.wave = __builtin_amdgcn_readfirstlane(c.tid >> 6); asm volatile("" : "+s"(c.wave)); c.bid = blockIdx.x; c.nb = gridDim.x;
    for (int u = c.tid; u < (LDS_BYTES - LDSCTL_OFF) / 4; u += 512) ((LAS unsigned*)((LAS unsigned char*)lds + LDSCTL_OFF))[u] = 0u;
    __syncthreads();
    unsigned* ctl = (unsigned*)(c.ws + WS_CTL);
    XcdBarrier bar = xcd_barrier_post(ctl + CW_BAR, (volatile LAS unsigned*)((LAS unsigned char*)lds + MISC_OFF) + 8);
#define GRID_BAR() xcd_barrier(bar)
    bf16_t* Win_t = (bf16_t*)(c.ws + WS_WIN); bf16_t* Wout_t = (bf16_t*)(c.ws + WS_WOUT); bf16_t* W1_t = (bf16_t*)(c.ws + WS_W1); bf16_t* W2_t = (bf16_t*)(c.ws + WS_W2);
    bf16_t* HN = (bf16_t*)(c.ws + WS_HN); bf16_t* Z = (bf16_t*)(c.ws + WS_Z); bf16_t* Y = (bf16_t*)(c.ws + WS_Y); bf16_t* H = (bf16_t*)(c.ws + WS_H); bf16_t* T = (bf16_t*)(c.ws + WS_T); bf16_t* T2 = (bf16_t*)(c.ws + WS_T2);

    ph_wconv(c, 0); ph_wconv_cmp(c, 0); ph_cpe_all(c);
    ph_resid_norm(c, c.x_in, (const bf16_t*)nullptr, nullptr, nullptr, c.norm_g, HN);
    GRID_BAR();
    for (int L = 0; L < DEPTH; ++L) {
        const float* ng = c.norm_g + (size_t)L * 4 * DM;
        { int nrep_ = REP_GEMM; asm volatile("" : "+s"(nrep_));
_Pragma("unroll 1") for (int rep_ = 0; rep_ < nrep_; ++rep_) { pg8::Gemm g{HN, Win_t, MTOK, DINP, DM, 0}; pg8::StaticOrder S; S.init(MTOK, DINP, c.nb, c.bid); pg8::EpiBf16<0> E{Z, DINP, 0};
          pg8::gemm_phase<pg8::EpiBf16<0>, pg8::StaticOrder, true, true>((PG8_LAS unsigned char*)lds, g, S, E, c.wave); } }
        GRID_BAR();
        { int nrep_ = REP_P2; asm volatile("" : "+s"(nrep_));
_Pragma("unroll 1") for (int rep_ = 0; rep_ < nrep_; ++rep_) { ph_kmean(c); ph_cmp(c, L); ph_ml_chunk(c, L); } }
        GRID_BAR();
        { int nrep_ = REP_P3; asm volatile("" : "+s"(nrep_));
_Pragma("unroll 1") for (int rep_ = 0; rep_ < nrep_; ++rep_) { ph_ml_scan(c); ph_moba(c, L); } }
        GRID_BAR();
        { int nrep_ = REP_P3B; asm volatile("" : "+s"(nrep_));
_Pragma("unroll 1") for (int rep_ = 0; rep_ < nrep_; ++rep_) { ph_ml_out(c, L); ph_nsa(c, L); } }
        GRID_BAR();
        { int nrep_ = REP_GEMM; asm volatile("" : "+s"(nrep_));
_Pragma("unroll 1") for (int rep_ = 0; rep_ < nrep_; ++rep_) { pg8::Gemm g{Y, Wout_t, MTOK, DM, DM, 0}; pg8::StaticOrder S; S.init(MTOK, DM, c.nb, c.bid); pg8::EpiBf16<0> E{T, DM, 0};
          pg8::gemm_phase<pg8::EpiBf16<0>, pg8::StaticOrder, true, true>((PG8_LAS unsigned char*)lds, g, S, E, c.wave); } }
        GRID_BAR();
        ph_resid_norm(c, L == 0 ? c.x_in : (const float*)c.xo, T, c.xo, ng + DM, ng + 2 * DM, HN);
        GRID_BAR();
        { int nrep_ = REP_GEMM; asm volatile("" : "+s"(nrep_));
_Pragma("unroll 1") for (int rep_ = 0; rep_ < nrep_; ++rep_) { pg8::Gemm g{HN, W1_t, MTOK, DFF, DM, 0}; pg8::StaticOrder S; S.init(MTOK, DFF, c.nb, c.bid); pg8::EpiBf16<1> E{H, DFF, 0};
          pg8::gemm_phase<pg8::EpiBf16<1>, pg8::StaticOrder, true, true>((PG8_LAS unsigned char*)lds, g, S, E, c.wave); } }
        GRID_BAR();
        { int nrep_ = REP_GEMM; asm volatile("" : "+s"(nrep_));
_Pragma("unroll 1") for (int rep_ = 0; rep_ < nrep_; ++rep_) { pg8::Gemm g{H, W2_t, MTOK, DM, DFF, 0}; pg8::StaticOrder S; S.init(MTOK, DM, c.nb, c.bid); pg8::EpiBf16<0> E{T2, DM, 0};
          pg8::gemm_phase<pg8::EpiBf16<0>, pg8::StaticOrder, true, true>((PG8_LAS unsigned char*)lds, g, S, E, c.wave); } }
        GRID_BAR();
        if (L + 1 < DEPTH) { ph_resid_norm(c, c.xo, T2, c.xo, ng + 3 * DM, c.norm_g + (size_t)(L + 1) * 4 * DM, HN); ph_wconv(c, L + 1); ph_wconv_cmp(c, L + 1); GRID_BAR(); }
        else ph_resid_norm(c, c.xo, T2, c.xo, ng + 3 * DM, nullptr, nullptr);
    }
#undef GRID_BAR
}

extern "C" void kernel_launch(void* const* d_in, const int* in_sizes, int n_in, void* d_out, int out_size, void* d_ws, size_t ws_size, hipStream_t stream) {
    static int grid = 0;
    if (grid == 0) {
        if (n_in != 13 || in_sizes[0] != MTOK * DM || out_size != MTOK * DM || ws_size < WS_END) { fprintf(stderr, "kernel_launch: unexpected shapes / workspace (%zu)\n", ws_size); grid = -1; return; }
        int dev = 0, cus = 0, per_cu = 0;
        if (hipGetDevice(&dev) != hipSuccess || hipDeviceGetAttribute(&cus, hipDeviceAttributeMultiprocessorCount, dev) != hipSuccess) { grid = -1; return; }
        if (hipFuncSetAttribute((const void*)mega_fwd, hipFuncAttributeMaxDynamicSharedMemorySize, LDS_BYTES) != hipSuccess) { fprintf(stderr, "hipFuncSetAttribute failed\n"); grid = -1; return; }
        if (hipOccupancyMaxActiveBlocksPerMultiprocessor(&per_cu, (const void*)mega_fwd, 512, LDS_BYTES) != hipSuccess || per_cu < 1) { fprintf(stderr, "occupancy query: %d\n", per_cu); (void)hipGetLastError(); }
        grid = cus;
    }
    if (grid < 0) return;
    if (hipMemsetAsync((char*)d_ws + WS_CTL, 0, CTL_ZERO_BYTES, stream) != hipSuccess) return;
    Args a{};
    for (int i = 0; i < 13; ++i) a.in[i] = (const float*)d_in[i];
    a.out = (float*)d_out; a.ws = (unsigned char*)d_ws;
    hipLaunchKernelGGL(mega_fwd, dim3(grid), dim3(512), LDS_BYTES, stream, a);
}
```

```cpp
#include <hip/hip_runtime.h>
#include <cstdio>
#include <cstdint>

namespace pg8 {
#define PG8_LAS __attribute__((address_space(3)))
typedef unsigned short bf16_t;
typedef short bf16x8 __attribute__((ext_vector_type(8)));
typedef float f32x4 __attribute__((ext_vector_type(4)));
typedef unsigned u32x4 __attribute__((ext_vector_type(4)));
constexpr int BM = 256, BK = 64, HALF = 128, HTB = HALF * BK * 2  , STAGE_BYTES = 8 * HTB, NXCD = 8, WGM = 8;

__host__ __device__ __forceinline__ int lds_byte(int r, int c) { const int st = (r >> 4) * 2 + (c >> 5), rr = r & 15, cc = c & 31, ob = rr * 64 + cc * 2; return st * 1024 + (ob ^ (((ob >> 9) & 1) << 5)); }
__host__ __device__ __forceinline__ void stage_rc(int b, int& R, int& C) { const int st = b / 1024, sb = b % 1024, swz = sb ^ (((sb >> 9) & 1) << 5); R = (st >> 1) * 16 + swz / 64; C = (st & 1) * 32 + (swz % 64) / 2; }
__host__ __device__ __forceinline__ int perm32(int rho) { const int n = rho >> 4, i = rho & 15; return 8 * (i >> 2) + 4 * n + (i & 3); }

struct Unit { int pm, pn; };
struct Gemm { const bf16_t* A; const bf16_t* Bt; int M, N, K, pad; };

struct StaticOrder {
    int nM, nN, nwg, G, c;
    __host__ __device__ void init(int M, int N, int G_, int c_) { nM = M / BM; nN = N / BM; nwg = nM * nN; G = G_; c = c_; }
    __host__ __device__ bool next(int i, Unit& u) const {
        const long L = (long)i * G + c; if (L >= nwg) return false;
        int wgid = (int)L; { const int q = nwg / NXCD, r = nwg % NXCD, xcd = wgid % NXCD, off = wgid / NXCD; wgid = (xcd < r ? xcd * (q + 1) : r * (q + 1) + (xcd - r) * q) + off; }
        const int nig = WGM * nN, gid = wgid / nig, fm = gid * WGM, gsz = (nM - fm) < WGM ? (nM - fm) : WGM;
        u.pm = fm + ((wgid % nig) % gsz); u.pn = (wgid % nig) / gsz; return true;
    }
    __device__ __forceinline__ void a_ready(const Unit&) const {}
    __device__ __forceinline__ void done(const Unit&) const {}
};

__device__ __forceinline__ unsigned cvt_pk_bf16(float lo, float hi) { unsigned r; asm volatile("v_cvt_pk_bf16_f32 %0, %1, %2" : "=v"(r) : "v"(lo), "v"(hi)); return r; }
typedef float f32x2 __attribute__((ext_vector_type(2)));
struct EpiF32 {
    static constexpr bool PERM = false, AFTER_DRAIN = false;
    float* C; const float* bias; int ldc, pad;
    __device__ __forceinline__ void operator()(const f32x4 (&acc)[2][2][4][2], const Unit& u, int wr, int wc, int fr, int fq) const {
        const int row0 = u.pm * BM + wr * 64 + fr, col0 = u.pn * BM + wc * 32 + 4 * fq;
        f32x4 bv[2][2];
#pragma unroll
        for (int bj = 0; bj < 2; ++bj)
#pragma unroll
            for (int n = 0; n < 2; ++n) bv[bj][n] = bias ? *(const f32x4*)(bias + col0 + bj * HALF + n * 16) : (f32x4){0.f, 0.f, 0.f, 0.f};
#pragma unroll
        for (int ai = 0; ai < 2; ++ai)
#pragma unroll
            for (int m = 0; m < 4; ++m) { float* rowp = C + (size_t)(row0 + ai * HALF + m * 16) * ldc + col0;
#pragma unroll
                for (int bj = 0; bj < 2; ++bj)
#pragma unroll
                    for (int n = 0; n < 2; ++n) *(f32x4*)(rowp + bj * HALF + n * 16) = acc[ai][bj][m][n] + bv[bj][n]; }
    }
};
template <int ACT> struct EpiBf16 {
    static constexpr bool PERM = true, AFTER_DRAIN = false;
    bf16_t* O; const float* rs; int ldc, pad;
    __device__ __forceinline__ void operator()(const f32x4 (&acc)[2][2][4][2], const Unit& u, int wr, int wc, int fr, int fq) const {
        const int row0 = u.pm * BM + wr * 64 + fr; const int col0 = u.pn * BM + wc * 32 + 8 * fq;
#pragma unroll
        for (int ai = 0; ai < 2; ++ai)
#pragma unroll
            for (int m = 0; m < 4; ++m) { bf16_t* rowp = O + (size_t)(row0 + ai * HALF + m * 16) * ldc + col0; const float s = rs ? rs[row0 + ai * HALF + m * 16] : 1.f;
#pragma unroll
                for (int bj = 0; bj < 2; ++bj) { f32x4 v0 = acc[ai][bj][m][0] * s, v1 = acc[ai][bj][m][1] * s;
                    if (ACT == 1) {
#pragma unroll
                        for (int j = 0; j < 4; ++j) { const float a = fmaxf(v0[j], 0.f), b = fmaxf(v1[j], 0.f); v0[j] = a * a; v1[j] = b * b; } }
                    u32x4 w; w.x = cvt_pk_bf16(v0[0], v0[1]); w.y = cvt_pk_bf16(v0[2], v0[3]); w.z = cvt_pk_bf16(v1[0], v1[1]); w.w = cvt_pk_bf16(v1[2], v1[3]);
                    *(u32x4*)(rowp + bj * HALF) = w; } }
    }
};
template <class Epi, class Sched, bool ALIGN_EPI = false, bool SP2 = false>
__device__ __forceinline__ void gemm_phase(PG8_LAS unsigned char* lds, const Gemm g, const Sched& S, const Epi& E, int wave_id  ) {
    int tid_ = wave_id * 64 + (int)__builtin_amdgcn_mbcnt_hi(~0u, __builtin_amdgcn_mbcnt_lo(~0u, 0u)); asm volatile("" : "+v"(tid_));
    const int tid = tid_, wid = __builtin_amdgcn_readfirstlane(tid >> 6), lane = tid & 63, wr = wid >> 2, wc = wid & 3, fr = lane & 15, fq = lane >> 4;
    const int K = g.K, nt = K / BK;
    unsigned voffA[2], voffB[2];
#pragma unroll
    for (int i = 0; i < 2; ++i) { int R, C; stage_rc(tid * 16 + i * 8192, R, C); const int Rb = Epi::PERM ? ((R & ~31) + perm32(R & 31)) : R;
        voffA[i] = (unsigned)(R * K + C) * 2u; voffB[i] = (unsigned)(Rb * K + C) * 2u; }
    const size_t kstep = (size_t)(BK * 2);
    const size_t hstep = (size_t)HALF * K * 2;
    const size_t tstep = 2 * hstep;
    const unsigned ldsw = (unsigned)wid * 1024u;
    const int aoff = lds_byte(wr * 64 + fr, fq * 8), boff = lds_byte(wc * 32 + fr, fq * 8);
#define PG8_SA(b, h) (((b) * 2 + (h)) * HTB)
#define PG8_SB(b, h) ((4 + (b) * 2 + (h)) * HTB)
#define PG8_STAGE(bufoff, gbase, voff) do { _Pragma("unroll") for (int _i = 0; _i < 2; ++_i) \
        __builtin_amdgcn_global_load_lds((const unsigned*)((const char*)(gbase) + (voff)[_i]), (PG8_LAS unsigned*)(lds + (bufoff) + ldsw + _i * 8192), 16, 0, 0); } while (0)
#define PG8_LDA(dst, b, h) do { _Pragma("unroll") for (int m = 0; m < 4; ++m) _Pragma("unroll") for (int k = 0; k < 2; ++k) dst[m][k] = *(const PG8_LAS bf16x8*)(lds + PG8_SA(b, h) + aoff + m * 2048 + k * 1024); } while (0)
#define PG8_LDB(dst, b, h) do { _Pragma("unroll") for (int n = 0; n < 2; ++n) _Pragma("unroll") for (int k = 0; k < 2; ++k) dst[n][k] = *(const PG8_LAS bf16x8*)(lds + PG8_SB(b, h) + boff + n * 2048 + k * 1024); } while (0)
#define PG8_MMA(ai, bj, At, Bt) do { __builtin_amdgcn_s_setprio(1); _Pragma("unroll") for (int m = 0; m < 4; ++m) _Pragma("unroll") for (int n = 0; n < 2; ++n) _Pragma("unroll") for (int k = 0; k < 2; ++k) \
        acc[ai][bj][m][n] = __builtin_amdgcn_mfma_f32_16x16x32_bf16(Bt[n][k], At[m][k], acc[ai][bj][m][n], 0, 0, 0); __builtin_amdgcn_s_setprio(0); } while (0)
#define PG8_WAIT_V(n) asm volatile("s_waitcnt vmcnt(" #n ")" ::: "memory")
#define PG8_WAIT_L(n) asm volatile("s_waitcnt lgkmcnt(" #n ")" ::: "memory")
#define PG8_BAR __builtin_amdgcn_s_barrier()
#define PG8_SCHED __builtin_amdgcn_sched_barrier(0)
    Unit cur, nxt; int ui = 0;
    if (!S.next(0, cur)) return;
    f32x4 acc[2][2][4][2];
#pragma unroll
    for (int a = 0; a < 2; ++a)
#pragma unroll
        for (int b = 0; b < 2; ++b)
#pragma unroll
            for (int m = 0; m < 4; ++m)
#pragma unroll
                for (int n = 0; n < 2; ++n) acc[a][b][m][n] = (f32x4){0.f, 0.f, 0.f, 0.f};
    bf16x8 At[4][2], B0[2][2], B1[2][2];
    const char* cA = (const char*)g.A + (size_t)cur.pm * tstep; const char* cB = (const char*)g.Bt + (size_t)cur.pn * tstep;
    S.a_ready(cur);
    if constexpr (SP2) {
        PG8_STAGE(PG8_SB(0, 0), cB, voffB); PG8_STAGE(PG8_SB(0, 1), cB + hstep, voffB); PG8_STAGE(PG8_SA(0, 0), cA, voffA); PG8_STAGE(PG8_SA(0, 1), cA + hstep, voffA);
        if (wr == 1) PG8_BAR;
        PG8_WAIT_V(2); PG8_BAR;
        PG8_STAGE(PG8_SB(1, 0), cB + kstep, voffB); PG8_STAGE(PG8_SA(1, 0), cA + kstep, voffA); PG8_STAGE(PG8_SB(1, 1), cB + hstep + kstep, voffB);
        PG8_WAIT_V(6); PG8_BAR;
    } else {
        PG8_STAGE(PG8_SB(0, 0), cB, voffB); PG8_STAGE(PG8_SA(0, 0), cA, voffA); PG8_STAGE(PG8_SB(0, 1), cB + hstep, voffB); PG8_STAGE(PG8_SA(0, 1), cA + hstep, voffA);
        if (wr == 1) PG8_BAR;
        PG8_WAIT_V(4); PG8_BAR;
        PG8_STAGE(PG8_SB(1, 0), cB + kstep, voffB); PG8_STAGE(PG8_SA(1, 0), cA + kstep, voffA); PG8_STAGE(PG8_SB(1, 1), cB + hstep + kstep, voffB);
        PG8_WAIT_V(6); PG8_BAR;
    }
    for (;;) {
        const bool has_next = S.next(ui + 1, nxt);
        const char* nA = has_next ? (const char*)g.A + (size_t)nxt.pm * tstep : cA; const char* nB = has_next ? (const char*)g.Bt + (size_t)nxt.pn * tstep : cB;
        for (int t = 0; t < nt; t += 2) {
            const bool last = (t == nt - 2);
            const char* a1 = cA + (size_t)(t + 1) * kstep;
            const char* a2 = last ? nA : cA + (size_t)(t + 2) * kstep; const char* b2 = last ? nB : cB + (size_t)(t + 2) * kstep;
            const char* a3 = a2 + kstep; const char* b3 = b2 + kstep;
            if (last && has_next) S.a_ready(nxt);
            if constexpr (SP2) {
            PG8_LDB(B0, 0, 0); PG8_LDB(B1, 0, 1); PG8_SCHED; PG8_LDA(At, 0, 0); PG8_STAGE(PG8_SA(1, 1), a1 + hstep, voffA);
            PG8_WAIT_V(8); PG8_WAIT_L(0); PG8_BAR; PG8_MMA(0, 0, At, B0); PG8_MMA(0, 1, At, B1); PG8_BAR; PG8_SCHED;
            PG8_LDA(At, 0, 1); PG8_STAGE(PG8_SB(0, 0), b2, voffB); PG8_STAGE(PG8_SB(0, 1), b2 + hstep, voffB); PG8_STAGE(PG8_SA(0, 0), a2, voffA);
            PG8_WAIT_V(8); PG8_WAIT_L(0); PG8_BAR; PG8_MMA(1, 0, At, B0); PG8_MMA(1, 1, At, B1); PG8_BAR; PG8_SCHED;
            PG8_LDB(B0, 1, 0); PG8_LDB(B1, 1, 1); PG8_SCHED; PG8_LDA(At, 1, 0); PG8_STAGE(PG8_SA(0, 1), a2 + hstep, voffA);
            PG8_WAIT_V(8); PG8_WAIT_L(0); PG8_BAR; PG8_MMA(0, 0, At, B0); PG8_MMA(0, 1, At, B1); PG8_BAR; PG8_SCHED;
            PG8_LDA(At, 1, 1); PG8_STAGE(PG8_SB(1, 0), b3, voffB); PG8_STAGE(PG8_SB(1, 1), b3 + hstep, voffB); PG8_STAGE(PG8_SA(1, 0), a3, voffA);
            PG8_WAIT_V(8); PG8_WAIT_L(0); PG8_BAR; PG8_MMA(1, 0, At, B0); PG8_MMA(1, 1, At, B1); PG8_BAR; PG8_SCHED;
            } else {
            PG8_LDB(B0, 0, 0); PG8_SCHED; PG8_LDA(At, 0, 0); PG8_STAGE(PG8_SA(1, 1), a1 + hstep, voffA);
            PG8_WAIT_L(8); PG8_BAR; PG8_WAIT_L(0); PG8_MMA(0, 0, At, B0); PG8_BAR; PG8_SCHED;
            PG8_LDB(B1, 0, 1); PG8_STAGE(PG8_SB(0, 0), b2, voffB);
            PG8_BAR; PG8_WAIT_L(0); PG8_MMA(0, 1, At, B1); PG8_BAR;
            PG8_LDA(At, 0, 1); PG8_STAGE(PG8_SA(0, 0), a2, voffA);
            PG8_BAR; PG8_WAIT_L(0); PG8_MMA(1, 0, At, B0); PG8_BAR; PG8_SCHED;
            PG8_STAGE(PG8_SB(0, 1), b2 + hstep, voffB);
            PG8_WAIT_V(6); PG8_BAR; PG8_MMA(1, 1, At, B1); PG8_BAR;
            PG8_LDB(B0, 1, 0); PG8_SCHED; PG8_LDA(At, 1, 0); PG8_STAGE(PG8_SA(0, 1), a2 + hstep, voffA);
            PG8_WAIT_L(8); PG8_BAR; PG8_WAIT_L(0); PG8_MMA(0, 0, At, B0); PG8_BAR; PG8_SCHED;
            PG8_LDB(B1, 1, 1); PG8_STAGE(PG8_SB(1, 0), b3, voffB);
            PG8_BAR; PG8_WAIT_L(0); PG8_MMA(0, 1, At, B1); PG8_BAR;
            PG8_LDA(At, 1, 1); PG8_STAGE(PG8_SA(1, 0), a3, voffA);
            PG8_BAR; PG8_WAIT_L(0); PG8_MMA(1, 0, At, B0); PG8_BAR; PG8_SCHED;
            PG8_STAGE(PG8_SB(1, 1), b3 + hstep, voffB);
            PG8_WAIT_V(6); PG8_BAR; PG8_MMA(1, 1, At, B1); PG8_BAR;
            }
        }
        if constexpr (ALIGN_EPI) { if (wr == 0) PG8_BAR; }
        if constexpr (!Epi::AFTER_DRAIN) { E(acc, cur, wr, wc, fr, fq); S.done(cur); }
        if (!has_next) break;
#pragma unroll
        for (int a = 0; a < 2; ++a)
#pragma unroll
            for (int b = 0; b < 2; ++b)
#pragma unroll
                for (int m = 0; m < 4; ++m)
#pragma unroll
                    for (int n = 0; n < 2; ++n) acc[a][b][m][n] = (f32x4){0.f, 0.f, 0.f, 0.f};
        cur = nxt; cA = nA; cB = nB; ++ui;
        if constexpr (ALIGN_EPI) { if (wr == 1) PG8_BAR; }
    }
    PG8_WAIT_V(0);
    if constexpr (!ALIGN_EPI) { if (wr == 0) PG8_BAR; }
    PG8_BAR;
    if constexpr (Epi::AFTER_DRAIN) { E.fused(acc, cur, wr, wc, fr, fq, lds, wid, lane); S.done(cur); }
#undef PG8_SA
#undef PG8_SB
#undef PG8_STAGE
#undef PG8_LDA
#undef PG8_LDB
#undef PG8_MMA
#undef PG8_WAIT_V
#undef PG8_WAIT_L
#undef PG8_BAR
#undef PG8_SCHED
}
}
#define GAS __attribute__((address_space(1)))
#define LAS __attribute__((address_space(3)))

typedef unsigned v4u __attribute__((ext_vector_type(4)));


typedef GAS unsigned gu32;
typedef GAS unsigned long long gu64;
#define RLX_AGENT __ATOMIC_RELAXED, __HIP_MEMORY_SCOPE_AGENT
#define LDS_WAIT() asm volatile("s_waitcnt lgkmcnt(0)" ::: "memory")
#define VM_WAIT() asm volatile("s_waitcnt vmcnt(0)" ::: "memory")
#define XB_TMO      128
#define XB_XCNT(j)  (256  + 64 * (j))
#define XB_XSUB(j)  (1280 + 64 * (j))
#define XB_XGEN(j)  (2304 + 64 * (j))
#define XB_TOP      3328
#define XB_TOPGEN   3392
#define XCD_BAR_WORDS 3456
#define XB_SPIN_CAP (1u << 18)

__device__ __forceinline__ unsigned xb_ld(unsigned* p)              { return __hip_atomic_load(p, __ATOMIC_RELAXED, __HIP_MEMORY_SCOPE_AGENT); }
__device__ __forceinline__ unsigned xb_add(unsigned* p, unsigned v) { return __hip_atomic_fetch_add(p, v, __ATOMIC_RELAXED, __HIP_MEMORY_SCOPE_AGENT); }
__device__ __forceinline__ unsigned xb_xcc_id() { return (unsigned)__builtin_amdgcn_s_getreg((3 << 11) | 20) & 0xFu; }
#define XB_SPIN(cond, bar) do { unsigned _sp = 0; while (cond) { __builtin_amdgcn_s_sleep(1); \
    if ((++_sp & 255u) == 0u) { if (xb_ld(&(bar)[XB_TMO])) break; if (_sp > XB_SPIN_CAP) { atomicAdd(&(bar)[XB_TMO], 1u); break; } } } } while (0)

struct XcdBarrier {
    unsigned* bar; unsigned x;
    volatile LAS unsigned* st;
};

__device__ __forceinline__ XcdBarrier xcd_barrier_post(unsigned* bar, volatile LAS unsigned* st) {
    XcdBarrier b; b.bar = bar; b.x = xb_xcc_id(); b.st = st;
    if (threadIdx.x == 0) (void)xb_add(&bar[XB_XCNT(b.x)], 1u);
    return b;
}
__device__ __forceinline__ void xcd_barrier_complete(unsigned* bar, unsigned x, unsigned& nloc, unsigned& nx) {
    const unsigned G = gridDim.x * gridDim.y * gridDim.z;
    unsigned sum, cnt, mine, sp = 0u;
    for (;;) {
        sum = 0u; cnt = 0u; mine = 0u;
#pragma unroll
        for (unsigned j = 0; j < 16; ++j) { const unsigned c = xb_ld(&bar[XB_XCNT(j)]); sum += c; cnt += (c > 0u) ? 1u : 0u; mine = (j == x) ? c : mine; }
        if (sum == G) break;
        __builtin_amdgcn_s_sleep(1);
        if ((++sp & 255u) == 0u) { if (xb_ld(&bar[XB_TMO])) break; if (sp > XB_SPIN_CAP) { atomicAdd(&bar[XB_TMO], 1u); break; } }
    }
    nloc = mine > 0u ? mine : 1u; nx = cnt > 0u ? cnt : 1u;
}

__device__ __forceinline__ void xcd_barrier(const XcdBarrier& b) {
    asm volatile("s_waitcnt vmcnt(0)" ::: "memory");
    __syncthreads();
    if (threadIdx.x == 0) {
        unsigned* bar = b.bar; asm volatile("" : "+s"(bar)); unsigned bx = b.x; asm volatile("" : "+s"(bx));
        __builtin_amdgcn_s_waitcnt(0);
        unsigned nloc = b.st[0], nx = b.st[1];
        if (nloc == 0u) { xcd_barrier_complete(bar, bx, nloc, nx); b.st[0] = nloc; b.st[1] = nx; }
        const unsigned old = xb_add(&bar[XB_XSUB(bx)], 1u);
        const unsigned gen = old / nloc;
        if (old + 1u == (gen + 1u) * nloc) {
            __builtin_amdgcn_fence(__ATOMIC_RELEASE, "agent");
            asm volatile("s_waitcnt vmcnt(0)" ::: "memory");
            const unsigned og = xb_add(&bar[XB_TOP], 1u);
            const unsigned tg = og / nx;
            if (og + 1u == (tg + 1u) * nx) xb_add(&bar[XB_TOPGEN], 1u);
            else XB_SPIN(xb_ld(&bar[XB_TOPGEN]) == tg, bar);
            __builtin_amdgcn_fence(__ATOMIC_ACQUIRE, "agent");
            xb_add(&bar[XB_XGEN(bx)], 1u);
            asm volatile("s_waitcnt vmcnt(0)" ::: "memory");
        } else {
            XB_SPIN(xb_ld(&bar[XB_XGEN(bx)]) == gen, bar);
            __builtin_amdgcn_fence(__ATOMIC_ACQUIRE, "agent");
            asm volatile("s_waitcnt vmcnt(0)" ::: "memory");
        }
    }
    __syncthreads();
}

typedef unsigned short bf16_t;
constexpr int NB = 16, SEQ = 2048, DM = 1024, MTOK = NB * SEQ, DEPTH = 4, DIN = 2964, DINP = 3072, DFF = 4096;
constexpr int ZC_MQ = 0, ZC_MK = 256, ZC_MV = 512, ZC_LQ = 768, ZC_LK = 1024, ZC_LV = 1280, ZC_LO = 1792, ZC_LI = 2304, ZC_LF = 2308,
              ZC_NQ = 2312, ZC_KC = 2568, ZC_VC = 2632, ZC_KSL = 2696, ZC_VSL = 2760, ZC_KWN = 2824, ZC_VWN = 2888, ZC_NG = 2952;
constexpr float EPS = 1e-6f;
constexpr size_t MiB = 1u << 20;
constexpr size_t WS_CTL = 0, CTL_ZERO_BYTES = 1 * MiB;
constexpr size_t WS_WIN = 1 * MiB, WS_WOUT = 7 * MiB, WS_W1 = 9 * MiB, WS_W2 = 17 * MiB;
constexpr size_t WS_CW1 = 25 * MiB;
constexpr size_t WS_CW2 = 27 * MiB;
constexpr size_t WS_CPE = 27 * MiB + 65536;
constexpr size_t WS_KMEAN = 28 * MiB, WS_RS = 28 * MiB + 256 * 1024;
constexpr size_t WS_KCMP = 28 * MiB + 512 * 1024, WS_VCMP = 28 * MiB + 768 * 1024;
constexpr size_t WS_GATES = 30 * MiB;
constexpr size_t WS_XB = 32 * MiB;
constexpr size_t WS_T2 = 96 * MiB;
constexpr size_t WS_QKC = 96 * MiB;
constexpr size_t WS_CC = 128 * MiB, WS_CPREV = 160 * MiB;
constexpr size_t WS_HID = 128 * MiB;
constexpr size_t WS_BIG = 192 * MiB;
constexpr size_t WS_Z = WS_BIG, WS_Y = WS_BIG + 192 * MiB, WS_H = WS_BIG, WS_T = WS_BIG;
constexpr size_t WS_HN = 448 * MiB;
constexpr size_t WS_END = 512 * MiB;
constexpr int CW_BAR = 4096;

__device__ __forceinline__ float bf2f(bf16_t v) { return __uint_as_float(((unsigned)v) << 16); }
__device__ __forceinline__ bf16_t f2bf(float f) { unsigned u = __float_as_uint(f); u += 0x7fffu + ((u >> 16) & 1u); return (bf16_t)(u >> 16); }
__device__ __forceinline__ unsigned pk2bf(float lo, float hi) { return (unsigned)f2bf(lo) | ((unsigned)f2bf(hi) << 16); }
__device__ __forceinline__ float wave_sum(float v) {
#pragma unroll
    for (int o = 1; o < 64; o <<= 1) v += __shfl_xor(v, o);
    return v;
}
__device__ __forceinline__ float wave_max(float v) {
#pragma unroll
    for (int o = 1; o < 64; o <<= 1) v = fmaxf(v, __shfl_xor(v, o));
    return v;
}
__device__ __forceinline__ float lane_get(float v, int src_lane) { return __int_as_float(__builtin_amdgcn_ds_bpermute(src_lane << 2, __float_as_int(v))); }
__device__ __forceinline__ float sigmoidf_(float x) { return __builtin_amdgcn_rcpf(1.f + __builtin_amdgcn_exp2f(-1.4426950408889634f * x)); }
__device__ __forceinline__ float gelu_tanh(float x) { const float u = 0.7978845608028654f * (x + 0.044715f * x * x * x); return 0.5f * x * (1.f + tanhf(u)); }

struct Ctx {
    const float *x_in, *norm_g, *w_in, *conv_w, *conv_b, *gate_b, *cmp_pe, *cmp_w1, *cmp_w2, *head_g, *w_out, *w1, *w2;
    float* xo; unsigned char* ws; unsigned char* lds;
    int tid, lane, wave, bid, nb;
};

__device__ __forceinline__ void wconv_tile(const float* __restrict__ src, bf16_t* __restrict__ dst, int K, int N, int Npad, int it, int t256, float* tile  , bool active, const float* __restrict__ gk = nullptr  ) {
    const int ntn = Npad / 64, tk = it / ntn, tn = it % ntn, k0 = tk * 64, n0 = tn * 64;
    if (active) {
#pragma unroll
        for (int i = 0; i < 4; ++i) { const int kk = i * 16 + (t256 >> 4), nn = 4 * (t256 & 15); const int n = n0 + nn;
            float4 w = (n < N) ? *(const float4*)(src + (size_t)(k0 + kk) * N + n) : make_float4(0.f, 0.f, 0.f, 0.f);
            if (gk) { const float gg = gk[k0 + kk]; w.x *= gg; w.y *= gg; w.z *= gg; w.w *= gg; }
            tile[kk * 65 + nn] = w.x; tile[kk * 65 + nn + 1] = w.y; tile[kk * 65 + nn + 2] = w.z; tile[kk * 65 + nn + 3] = w.w; }
    }
    __syncthreads();
    if (active) {
        const int nn = t256 >> 2, ks = (t256 & 3) * 16;
        unsigned w[8];
#pragma unroll
        for (int j = 0; j < 8; ++j) w[j] = pk2bf(tile[(ks + 2 * j) * 65 + nn], tile[(ks + 2 * j + 1) * 65 + nn]);
        uint4* o = (uint4*)(dst + (size_t)(n0 + nn) * K + k0 + ks);
        o[0] = make_uint4(w[0], w[1], w[2], w[3]); o[1] = make_uint4(w[4], w[5], w[6], w[7]);
    }
    __syncthreads();
}
__device__ __forceinline__ void ph_wconv(const Ctx& c_, int L) {
    Ctx c = c_; c.lane = (int)__builtin_amdgcn_mbcnt_hi(~0u, __builtin_amdgcn_mbcnt_lo(~0u, 0u)); asm volatile("" : "+v"(c.lane)); c.tid = c.wave * 64 + c.lane; asm volatile("" : "+s"(c.bid)); asm volatile("" : "+s"(c.ws));
    const int half = c.tid >> 8, t256 = c.tid & 255; float* tile = (float*)(c.lds) + half * (64 * 65);
    constexpr int T_IN = (DM / 64) * (DINP / 64), T_OUT = (DM / 64) * (DM / 64), T_1 = (DM / 64) * (DFF / 64), T_2 = (DFF / 64) * (DM / 64), TOT = T_IN + T_OUT + T_1 + T_2;
    for (int base = c.bid * 2; base < TOT; base += c.nb * 2) {
        int it = base + half; const bool act = it < TOT;
        if (!act) it = 0;
        const float* src; bf16_t* dst; int K, N, Np; const float* gk = nullptr;
        if (it < T_IN) { src = c.w_in + (size_t)L * DM * DIN; dst = (bf16_t*)(c.ws + WS_WIN); K = DM; N = DIN; Np = DINP; gk = c.norm_g + (size_t)L * 4 * DM; }
        else if ((it -= T_IN) < T_OUT) { src = c.w_out + (size_t)L * DM * DM; dst = (bf16_t*)(c.ws + WS_WOUT); K = DM; N = DM; Np = DM; }
        else if ((it -= T_OUT) < T_1) { src = c.w1 + (size_t)L * DM * DFF; dst = (bf16_t*)(c.ws + WS_W1); K = DM; N = DFF; Np = DFF; gk = c.norm_g + (size_t)L * 4 * DM + 2 * DM; }
        else { it -= T_1; src = c.w2 + (size_t)L * DFF * DM; dst = (bf16_t*)(c.ws + WS_W2); K = DFF; N = DM; Np = DM; }
        wconv_tile(src, dst, K, N, Np, it, t256, tile, act, gk);
    }
}

template <bool SRC_BF, bool DST_BF>
__device__ __forceinline__ void ph_resid(const Ctx& c_, const void* __restrict__ xsrc, const bf16_t* __restrict__ T, void* xdst, const float* __restrict__ ga, float* RS) {
    Ctx c = c_; c.lane = (int)__builtin_amdgcn_mbcnt_hi(~0u, __builtin_amdgcn_mbcnt_lo(~0u, 0u)); asm volatile("" : "+v"(c.lane)); c.tid = c.wave * 64 + c.lane; asm volatile("" : "+s"(c.bid)); asm volatile("" : "+s"(c.ws));
    const int lane = c.lane;
    for (int row0 = c.bid * 8 + c.wave; row0 < MTOK / 2; row0 += c.nb * 8) {
        float4 v[2][4]; float4 t[2][4];
#pragma unroll
        for (int u = 0; u < 2; ++u) { const int row = row0 + u * (MTOK / 2);
            if (SRC_BF) { const uint2* xr = (const uint2*)((const bf16_t*)xsrc + (size_t)row * DM) + lane;
#pragma unroll
                for (int j = 0; j < 4; ++j) { const uint2 w = xr[64 * j]; v[u][j].x = __uint_as_float(w.x << 16); v[u][j].y = __uint_as_float(w.x & 0xffff0000u); v[u][j].z = __uint_as_float(w.y << 16); v[u][j].w = __uint_as_float(w.y & 0xffff0000u); } }
            else { const float4* xr = (const float4*)((const float*)xsrc + (size_t)row * DM) + lane;
#pragma unroll
                for (int j = 0; j < 4; ++j) v[u][j] = xr[64 * j]; }
            if (T) { const uint2* tr = (const uint2*)(T + (size_t)row * DM) + lane;
#pragma unroll
                for (int j = 0; j < 4; ++j) { const uint2 w = tr[64 * j]; t[u][j].x = __uint_as_float(w.x << 16); t[u][j].y = __uint_as_float(w.x & 0xffff0000u); t[u][j].z = __uint_as_float(w.y << 16); t[u][j].w = __uint_as_float(w.y & 0xffff0000u); } }
        }
#pragma unroll
        for (int u = 0; u < 2; ++u) { const int row = row0 + u * (MTOK / 2);
            if (T) { float ss = 0.f;
#pragma unroll
                for (int j = 0; j < 4; ++j) ss += t[u][j].x * t[u][j].x + t[u][j].y * t[u][j].y + t[u][j].z * t[u][j].z + t[u][j].w * t[u][j].w;
                const float r = rsqrtf(wave_sum(ss) * (1.f / DM) + EPS);
#pragma unroll
                for (int j = 0; j < 4; ++j) { const float4 g = ((const float4*)ga)[lane + 64 * j];
                    v[u][j].x += t[u][j].x * r * g.x; v[u][j].y += t[u][j].y * r * g.y; v[u][j].z += t[u][j].z * r * g.z; v[u][j].w += t[u][j].w * r * g.w; } }
            if (DST_BF) { uint2* xo = (uint2*)((bf16_t*)xdst + (size_t)row * DM) + lane;
#pragma unroll
                for (int j = 0; j < 4; ++j) { uint2 w; w.x = pk2bf(v[u][j].x, v[u][j].y); w.y = pk2bf(v[u][j].z, v[u][j].w); xo[64 * j] = w;
                    v[u][j].x = __uint_as_float(w.x << 16); v[u][j].y = __uint_as_float(w.x & 0xffff0000u); v[u][j].z = __uint_as_float(w.y << 16); v[u][j].w = __uint_as_float(w.y & 0xffff0000u); } }
            else { float4* xo = (float4*)((float*)xdst + (size_t)row * DM) + lane;
#pragma unroll
                for (int j = 0; j < 4; ++j) xo[64 * j] = v[u][j]; }
            if (RS) { float ss = 0.f;
#pragma unroll
                for (int j = 0; j < 4; ++j) ss += v[u][j].x * v[u][j].x + v[u][j].y * v[u][j].y + v[u][j].z * v[u][j].z + v[u][j].w * v[u][j].w;
                const float r = rsqrtf(wave_sum(ss) * (1.f / DM) + EPS);
                if (lane == 0) RS[row] = r; }
        }
    }
}

__device__ __forceinline__ void wsync() { asm volatile("s_waitcnt lgkmcnt(0)" ::: "memory"); }

__device__ __forceinline__ void nv_kmean(const Ctx& c_) {
    Ctx c = c_; c.lane = (int)__builtin_amdgcn_mbcnt_hi(~0u, __builtin_amdgcn_mbcnt_lo(~0u, 0u)); asm volatile("" : "+v"(c.lane)); c.tid = c.wave * 64 + c.lane; asm volatile("" : "+s"(c.bid)); asm volatile("" : "+s"(c.ws));
    const bf16_t* Z = (const bf16_t*)(c.ws + WS_Z); float* kmean = (float*)(c.ws + WS_KMEAN);
    for (int it = c.bid * 8 + c.wave; it < 512; it += c.nb * 8) {
        const int bh = it >> 3, n = it & 7, b = bh >> 2, h = bh & 3, d = c.lane;
        const bf16_t* p = Z + ((size_t)b * SEQ + n * 256) * DINP + ZC_MK + h * 64 + d; float s = 0.f;
        for (int i = 0; i < 256; ++i) s += bf2f(p[(size_t)i * DINP]);
        kmean[(size_t)it * 64 + d] = s * (1.f / 256.f);
    }
}
__device__ __forceinline__ void nv_moba(const Ctx& c_, int L) {
    Ctx c = c_; c.lane = (int)__builtin_amdgcn_mbcnt_hi(~0u, __builtin_amdgcn_mbcnt_lo(~0u, 0u)); asm volatile("" : "+v"(c.lane)); c.tid = c.wave * 64 + c.lane; asm volatile("" : "+s"(c.bid)); asm volatile("" : "+s"(c.ws));
    const bf16_t* Z = (const bf16_t*)(c.ws + WS_Z); const float* kmean = (const float*)(c.ws + WS_KMEAN); bf16_t* Y = (bf16_t*)(c.ws + WS_Y); const float* hg = c.head_g + (size_t)L * DM;
    float* base = (float*)(c.lds + c.wave * 4608); float* qs = base; float* sc = base + 64; float* gate = base + 64 + 1024; int* blks = (int*)(base + 64 + 1024 + 8); int* nblk_s = blks + 4;
    const int lane = c.lane;
    for (int idx = c.bid * 8 + c.wave; idx < MTOK * 4; idx += c.nb * 8) {
        const int h = idx & 3, m = idx >> 2, b = m / SEQ, t = m % SEQ, cur = t >> 8;
        wsync();
        qs[lane] = bf2f(Z[(size_t)m * DINP + ZC_MQ + h * 64 + lane]);
        wsync();
        for (int n = 0; n < cur; ++n) { const float g = wave_sum(qs[lane] * kmean[((size_t)(b * 4 + h) * 8 + n) * 64 + lane]); if (lane == 0) gate[n] = g; }
        wsync();
        if (lane == 0) {
            int nb = 0;
            if (cur <= 3) { for (int n = 0; n < cur; ++n) blks[nb++] = n; }
            else { unsigned used = 0; for (int k = 0; k < 3; ++k) { int best = -1; float bv = -INFINITY; for (int n = 0; n < cur; ++n) if (!((used >> n) & 1u) && gate[n] > bv) { bv = gate[n]; best = n; }
                    if (best < 0) { for (int n = 0; n < cur; ++n) if (!((used >> n) & 1u)) { best = n; break; } }
                    used |= 1u << best; blks[nb++] = best; } }
            *nblk_s = nb;
        }
        wsync();
        const int nb = *nblk_s, nown = t - cur * 256 + 1, total = nb * 256 + nown;
        const bf16_t* Kb = Z + (size_t)b * SEQ * DINP + ZC_MK + h * 64; const bf16_t* Vb = Z + (size_t)b * SEQ * DINP + ZC_MV + h * 64;
        float mx = -INFINITY;
        for (int kk = lane; kk < total; kk += 64) { const int bi = kk >> 8, blk = bi < nb ? blks[bi] : cur, key = blk * 256 + (kk & 255);
            const uint4* kr = (const uint4*)(Kb + (size_t)key * DINP); float s = 0.f;
#pragma unroll
            for (int cc = 0; cc < 8; ++cc) { const uint4 w = kr[cc]; const unsigned ww[4] = {w.x, w.y, w.z, w.w};
#pragma unroll
                for (int j = 0; j < 4; ++j) { s += qs[cc * 8 + 2 * j] * __uint_as_float(ww[j] << 16) + qs[cc * 8 + 2 * j + 1] * __uint_as_float(ww[j] & 0xffff0000u); } }
            s *= 0.125f; sc[kk] = s; mx = fmaxf(mx, s); }
        mx = wave_max(mx);
        float sum = 0.f;
        for (int kk = lane; kk < total; kk += 64) { const float p = __expf(sc[kk] - mx); sc[kk] = p; sum += p; }
        sum = wave_sum(sum);
        wsync();
        float acc = 0.f;
        for (int kk = 0; kk < total; ++kk) { const int bi = kk >> 8, blk = bi < nb ? blks[bi] : cur, key = blk * 256 + (kk & 255); acc += sc[kk] * bf2f(Vb[(size_t)key * DINP + lane]); }
        const float o = acc / sum;
        const float ss = wave_sum(o * o);
        Y[(size_t)m * DM + h * 64 + lane] = f2bf(o * rsqrtf(ss * (1.f / 64.f) + EPS) * hg[h * 64 + lane]);
    }
}

__device__ __forceinline__ void nv_cmp(const Ctx& c_, int L) {
    Ctx c = c_; c.lane = (int)__builtin_amdgcn_mbcnt_hi(~0u, __builtin_amdgcn_mbcnt_lo(~0u, 0u)); asm volatile("" : "+v"(c.lane)); c.tid = c.wave * 64 + c.lane; asm volatile("" : "+s"(c.bid)); asm volatile("" : "+s"(c.ws));
    const bf16_t* Z = (const bf16_t*)(c.ws + WS_Z); float* kcmp = (float*)(c.ws + WS_KCMP); float* vcmp = (float*)(c.ws + WS_VCMP);
    const int half = c.tid >> 8, tid = c.tid & 255;
    float* blk = (float*)(c.lds + half * 36864); float* hid = blk + 4 * 2048;
    for (int base = c.bid * 2; base < 1024; base += c.nb * 2) {
        const int item = base + half; const int g4 = item & 31, kv = (item >> 5) & 1, b = item >> 6;
        const int col = kv ? ZC_VC : ZC_KC; const float* pej = c.cmp_pe + ((size_t)L * 2 + kv) * 2048; const float* w1j = c.cmp_w1 + ((size_t)L * 2 + kv) * 2048 * 256; const float* w2j = c.cmp_w2 + ((size_t)L * 2 + kv) * 256 * 64;
        for (int i = tid; i < 4 * 2048; i += 256) { const int g = i >> 11, e = i & 2047, l = e >> 6, d = e & 63, n = g4 * 4 + g; const int t = 16 * n + l;
            blk[g * 2048 + e] = (n < 127) ? bf2f(Z[((size_t)b * SEQ + t) * DINP + col + d]) + pej[e] : 0.f; }
        __syncthreads();
        float a0 = 0.f, a1 = 0.f, a2 = 0.f, a3 = 0.f;
        for (int i = 0; i < 2048; ++i) { const float w = w1j[(size_t)i * 256 + tid]; a0 += blk[i] * w; a1 += blk[2048 + i] * w; a2 += blk[4096 + i] * w; a3 += blk[6144 + i] * w; }
        hid[tid] = gelu_tanh(a0); hid[256 + tid] = gelu_tanh(a1); hid[512 + tid] = gelu_tanh(a2); hid[768 + tid] = gelu_tanh(a3);
        __syncthreads();
        const int g = tid >> 6, d = tid & 63, n = g4 * 4 + g; float o = 0.f;
        for (int j = 0; j < 256; ++j) o += hid[g * 256 + j] * w2j[j * 64 + d];
        float* dst = kv ? vcmp : kcmp; dst[((size_t)b * 128 + n) * 64 + d] = (n < 127) ? o : 0.f;
        __syncthreads();
    }
}

__device__ __forceinline__ void nv_nsa(const Ctx& c_, int L) {
    Ctx c = c_; c.lane = (int)__builtin_amdgcn_mbcnt_hi(~0u, __builtin_amdgcn_mbcnt_lo(~0u, 0u)); asm volatile("" : "+v"(c.lane)); c.tid = c.wave * 64 + c.lane; asm volatile("" : "+s"(c.bid)); asm volatile("" : "+s"(c.ws));
    const bf16_t* Z = (const bf16_t*)(c.ws + WS_Z); const float* kcmp = (const float*)(c.ws + WS_KCMP); const float* vcmp = (const float*)(c.ws + WS_VCMP); bf16_t* Y = (bf16_t*)(c.ws + WS_Y); const float* hg = c.head_g + (size_t)L * DM;
    const int half = c.tid >> 8, tid = c.tid & 255, h = tid >> 6, lane = tid & 63;
    float* base = (float*)(c.lds + 40960 + half * 12288);
    float* qs = base;
    float* pc = base + 256;
    float* Psum = base + 768;
    float* pslc = base + 896;
    unsigned* selmask = (unsigned*)(base + 928);
    float* sc = base + 1024;
    for (int m0 = c.bid * 2; m0 < MTOK; m0 += c.nb * 2) {
        const int m = m0 + half, b = m / SEQ, t = m % SEQ, cur = t >> 6;
        const bf16_t* zr = Z + (size_t)m * DINP;
        qs[h * 64 + lane] = bf2f(zr[ZC_NQ + h * 64 + lane]);
        pc[h * 128 + lane] = 0.f; pc[h * 128 + lane + 64] = 0.f;
        __syncthreads();
        const int nvis = t >= 31 ? (t - 31) / 16 + 1 : 0;
        const float* kc = kcmp + (size_t)b * 128 * 64; const float* vc = vcmp + (size_t)b * 128 * 64;
        float o_cmp = 0.f;
        if (nvis > 0) {
            float s0 = -INFINITY, s1 = -INFINITY;
            if (lane < nvis) { float s = 0.f; for (int d = 0; d < 64; ++d) s += qs[h * 64 + d] * kc[lane * 64 + d]; s0 = s * 0.125f; }
            if (lane + 64 < nvis) { float s = 0.f; for (int d = 0; d < 64; ++d) s += qs[h * 64 + d] * kc[(lane + 64) * 64 + d]; s1 = s * 0.125f; }
            const float mx = wave_max(fmaxf(s0, s1));
            const float p0 = lane < nvis ? __expf(s0 - mx) : 0.f, p1 = lane + 64 < nvis ? __expf(s1 - mx) : 0.f;
            const float sum = wave_sum(p0 + p1);
            pc[h * 128 + lane] = p0 / sum; pc[h * 128 + lane + 64] = p1 / sum;
        }
        __syncthreads();
        if (nvis > 0) { for (int n = 0; n < nvis; ++n) o_cmp += pc[h * 128 + n] * vc[n * 64 + lane]; }
        if (tid < 128) Psum[tid] = pc[tid] + pc[128 + tid] + pc[256 + tid] + pc[384 + tid];
        __syncthreads();
        if (tid < 32) { const int j = tid; float s = 0.f;
            if (4 * j - 1 >= 0) s += 0.5f * Psum[4 * j - 1];
            s += Psum[4 * j]; s += Psum[4 * j + 1]; s += Psum[4 * j + 2];
            if (4 * j + 3 <= 126) s += 0.5f * Psum[4 * j + 3];
            pslc[j] = s; }
        __syncthreads();
        if (tid == 0) {
            unsigned mask;
            if (cur <= 7) mask = (2u << cur) - 1u;
            else { mask = 1u | (1u << cur) | (1u << (cur - 1));
                for (int k = 0; k < 5; ++k) { int best = -1; float bv = -INFINITY; for (int j = 1; j <= cur - 2; ++j) if (!((mask >> j) & 1u) && pslc[j] > bv) { bv = pslc[j]; best = j; }
                    if (best < 0) { for (int j = 1; j <= cur - 2; ++j) if (!((mask >> j) & 1u)) { best = j; break; } }
                    mask |= 1u << best; } }
            *selmask = mask;
        }
        __syncthreads();
        const unsigned mask = *selmask;
        const bf16_t* Zb = Z + (size_t)b * SEQ * DINP;
        float o_sel, o_win;
        {
            int cnt = 0; float mx = -INFINITY;
            for (int j = 0; j <= cur; ++j) if ((mask >> j) & 1u) { const int key = j * 64 + lane; float s = -INFINITY;
                if (key <= t) { const bf16_t* kr = Zb + (size_t)key * DINP + ZC_KSL; float a = 0.f; for (int d = 0; d < 64; ++d) a += qs[h * 64 + d] * bf2f(kr[d]); s = a * 0.125f; }
                sc[h * 512 + cnt * 64 + lane] = s; mx = fmaxf(mx, s); ++cnt; }
            mx = wave_max(mx); float sum = 0.f;
            for (int i = 0; i < cnt; ++i) { const float s = sc[h * 512 + i * 64 + lane]; const float p = (s == -INFINITY) ? 0.f : __expf(s - mx); sc[h * 512 + i * 64 + lane] = p; sum += p; }
            sum = wave_sum(sum);
            __syncthreads();
            float acc = 0.f; int i = 0;
            for (int j = 0; j <= cur; ++j) if ((mask >> j) & 1u) { for (int k = 0; k < 64; ++k) acc += sc[h * 512 + i * 64 + k] * bf2f(Zb[(size_t)(j * 64 + k) * DINP + ZC_VSL + lane]); ++i; }
            o_sel = acc / sum;
            __syncthreads();
        }
        {
            float mx = -INFINITY;
            for (int i = 0; i < 8; ++i) { const int key = t - 511 + i * 64 + lane; float s = -INFINITY;
                if (key >= 0) { const bf16_t* kr = Zb + (size_t)key * DINP + ZC_KWN; float a = 0.f; for (int d = 0; d < 64; ++d) a += qs[h * 64 + d] * bf2f(kr[d]); s = a * 0.125f; }
                sc[h * 512 + i * 64 + lane] = s; mx = fmaxf(mx, s); }
            mx = wave_max(mx); float sum = 0.f;
            for (int i = 0; i < 8; ++i) { const float s = sc[h * 512 + i * 64 + lane]; const float p = (s == -INFINITY) ? 0.f : __expf(s - mx); sc[h * 512 + i * 64 + lane] = p; sum += p; }
            sum = wave_sum(sum);
            __syncthreads();
            float acc = 0.f;
            for (int kk = 0; kk < 512; ++kk) { const int key = t - 511 + kk; if (key >= 0) acc += sc[h * 512 + kk] * bf2f(Zb[(size_t)key * DINP + ZC_VWN + lane]); }
            o_win = acc / sum;
        }
        const float g0 = sigmoidf_(bf2f(zr[ZC_NG + h * 3 + 0])), g1 = sigmoidf_(bf2f(zr[ZC_NG + h * 3 + 1])), g2 = sigmoidf_(bf2f(zr[ZC_NG + h * 3 + 2]));
        const float o = g0 * o_cmp + g1 * o_sel + g2 * o_win;
        const float ss = wave_sum(o * o);
        Y[(size_t)m * DM + 768 + h * 64 + lane] = f2bf(o * rsqrtf(ss * (1.f / 64.f) + EPS) * hg[768 + h * 64 + lane]);
        __syncthreads();
    }
}

__device__ __forceinline__ void nv_ml_conv(const Ctx& c_, int L) {
    Ctx c = c_; c.lane = (int)__builtin_amdgcn_mbcnt_hi(~0u, __builtin_amdgcn_mbcnt_lo(~0u, 0u)); asm volatile("" : "+v"(c.lane)); c.tid = c.wave * 64 + c.lane; asm volatile("" : "+s"(c.bid)); asm volatile("" : "+s"(c.ws));
    const bf16_t* Z = (const bf16_t*)(c.ws + WS_Z); bf16_t* QKC = (bf16_t*)(c.ws + WS_QKC); float* gates = (float*)(c.ws + WS_GATES);
    const float* cw = c.conv_w + (size_t)L * 4 * 512; const float* cb = c.conv_b + (size_t)L * 512; const float* gb = c.gate_b + (size_t)L * 8;
    const int tid = c.tid;
    for (int m = c.bid; m < MTOK; m += c.nb) { const int t = m % SEQ;
        float a = cb[tid];
#pragma unroll
        for (int j = 0; j < 4; ++j) { const int tt = t - 3 + j; if (tt >= 0) a += bf2f(Z[(size_t)(m - 3 + j) * DINP + ZC_LQ + tid]) * cw[j * 512 + tid]; }
        float y = a / (1.f + __expf(-a)); if (tid >= 256) y *= 0.125f;
        QKC[(size_t)m * 512 + tid] = f2bf(y);
        if (tid < 4) gates[(size_t)m * 8 + tid] = bf2f(Z[(size_t)m * DINP + ZC_LI + tid]) + gb[tid];
        else if (tid < 8) { const float x = bf2f(Z[(size_t)m * DINP + ZC_LF + (tid - 4)]) + gb[tid]; gates[(size_t)m * 8 + tid] = fminf(x, 0.f) - log1pf(__expf(-fabsf(x))); }
    }
}
__device__ __forceinline__ void nv_ml(const Ctx& c_) {
    Ctx c = c_; c.lane = (int)__builtin_amdgcn_mbcnt_hi(~0u, __builtin_amdgcn_mbcnt_lo(~0u, 0u)); asm volatile("" : "+v"(c.lane)); c.tid = c.wave * 64 + c.lane; asm volatile("" : "+s"(c.bid)); asm volatile("" : "+s"(c.ws));
    if (c.bid >= 64) return;
    const bf16_t* Z = (const bf16_t*)(c.ws + WS_Z); const bf16_t* QKC = (const bf16_t*)(c.ws + WS_QKC); const float* gates = (const float*)(c.ws + WS_GATES); float* HID = (float*)(c.ws + WS_HID);
    const int b = c.bid >> 2, h = c.bid & 3, tid = c.tid, v = tid >> 2, kq = (tid & 3) * 16;
    float C[16], nn[16];
#pragma unroll
    for (int j = 0; j < 16; ++j) { C[j] = 0.f; nn[j] = 0.f; }
    for (int t = 0; t < SEQ; ++t) { const size_t m = (size_t)b * SEQ + t;
        const float ig = gates[m * 8 + h], lf = gates[m * 8 + 4 + h]; const float f = __expf(lf), ii = __expf(ig), iv = ii * bf2f(Z[m * DINP + ZC_LV + h * 128 + v]);
        const uint4* qp = (const uint4*)(QKC + m * 512 + h * 64 + kq); const uint4* kp = (const uint4*)(QKC + m * 512 + 256 + h * 64 + kq);
        const uint4 q0 = qp[0], q1 = qp[1], k0 = kp[0], k1 = kp[1];
        const unsigned qw[8] = {q0.x, q0.y, q0.z, q0.w, q1.x, q1.y, q1.z, q1.w}, kw[8] = {k0.x, k0.y, k0.z, k0.w, k1.x, k1.y, k1.z, k1.w};
        float num = 0.f, den = 0.f;
#pragma unroll
        for (int j = 0; j < 8; ++j) { const float ka = __uint_as_float(kw[j] << 16), kb = __uint_as_float(kw[j] & 0xffff0000u), qa = __uint_as_float(qw[j] << 16), qb = __uint_as_float(qw[j] & 0xffff0000u);
            C[2 * j] = f * C[2 * j] + iv * ka; C[2 * j + 1] = f * C[2 * j + 1] + iv * kb; nn[2 * j] = f * nn[2 * j] + ii * ka; nn[2 * j + 1] = f * nn[2 * j + 1] + ii * kb;
            num += C[2 * j] * qa + C[2 * j + 1] * qb; den += nn[2 * j] * qa + nn[2 * j + 1] * qb; }
        num += __shfl_xor(num, 1); num += __shfl_xor(num, 2); den += __shfl_xor(den, 1); den += __shfl_xor(den, 2);
        if ((tid & 3) == 0) HID[m * 512 + h * 128 + v] = num / fmaxf(fabsf(den), 1.f);
    }
}
__device__ __forceinline__ void nv_ml_post(const Ctx& c_, int L) {
    Ctx c = c_; c.lane = (int)__builtin_amdgcn_mbcnt_hi(~0u, __builtin_amdgcn_mbcnt_lo(~0u, 0u)); asm volatile("" : "+v"(c.lane)); c.tid = c.wave * 64 + c.lane; asm volatile("" : "+s"(c.bid)); asm volatile("" : "+s"(c.ws));
    const bf16_t* Z = (const bf16_t*)(c.ws + WS_Z); const float* HID = (const float*)(c.ws + WS_HID); bf16_t* Y = (bf16_t*)(c.ws + WS_Y); const float* hg = c.head_g + (size_t)L * DM;
    float* part = (float*)(c.lds + 65536); const int tid = c.tid, w = c.wave;
    for (int m = c.bid; m < MTOK; m += c.nb) {
        const float x = HID[(size_t)m * 512 + tid]; const float s = wave_sum(x * x);
        if ((tid & 63) == 0) part[w] = s;
        __syncthreads();
        const float ss = part[(w & ~1)] + part[(w | 1)];
        const float lo = bf2f(Z[(size_t)m * DINP + ZC_LO + tid]);
        Y[(size_t)m * DM + 256 + tid] = f2bf(x * rsqrtf(ss * (1.f / 128.f) + EPS) * hg[256 + tid] * sigmoidf_(lo));
        __syncthreads();
    }
}

typedef float f32x16 __attribute__((ext_vector_type(16)));
typedef short bf16x8v __attribute__((ext_vector_type(8)));
typedef short s16x4v __attribute__((ext_vector_type(4)));
typedef unsigned u32x4v __attribute__((ext_vector_type(4)));
constexpr int AT_KROW = 144, AT_VROW = 192;
constexpr int AT_KTILE = 64 * AT_KROW, AT_VTILE = 64 * AT_VROW;
constexpr int AT_K0 = 0, AT_V0 = 2 * AT_KTILE, AT_MISC = AT_V0 + 2 * AT_VTILE;
constexpr float AT_C = 0.125f * 1.4426950408889634f;

__device__ __forceinline__ int crow16(int r, int hi) { return (r & 3) + 8 * (r >> 2) + 4 * hi; }
typedef float f32x2v_ __attribute__((ext_vector_type(2))); typedef __bf16 bf16x2v_ __attribute__((ext_vector_type(2)));
__device__ __forceinline__ unsigned cvtpk(float lo, float hi) { const f32x2v_ v = {lo, hi}; return __builtin_bit_cast(unsigned, __builtin_convertvector(v, bf16x2v_)); }
__device__ __forceinline__ float xhalf_max(float v) { auto rr = __builtin_amdgcn_permlane32_swap(__float_as_uint(v), __float_as_uint(v), false, false); return fmaxf(__uint_as_float(rr[0]), __uint_as_float(rr[1])); }
__device__ __forceinline__ float xhalf_sum(float v) { auto rr = __builtin_amdgcn_permlane32_swap(__float_as_uint(v), __float_as_uint(v), false, false); return __uint_as_float(rr[0]) + __uint_as_float(rr[1]); }

struct AttnSt { f32x16 o0, o1; float m, l; bool seen; };
__device__ __forceinline__ void attn_init(AttnSt& s) { s.o0 = (f32x16){}; s.o1 = (f32x16){}; s.m = 0.f; s.l = 0.f; s.seen = false; }
constexpr float AT_THR = 8.f;

__device__ __forceinline__ void attn_load_q(bf16x8v (&qf)[4], const bf16_t* qrow  , int hi) {
#pragma unroll
    for (int d0 = 0; d0 < 4; ++d0) { const u32x4v w = *(const u32x4v*)(qrow + 16 * d0 + 8 * hi); u32x4v o;
#pragma unroll
        for (int i = 0; i < 4; ++i) o[i] = cvtpk(__uint_as_float(w[i] << 16) * AT_C, __uint_as_float(w[i] & 0xffff0000u) * AT_C);
        qf[d0] = __builtin_bit_cast(bf16x8v, o); }
}

__device__ __forceinline__ void attn_tile(AttnSt& st, const bf16x8v (&qf)[4], const LAS unsigned char* Kt, const LAS unsigned char* Vt, int r32, int hi, int lane, bool rowsel, int mode, int kbase, int klo, int khi) {
    asm volatile("" : "+v"(r32), "+v"(hi), "+v"(lane));
    const float c0 = rowsel ? -st.m : -1e30f;
    f32x16 p0, p1;
#pragma unroll
    for (int r = 0; r < 16; ++r) { p0[r] = c0; p1[r] = c0; }
    const LAS unsigned char* kp = Kt + r32 * AT_KROW + hi * 16;
    bf16x8v kf[8];
#pragma unroll
    for (int d0 = 0; d0 < 4; ++d0) { kf[2 * d0] = *(const LAS bf16x8v*)(kp + d0 * 32); kf[2 * d0 + 1] = *(const LAS bf16x8v*)(kp + 32 * AT_KROW + d0 * 32); }
    __builtin_amdgcn_sched_barrier(0);
#pragma unroll
    for (int d0 = 0; d0 < 4; ++d0) {
        p0 = __builtin_amdgcn_mfma_f32_32x32x16_bf16(kf[2 * d0], qf[d0], p0, 0, 0, 0);
        p1 = __builtin_amdgcn_mfma_f32_32x32x16_bf16(kf[2 * d0 + 1], qf[d0], p1, 0, 0, 0);
    }
    const int li = lane & 15, g = lane >> 4;
    const LAS unsigned char* vp = Vt + (4 * (g >> 1) + (li >> 2)) * AT_VROW + (16 * (g & 1) + 4 * (li & 3)) * 2;
    s16x4v va[8], vb[8];
#pragma unroll
    for (int ks = 0; ks < 4; ++ks)
#pragma unroll
        for (int dh = 0; dh < 2; ++dh) {
            va[2 * ks + dh] = __builtin_bit_cast(s16x4v, __builtin_amdgcn_ds_read_tr16_b64_v4i16((LAS s16x4v*)(vp + (16 * ks) * AT_VROW + dh * 64)));
            vb[2 * ks + dh] = __builtin_bit_cast(s16x4v, __builtin_amdgcn_ds_read_tr16_b64_v4i16((LAS s16x4v*)(vp + (16 * ks + 8) * AT_VROW + dh * 64))); }
    __builtin_amdgcn_sched_barrier(0);
    if (mode != 0) {
        const int hi_c = khi - kbase - 4 * hi, lo_c = (mode == 2 ? klo - kbase : -1000000) - 4 * hi;
#pragma unroll
        for (int r = 0; r < 16; ++r) { const int cr = (r & 3) + 8 * (r >> 2);
            if (cr > hi_c || cr < lo_c) p0[r] = -INFINITY; if (cr + 32 > hi_c || cr + 32 < lo_c) p1[r] = -INFINITY; }
    }
    float mx = fmaxf(p0[0], p1[0]);
#pragma unroll
    for (int r = 1; r < 16; ++r) mx = fmaxf(mx, fmaxf(p0[r], p1[r]));
    mx = xhalf_max(mx);
    const bool valid = mx > -1e29f;
    const bool up = (mx > AT_THR) || (mx < -AT_THR && valid && !st.seen);
    st.seen = st.seen || valid;
    if (__builtin_expect(__any(up), 0)) {
        const float delta = up ? mx : 0.f; const float alpha = __builtin_amdgcn_exp2f(-delta);
#pragma unroll
        for (int r = 0; r < 16; ++r) { p0[r] -= delta; p1[r] -= delta; st.o0[r] *= alpha; st.o1[r] *= alpha; }
        st.l *= alpha; st.m += delta;
    }
    float ps = 0.f;
#pragma unroll
    for (int r = 0; r < 16; ++r) { p0[r] = __builtin_amdgcn_exp2f(p0[r]); p1[r] = __builtin_amdgcn_exp2f(p1[r]); ps += p0[r] + p1[r]; }
    st.l += ps;
    bf16x8v pf[4];
    { u32x4v w;
      w = (u32x4v){cvtpk(p0[0], p0[1]), cvtpk(p0[2], p0[3]), cvtpk(p0[4], p0[5]), cvtpk(p0[6], p0[7])}; pf[0] = __builtin_bit_cast(bf16x8v, w);
      w = (u32x4v){cvtpk(p0[8], p0[9]), cvtpk(p0[10], p0[11]), cvtpk(p0[12], p0[13]), cvtpk(p0[14], p0[15])}; pf[1] = __builtin_bit_cast(bf16x8v, w);
      w = (u32x4v){cvtpk(p1[0], p1[1]), cvtpk(p1[2], p1[3]), cvtpk(p1[4], p1[5]), cvtpk(p1[6], p1[7])}; pf[2] = __builtin_bit_cast(bf16x8v, w);
      w = (u32x4v){cvtpk(p1[8], p1[9]), cvtpk(p1[10], p1[11]), cvtpk(p1[12], p1[13]), cvtpk(p1[14], p1[15])}; pf[3] = __builtin_bit_cast(bf16x8v, w); }
#pragma unroll
    for (int ks = 0; ks < 4; ++ks) {
        const bf16x8v v0 = (bf16x8v){va[2 * ks][0], va[2 * ks][1], va[2 * ks][2], va[2 * ks][3], vb[2 * ks][0], vb[2 * ks][1], vb[2 * ks][2], vb[2 * ks][3]};
        const bf16x8v v1 = (bf16x8v){va[2 * ks + 1][0], va[2 * ks + 1][1], va[2 * ks + 1][2], va[2 * ks + 1][3], vb[2 * ks + 1][0], vb[2 * ks + 1][1], vb[2 * ks + 1][2], vb[2 * ks + 1][3]};
        st.o0 = __builtin_amdgcn_mfma_f32_32x32x16_bf16(v0, pf[ks], st.o0, 0, 0, 0);
        st.o1 = __builtin_amdgcn_mfma_f32_32x32x16_bf16(v1, pf[ks], st.o1, 0, 0, 0);
    }
}

struct KVRegs { u32x4v k, v; };
__device__ __forceinline__ void kv_load(KVRegs& r, const bf16_t* Kg, const bf16_t* Vg, size_t pitch, int tid) {
    const size_t off = (size_t)(tid >> 3) * pitch + (tid & 7) * 8;
    r.k = *(const u32x4v*)(Kg + off); r.v = *(const u32x4v*)(Vg + off);
}
__device__ __forceinline__ void kv_store(const KVRegs& r, LAS unsigned char* Kt, LAS unsigned char* Vt, int tid) {
    *(LAS u32x4v*)(Kt + (tid >> 3) * AT_KROW + (tid & 7) * 16) = r.k;
    *(LAS u32x4v*)(Vt + (tid >> 3) * AT_VROW + (tid & 7) * 16) = r.v;
}

__device__ __forceinline__ void attn_store_headnorm(const f32x16& o0, const f32x16& o1, bf16_t* Yrow  , const float* g  , int hi) {
    float ss = 0.f;
#pragma unroll
    for (int r = 0; r < 16; ++r) ss += o0[r] * o0[r] + o1[r] * o1[r];
    ss = xhalf_sum(ss);
    const float rn = rsqrtf(ss * (1.f / 64.f) + EPS);
#pragma unroll
    for (int dh = 0; dh < 2; ++dh)
#pragma unroll
        for (int q4 = 0; q4 < 4; ++q4) { const int d = 32 * dh + 8 * q4 + 4 * hi; const float4 gg = *(const float4*)(g + d);
            const f32x16& o = dh ? o1 : o0;
            uint2 w; w.x = cvtpk(o[4 * q4] * rn * gg.x, o[4 * q4 + 1] * rn * gg.y); w.y = cvtpk(o[4 * q4 + 2] * rn * gg.z, o[4 * q4 + 3] * rn * gg.w);
            *(uint2*)(Yrow + d) = w; }
}

__device__ __forceinline__ void ph_kmean(const Ctx& c_) {
    Ctx c = c_; c.lane = (int)__builtin_amdgcn_mbcnt_hi(~0u, __builtin_amdgcn_mbcnt_lo(~0u, 0u)); asm volatile("" : "+v"(c.lane)); c.tid = c.wave * 64 + c.lane; asm volatile("" : "+s"(c.bid)); asm volatile("" : "+s"(c.ws));
    const bf16_t* Z = (const bf16_t*)(c.ws + WS_Z); float* kmean = (float*)(c.ws + WS_KMEAN); LAS float* red = (LAS float*)((LAS unsigned char*)c.lds);
    for (int it = c.bid; it < 512; it += c.nb) {
        const int bh = it >> 3, n = it & 7, b = bh >> 2, h = bh & 3;
        const bf16_t* p = Z + ((size_t)b * SEQ + n * 256 + c.wave * 32) * DINP + ZC_MK + h * 64 + c.lane; float s = 0.f;
#pragma unroll 8
        for (int i = 0; i < 32; ++i) s += bf2f(p[(size_t)i * DINP]);
        red[c.tid] = s;
        __syncthreads();
        if (c.wave == 0) { float t = 0.f;
#pragma unroll
            for (int k = 0; k < 8; ++k) t += red[k * 64 + c.lane];
            kmean[(size_t)it * 64 + c.lane] = t * (1.f / 256.f); }
        __syncthreads();
    }
}

__device__ __forceinline__ void moba_unit(const Ctx& c, int L, int b, int h, int qb) {
    const bf16_t* Z = (const bf16_t*)(c.ws + WS_Z); bf16_t* Y = (bf16_t*)(c.ws + WS_Y);
    LAS unsigned char* lds = (LAS unsigned char*)c.lds;
    int lane = c.lane; asm volatile("" : "+v"(lane));
    const int wave = c.wave, tid = wave * 64 + lane, r32 = lane & 31, hi = lane >> 5;
    LAS float* km = (LAS float*)(lds + AT_MISC);
    { const float* kmg = (const float*)(c.ws + WS_KMEAN) + (size_t)(b * 4 + h) * 512; km[tid] = kmg[tid]; }
    const size_t rowq = (size_t)b * SEQ + 256 * qb + 32 * wave + r32;
    bf16x8v qf[4];
#pragma unroll
    for (int d0 = 0; d0 < 4; ++d0) qf[d0] = *(const bf16x8v*)(Z + rowq * DINP + ZC_MQ + h * 64 + 16 * d0 + 8 * hi);
    const bf16_t* Kg = Z + (size_t)b * SEQ * DINP + ZC_MK + h * 64; const bf16_t* Vg = Z + (size_t)b * SEQ * DINP + ZC_MV + h * 64;
    const int NT = 4 * (qb + 1);
    KVRegs ka, kb; kv_load(ka, Kg, Vg, DINP, tid); kv_load(kb, Kg + (size_t)64 * DINP, Vg + (size_t)64 * DINP, DINP, tid);
    __syncthreads();
    unsigned selbits;
    if (qb <= 3) selbits = (1u << qb) - 1u;
    else {
        float gt[7];
#pragma unroll
        for (int n = 0; n < 7; ++n) { float a = 0.f;
            if (n < qb) {
#pragma unroll
                for (int d0 = 0; d0 < 4; ++d0)
#pragma unroll
                    for (int j = 0; j < 8; ++j) a += bf2f((bf16_t)qf[d0][j]) * km[n * 64 + 16 * d0 + 8 * hi + j];
            }
            gt[n] = xhalf_sum(a); }
        selbits = 0u;
#pragma unroll
        for (int k = 0; k < 3; ++k) { int best = -1; float bv = -INFINITY;
#pragma unroll
            for (int n = 0; n < 7; ++n) if (n < qb && !((selbits >> n) & 1u) && gt[n] > bv) { bv = gt[n]; best = n; }
            if (best < 0) {
#pragma unroll
                for (int n = 6; n >= 0; --n) if (n < qb && !((selbits >> n) & 1u)) best = n; }
            selbits |= 1u << best; }
    }
    attn_load_q(qf, Z + rowq * DINP + ZC_MQ + h * 64, hi);
    kv_store(ka, lds + AT_K0, lds + AT_V0, tid);
    __syncthreads();
    AttnSt st; attn_init(st);
    const int qrel = 32 * wave + r32;
#define MOBA_TILE(ti, buf) do { const LAS unsigned char* Kt = lds + AT_K0 + (buf) * AT_KTILE; const LAS unsigned char* Vt = lds + AT_V0 + (buf) * AT_VTILE; const int j = (ti) >> 2, k0 = ((ti) & 3) * 64; \
        const bool own = j >= qb;                                         \
        if (!own || k0 <= 32 * wave + 31) attn_tile(st, qf, Kt, Vt, r32, hi, lane, own ? true : (((selbits >> j) & 1u) != 0u), (own && k0 + 63 > 32 * wave) ? 1 : 0, k0, 0, qrel); } while (0)
    for (int ti = 0; ti < NT; ti += 2) {
        if (ti + 2 < NT) kv_load(ka, Kg + (size_t)(ti + 2) * 64 * DINP, Vg + (size_t)(ti + 2) * 64 * DINP, DINP, tid);
        MOBA_TILE(ti, 0);
        kv_store(kb, lds + AT_K0 + AT_KTILE, lds + AT_V0 + AT_VTILE, tid);
        __syncthreads();
        if (ti + 3 < NT) kv_load(kb, Kg + (size_t)(ti + 3) * 64 * DINP, Vg + (size_t)(ti + 3) * 64 * DINP, DINP, tid);
        MOBA_TILE(ti + 1, 1);
        if (ti + 2 < NT) kv_store(ka, lds + AT_K0, lds + AT_V0, tid);
        __syncthreads();
    }
#undef MOBA_TILE
    const float lt = xhalf_sum(st.l); const float inv = 1.f / lt;
#pragma unroll
    for (int r = 0; r < 16; ++r) { st.o0[r] *= inv; st.o1[r] *= inv; }
    attn_store_headnorm(st.o0, st.o1, Y + rowq * DM + h * 64, c.head_g + (size_t)L * DM + h * 64, hi);
}
__device__ __forceinline__ void ph_moba(const Ctx& c_, int L) {
    Ctx c = c_; c.lane = (int)__builtin_amdgcn_mbcnt_hi(~0u, __builtin_amdgcn_mbcnt_lo(~0u, 0u)); asm volatile("" : "+v"(c.lane)); c.tid = c.wave * 64 + c.lane; asm volatile("" : "+s"(c.bid)); asm volatile("" : "+s"(c.ws));
    for (int pi = c.bid; pi < 256; pi += c.nb) {
        const int bh = pi >> 2, s = pi & 3;
        moba_unit(c, L, bh >> 2, bh & 3, s);
        moba_unit(c, L, bh >> 2, bh & 3, 7 - s);
    }
}

constexpr size_t WS_KCB = 29 * MiB + 512 * 1024, WS_VCB = 29 * MiB + 768 * 1024;

__device__ __forceinline__ void ph_wconv_cmp(const Ctx& c_, int L) {
    Ctx c = c_; c.lane = (int)__builtin_amdgcn_mbcnt_hi(~0u, __builtin_amdgcn_mbcnt_lo(~0u, 0u)); asm volatile("" : "+v"(c.lane)); c.tid = c.wave * 64 + c.lane; asm volatile("" : "+s"(c.bid)); asm volatile("" : "+s"(c.ws));
    const int half = c.tid >> 8, t256 = c.tid & 255; float* tile = (float*)(c.lds) + half * (64 * 65);
    constexpr int T_1 = (2048 / 64) * (256 / 64), T_2 = (256 / 64) * 1, TOT = 2 * (T_1 + T_2);
    for (int base = c.bid * 2; base < TOT; base += c.nb * 2) {
        int it = base + half; const bool act = it < TOT; if (!act) it = 0;
        const int kv = it / (T_1 + T_2); it -= kv * (T_1 + T_2);
        const float* src; bf16_t* dst; int K, N;
        if (it < T_1) { src = c.cmp_w1 + ((size_t)L * 2 + kv) * 2048 * 256; dst = (bf16_t*)(c.ws + WS_CW1) + (size_t)kv * 256 * 2048; K = 2048; N = 256; }
        else { it -= T_1; src = c.cmp_w2 + ((size_t)L * 2 + kv) * 256 * 64; dst = (bf16_t*)(c.ws + WS_CW2) + (size_t)kv * 64 * 256; K = 256; N = 64; }
        wconv_tile(src, dst, K, N, N, it, t256, tile, act);
    }
}

__device__ __forceinline__ void ph_cpe_all(const Ctx& c_) {
    Ctx c = c_; c.lane = (int)__builtin_amdgcn_mbcnt_hi(~0u, __builtin_amdgcn_mbcnt_lo(~0u, 0u)); asm volatile("" : "+v"(c.lane)); c.tid = c.wave * 64 + c.lane; asm volatile("" : "+s"(c.bid)); asm volatile("" : "+s"(c.ws));
    float* red = (float*)(c.lds + 40960);
    for (int item = c.bid; item < DEPTH * 2 * 16; item += c.nb) {
        const int lk = item >> 4, j0 = (item & 15) * 16, jj = c.tid & 15, ig = c.tid >> 4;
        const float* pe = c.cmp_pe + (size_t)lk * 2048; const float* w = c.cmp_w1 + (size_t)lk * 2048 * 256 + j0 + jj;
        float a = 0.f;
#pragma unroll 8
        for (int i = ig; i < 2048; i += 32) a += pe[i] * w[(size_t)i * 256];
        red[c.tid] = a;
        __syncthreads();
        if (c.tid < 16) { float s = 0.f; for (int k = 0; k < 32; ++k) s += red[k * 16 + c.tid]; ((float*)(c.ws + WS_CPE))[lk * 256 + j0 + c.tid] = s; }
        __syncthreads();
    }
}

typedef float f32x4v __attribute__((ext_vector_type(4)));
__device__ __forceinline__ int cmp_a_off(int tok, int chunk) { return ((tok ^ ((tok >> 7) & 1)) << 7) + (((chunk ^ (tok >> 4)) & 7) << 4); }
__device__ __forceinline__ void ph_cmp(const Ctx& c_, int L) {
    Ctx c = c_; c.lane = (int)__builtin_amdgcn_mbcnt_hi(~0u, __builtin_amdgcn_mbcnt_lo(~0u, 0u)); asm volatile("" : "+v"(c.lane)); c.tid = c.wave * 64 + c.lane; asm volatile("" : "+s"(c.bid)); asm volatile("" : "+s"(c.ws));
    const bf16_t* Z = (const bf16_t*)(c.ws + WS_Z); const bf16_t* W1t = (const bf16_t*)(c.ws + WS_CW1); const bf16_t* W2t = (const bf16_t*)(c.ws + WS_CW2); const float* cpe = (const float*)(c.ws + WS_CPE);
    LAS unsigned char* lds = (LAS unsigned char*)c.lds;
    const int w = c.wave;
    constexpr int HROW = 528, HOFF = 272 * 128;
    for (int item = c.bid; item < 256; item += c.nb) {
        int lane = c.lane; asm volatile("" : "+v"(lane)); const int tid = w * 64 + lane, r16 = lane & 15, kq = lane >> 4;
        const int b = item >> 4, kv = (item >> 3) & 1, g = item & 7; const int col = kv ? ZC_VC : ZC_KC;
        { u32x4v st[5];
#pragma unroll
          for (int q = 0; q < 5; ++q) { const int i = tid + 512 * q; if (i < 272 * 8) { const int tok = i >> 3, ch = i & 7; int tg = 256 * g + tok; tg = tg < SEQ ? tg : SEQ - 1;
              st[q] = *(const u32x4v*)(Z + ((size_t)b * SEQ + tg) * DINP + col + 8 * ch); } }
#pragma unroll
          for (int q = 0; q < 5; ++q) { const int i = tid + 512 * q; if (i < 272 * 8) *(LAS u32x4v*)(lds + cmp_a_off(i >> 3, i & 7)) = st[q]; } }
        const bf16_t* brow = W1t + ((size_t)kv * 256 + 32 * w + r16) * 2048 + 8 * kq;
        f32x4v acc0 = (f32x4v){0.f, 0.f, 0.f, 0.f}, acc1 = acc0;
        bf16x8v w2f[8];
        if (w < 4) { const bf16_t* b2 = W2t + ((size_t)kv * 64 + 16 * w + r16) * 256 + 8 * kq;
#pragma unroll
            for (int ks = 0; ks < 8; ++ks) w2f[ks] = *(const bf16x8v*)(b2 + 32 * ks); }
        __syncthreads();
#pragma unroll 1
        for (int kb = 0; kb < 64; kb += 16) {
            bf16x8v b0[16], b1[16];
#pragma unroll
            for (int i = 0; i < 16; ++i) { const int ks = kb + i; b0[i] = *(const bf16x8v*)(brow + 32 * ks); b1[i] = *(const bf16x8v*)(brow + 16 * 2048 + 32 * ks); }
#pragma unroll
            for (int i = 0; i < 16; ++i) { const int ks = kb + i; const bf16x8v af = *(const LAS bf16x8v*)(lds + cmp_a_off(16 * r16 + (ks >> 1), 4 * (ks & 1) + kq));
                acc0 = __builtin_amdgcn_mfma_f32_16x16x32_bf16(af, b0[i], acc0, 0, 0, 0); acc1 = __builtin_amdgcn_mfma_f32_16x16x32_bf16(af, b1[i], acc1, 0, 0, 0); }
        }
        { const float bias0 = cpe[(L * 2 + kv) * 256 + 32 * w + r16], bias1 = cpe[(L * 2 + kv) * 256 + 32 * w + 16 + r16];
#pragma unroll
          for (int i = 0; i < 4; ++i) { *(LAS bf16_t*)(lds + HOFF + (4 * kq + i) * HROW + (32 * w + r16) * 2) = f2bf(gelu_tanh(acc0[i] + bias0));
              *(LAS bf16_t*)(lds + HOFF + (4 * kq + i) * HROW + (32 * w + 16 + r16) * 2) = f2bf(gelu_tanh(acc1[i] + bias1)); } }
        __syncthreads();
        if (w < 4) {
            f32x4v o = (f32x4v){0.f, 0.f, 0.f, 0.f};
#pragma unroll
            for (int ks = 0; ks < 8; ++ks) o = __builtin_amdgcn_mfma_f32_16x16x32_bf16(*(const LAS bf16x8v*)(lds + HOFF + r16 * HROW + (32 * ks + 8 * kq) * 2), w2f[ks], o, 0, 0, 0);
            bf16_t* dst = (bf16_t*)(c.ws + (kv ? WS_VCB : WS_KCB)) + ((size_t)b * 128 + 16 * g + 4 * kq) * 64 + 16 * w + r16;
#pragma unroll
            for (int i = 0; i < 4; ++i) dst[i * 64] = (16 * g + 4 * kq + i < 127) ? f2bf(o[i]) : (bf16_t)0;
        }
        __syncthreads();
    }
}

constexpr int NS_A = AT_MISC, NS_B = NS_A + 4 * 64 * 33 * 4, NS_SEL = NS_B + 4 * 64 * 33 * 4;
static_assert(NS_SEL + 256 <= 131072, "NSA LDS map");

__device__ __forceinline__ void nsa_unit(const Ctx& c, int L, int b, int ch) {
    const bf16_t* Z = (const bf16_t*)(c.ws + WS_Z); bf16_t* Y = (bf16_t*)(c.ws + WS_Y);
    LAS unsigned char* lds = (LAS unsigned char*)c.lds;
    int lane = c.lane; asm volatile("" : "+v"(lane));
    const int wave = c.wave, tid = wave * 64 + lane, r32 = lane & 31, hi = lane >> 5, head = wave >> 1, tq = 32 * (wave & 1) + r32, t = 64 * ch + tq;
    const size_t rowq = (size_t)b * SEQ + t;
    bf16x8v qf[4]; attn_load_q(qf, Z + rowq * DINP + ZC_NQ + head * 64, hi);
    const float g0 = sigmoidf_(bf2f(Z[rowq * DINP + ZC_NG + head * 3 + 0])), g1 = sigmoidf_(bf2f(Z[rowq * DINP + ZC_NG + head * 3 + 1])), g2 = sigmoidf_(bf2f(Z[rowq * DINP + ZC_NG + head * 3 + 2]));
    const bool two = ch >= 16;
    { const bf16_t* KC = (const bf16_t*)(c.ws + WS_KCB) + (size_t)b * 128 * 64; const bf16_t* VC = (const bf16_t*)(c.ws + WS_VCB) + (size_t)b * 128 * 64;
      KVRegs kv; kv_load(kv, KC, VC, 64, tid); kv_store(kv, lds + AT_K0, lds + AT_V0, tid);
      if (two) { kv_load(kv, KC + 64 * 64, VC + 64 * 64, 64, tid); kv_store(kv, lds + AT_K0 + AT_KTILE, lds + AT_V0 + AT_VTILE, tid); } }
    __syncthreads();
    f32x16 acc0, acc1;
    {
        const int nvis = t >= 31 ? (t - 31) / 16 + 1 : 0;
        f32x16 p[4];
#pragma unroll
        for (int i = 0; i < 4; ++i) p[i] = (f32x16){};
        { const LAS unsigned char* kp = lds + AT_K0 + r32 * AT_KROW + hi * 16;
#pragma unroll
          for (int d0 = 0; d0 < 4; ++d0) {
              p[0] = __builtin_amdgcn_mfma_f32_32x32x16_bf16(*(const LAS bf16x8v*)(kp + d0 * 32), qf[d0], p[0], 0, 0, 0);
              p[1] = __builtin_amdgcn_mfma_f32_32x32x16_bf16(*(const LAS bf16x8v*)(kp + 32 * AT_KROW + d0 * 32), qf[d0], p[1], 0, 0, 0); }
          if (two) {
#pragma unroll
              for (int d0 = 0; d0 < 4; ++d0) {
                  p[2] = __builtin_amdgcn_mfma_f32_32x32x16_bf16(*(const LAS bf16x8v*)(kp + AT_KTILE + d0 * 32), qf[d0], p[2], 0, 0, 0);
                  p[3] = __builtin_amdgcn_mfma_f32_32x32x16_bf16(*(const LAS bf16x8v*)(kp + AT_KTILE + 32 * AT_KROW + d0 * 32), qf[d0], p[3], 0, 0, 0); } } }
        float mx = -INFINITY; const int nlim = nvis - 4 * hi;
#pragma unroll
        for (int i = 0; i < 4; ++i)
#pragma unroll
            for (int r = 0; r < 16; ++r) { if (32 * i + (r & 3) + 8 * (r >> 2) >= nlim || (i >= 2 && !two)) p[i][r] = -INFINITY; mx = fmaxf(mx, p[i][r]); }
        mx = xhalf_max(mx);
        const float msub = nvis > 0 ? mx : 0.f; float ps = 0.f;
#pragma unroll
        for (int i = 0; i < 4; ++i)
#pragma unroll
            for (int r = 0; r < 16; ++r) { p[i][r] = __builtin_amdgcn_exp2f(p[i][r] - msub); ps += p[i][r]; }
        ps = xhalf_sum(ps);
        const float inv = nvis > 0 ? 1.f / ps : 0.f;
        LAS float* Ab = (LAS float*)(lds + NS_A) + (head * 64 + tq) * 33; LAS float* Bb = (LAS float*)(lds + NS_B) + (head * 64 + tq) * 33;
#pragma unroll
        for (int i = 0; i < 4; ++i) {
#pragma unroll
            for (int r = 0; r < 16; ++r) p[i][r] *= inv;
#pragma unroll
            for (int g = 0; g < 4; ++g) { const int j = 8 * i + 2 * g + hi; const float hb = 0.5f * p[i][4 * g + 3];
                Ab[j] = p[i][4 * g] + p[i][4 * g + 1] + p[i][4 * g + 2] + hb; Bb[j] = hb; }
        }
        acc0 = (f32x16){}; acc1 = (f32x16){};
        const int li = lane & 15, g16 = lane >> 4;
        const LAS unsigned char* vp = lds + AT_V0 + (4 * (g16 >> 1) + (li >> 2)) * AT_VROW + (16 * (g16 & 1) + 4 * (li & 3)) * 2;
#pragma unroll
        for (int i = 0; i < 4; ++i) {
            if (i >= 2 && !two) break;
#pragma unroll
            for (int s = 0; s < 2; ++s) {
                const u32x4v wv = (u32x4v){cvtpk(p[i][8 * s], p[i][8 * s + 1]), cvtpk(p[i][8 * s + 2], p[i][8 * s + 3]), cvtpk(p[i][8 * s + 4], p[i][8 * s + 5]), cvtpk(p[i][8 * s + 6], p[i][8 * s + 7])};
                const bf16x8v pf = __builtin_bit_cast(bf16x8v, wv);
                const LAS unsigned char* vq = vp + (i >> 1) * AT_VTILE + (32 * (i & 1) + 16 * s) * AT_VROW;
#pragma unroll
                for (int dh = 0; dh < 2; ++dh) {
                    const s16x4v a = __builtin_bit_cast(s16x4v, __builtin_amdgcn_ds_read_tr16_b64_v4i16((LAS s16x4v*)(vq + dh * 64)));
                    const s16x4v bq = __builtin_bit_cast(s16x4v, __builtin_amdgcn_ds_read_tr16_b64_v4i16((LAS s16x4v*)(vq + 8 * AT_VROW + dh * 64)));
                    const bf16x8v vf = (bf16x8v){a[0], a[1], a[2], a[3], bq[0], bq[1], bq[2], bq[3]};
                    if (dh == 0) acc0 = __builtin_amdgcn_mfma_f32_32x32x16_bf16(vf, pf, acc0, 0, 0, 0);
                    else         acc1 = __builtin_amdgcn_mfma_f32_32x32x16_bf16(vf, pf, acc1, 0, 0, 0);
                }
            }
        }
#pragma unroll
        for (int r = 0; r < 16; ++r) { acc0[r] *= g0; acc1[r] *= g0; }
    }
    __syncthreads();
    if (tid < 64) {
        unsigned mask;
        if (ch <= 7) mask = (2u << ch) - 1u;
        else {
            LAS float* A0 = (LAS float*)(lds + NS_A) + tid * 33;
            for (int j = 1; j <= ch - 2; ++j) { float s = 0.f;
#pragma unroll
                for (int h = 0; h < 4; ++h) s += ((LAS float*)(lds + NS_A))[(h * 64 + tid) * 33 + j] + ((LAS float*)(lds + NS_B))[(h * 64 + tid) * 33 + j - 1];
                A0[j] = s; }
            mask = 1u | (1u << ch) | (1u << (ch - 1));
            for (int k = 0; k < 5; ++k) { int best = -1; float bv = -INFINITY;
                for (int j = 1; j <= ch - 2; ++j) { const float v = A0[j]; if (!((mask >> j) & 1u) && v > bv) { bv = v; best = j; } }
                if (best < 0) { for (int j = ch - 2; j >= 1; --j) if (!((mask >> j) & 1u)) best = j; }
                mask |= 1u << best; }
        }
        ((LAS unsigned*)(lds + NS_SEL))[tid] = mask;
    }
    __syncthreads();
    const unsigned selbits = ((LAS unsigned*)(lds + NS_SEL))[tq];
    const int wl = ch >= 8 ? ch - 8 : 0, nsel = ch + 1, ntot = nsel + (ch - wl + 1);
    const bf16_t* Zb = Z + (size_t)b * SEQ * DINP;
#define NSA_SRC(s_, Kp, Vp) do { const int s1_ = (s_); const bool w1_ = s1_ >= nsel; const int j1_ = w1_ ? wl + (s1_ - nsel) : s1_; \
        Kp = Zb + (size_t)j1_ * 64 * DINP + (w1_ ? ZC_KWN : ZC_KSL); Vp = Zb + (size_t)j1_ * 64 * DINP + (w1_ ? ZC_VWN : ZC_VSL); } while (0)
    KVRegs ka, kb; const bf16_t* Kp; const bf16_t* Vp;
    NSA_SRC(0, Kp, Vp); kv_load(ka, Kp, Vp, DINP, tid); NSA_SRC(1, Kp, Vp); kv_load(kb, Kp, Vp, DINP, tid);
    kv_store(ka, lds + AT_K0, lds + AT_V0, tid);
    __syncthreads();
    AttnSt st; attn_init(st);
#define NSA_TILE(s_, buf) do { const int s = (s_); const LAS unsigned char* Kt = lds + AT_K0 + (buf) * AT_KTILE; const LAS unsigned char* Vt = lds + AT_V0 + (buf) * AT_VTILE; \
        if (s == nsel) {   \
            const float inv = g1 / xhalf_sum(st.l); _Pragma("unroll") for (int r = 0; r < 16; ++r) { acc0[r] += st.o0[r] * inv; acc1[r] += st.o1[r] * inv; } attn_init(st); } \
        { const bool win = s >= nsel; const int j = win ? wl + (s - nsel) : s; const bool far = win && ch >= 8 && j == ch - 8; \
          attn_tile(st, qf, Kt, Vt, r32, hi, lane, (win || j == ch) ? true : (((selbits >> j) & 1u) != 0u), j == ch ? 1 : (far ? 2 : 0), 64 * j, t - 511, t); } } while (0)
    for (int s0 = 0; s0 < ntot; s0 += 2) {
        if (s0 + 2 < ntot) { NSA_SRC(s0 + 2, Kp, Vp); kv_load(ka, Kp, Vp, DINP, tid); }
        NSA_TILE(s0, 0);
        if (s0 + 1 < ntot) kv_store(kb, lds + AT_K0 + AT_KTILE, lds + AT_V0 + AT_VTILE, tid);
        __syncthreads();
        if (s0 + 1 >= ntot) break;
        if (s0 + 3 < ntot) { NSA_SRC(s0 + 3, Kp, Vp); kv_load(kb, Kp, Vp, DINP, tid); }
        NSA_TILE(s0 + 1, 1);
        if (s0 + 2 < ntot) kv_store(ka, lds + AT_K0, lds + AT_V0, tid);
        __syncthreads();
    }
#undef NSA_TILE
#undef NSA_SRC
    { const float inv = g2 / xhalf_sum(st.l);
#pragma unroll
      for (int r = 0; r < 16; ++r) { acc0[r] += st.o0[r] * inv; acc1[r] += st.o1[r] * inv; } }
    attn_store_headnorm(acc0, acc1, Y + rowq * DM + 768 + head * 64, c.head_g + (size_t)L * DM + 768 + head * 64, hi);
}
__device__ __forceinline__ void ph_nsa(const Ctx& c_, int L) {
    Ctx c = c_; c.lane = (int)__builtin_amdgcn_mbcnt_hi(~0u, __builtin_amdgcn_mbcnt_lo(~0u, 0u)); asm volatile("" : "+v"(c.lane)); c.tid = c.wave * 64 + c.lane; asm volatile("" : "+s"(c.bid)); asm volatile("" : "+s"(c.ws));
    for (int pi = c.bid; pi < 256; pi += c.nb) {
        const int b = pi >> 4, s = pi & 15;
        nsa_unit(c, L, b, 31 - s);
        nsa_unit(c, L, b, s);
    }
}

constexpr size_t WS_SCAL = 29 * MiB;
constexpr size_t WS_NCH = 31 * MiB, WS_NPREV = 31 * MiB + 512 * 1024;
constexpr int ML_KROW = 192;
constexpr int ML_VROW = 320;
constexpr int ML_K = 0, ML_V = 64 * 192, ML_E = ML_V + 64 * ML_VROW, ML_MISC = ML_E + 1024;

struct MlcIn { u32x4v xq[4], xk[4], v0, v1; float li, lf; };
__device__ __forceinline__ void ml_chunk_load(MlcIn& R, const Ctx& c, int item, int tid, int lane, int wave) {
    const bf16_t* Z = (const bf16_t*)(c.ws + WS_Z);
    const int bh = item >> 5, ch = item & 31, b = bh >> 2, h = bh & 3; const size_t row0 = (size_t)b * SEQ + 64 * ch;
    const int s = tid >> 3, c8 = 8 * (tid & 7), t = 64 * ch + s;
#pragma unroll
    for (int j = 0; j < 4; ++j) {
        if (t - 3 + j >= 0) { const bf16_t* zr = Z + (row0 + s - 3 + j) * DINP; R.xq[j] = *(const u32x4v*)(zr + ZC_LQ + 64 * h + c8); R.xk[j] = *(const u32x4v*)(zr + ZC_LK + 64 * h + c8); }
        else { R.xq[j] = (u32x4v){0u, 0u, 0u, 0u}; R.xk[j] = (u32x4v){0u, 0u, 0u, 0u}; } }
    { const bf16_t* zr = Z + (row0 + s) * DINP + ZC_LV + 128 * h + 16 * (tid & 7); R.v0 = *(const u32x4v*)zr; R.v1 = *(const u32x4v*)(zr + 8); }
    if (wave == 0) { const size_t m = row0 + lane; R.li = bf2f(Z[m * DINP + ZC_LI + h]); R.lf = bf2f(Z[m * DINP + ZC_LF + h]); }
}
__device__ __forceinline__ void ph_ml_chunk(const Ctx& c_, int L) {
    Ctx c = c_; c.lane = (int)__builtin_amdgcn_mbcnt_hi(~0u, __builtin_amdgcn_mbcnt_lo(~0u, 0u)); asm volatile("" : "+v"(c.lane)); c.tid = c.wave * 64 + c.lane; asm volatile("" : "+s"(c.bid)); asm volatile("" : "+s"(c.ws));
    bf16_t* QKC = (bf16_t*)(c.ws + WS_QKC); float* gates = (float*)(c.ws + WS_GATES);
    float* scal = (float*)(c.ws + WS_SCAL); float* nch = (float*)(c.ws + WS_NCH); bf16_t* CC = (bf16_t*)(c.ws + WS_CC);
    const float* cw = c.conv_w + (size_t)L * 4 * 512; const float* cb = c.conv_b + (size_t)L * 512; const float* gb = c.gate_b + (size_t)L * 8;
    LAS unsigned char* lds = (LAS unsigned char*)c.lds;
    LAS float* wl = (LAS float*)(lds + ML_MISC);
    const int wave = c.wave;
    MlcIn R; int hcur = -1;
    if (c.bid < 2048) ml_chunk_load(R, c, c.bid, c.tid, c.lane, wave);
    for (int item = c.bid; item < 2048; item += c.nb) {
        int lane = c.lane; asm volatile("" : "+v"(lane)); const int tid = wave * 64 + lane, r32 = lane & 31, hi = lane >> 5;
        const int bh = item >> 5, ch = item & 31, b = bh >> 2, h = bh & 3;
        const size_t row0 = (size_t)b * SEQ + 64 * ch;
        if (h != hcur) {
            __syncthreads();
            for (int i = tid; i < 640; i += 512) { float w; if (i < 512) { const int j = i >> 7, cc = i & 127; w = cw[j * 512 + (cc < 64 ? 64 * h + cc : 256 + 64 * h + cc - 64)]; } else { const int cc = i - 512; w = cb[cc < 64 ? 64 * h + cc : 256 + 64 * h + cc - 64]; } wl[i] = w; }
            hcur = h;
            __syncthreads();
        }
        u32x4v cv0, cv1;
        { const int s = tid >> 3, c8 = 8 * (tid & 7);
          float aq[8], ak[8];
#pragma unroll
          for (int i = 0; i < 8; ++i) { aq[i] = wl[512 + c8 + i]; ak[i] = wl[512 + 64 + c8 + i]; }
#pragma unroll
          for (int j = 0; j < 4; ++j) {
#pragma unroll
              for (int i = 0; i < 4; ++i) {
                  aq[2 * i] += __uint_as_float(R.xq[j][i] << 16) * wl[j * 128 + c8 + 2 * i]; aq[2 * i + 1] += __uint_as_float(R.xq[j][i] & 0xffff0000u) * wl[j * 128 + c8 + 2 * i + 1];
                  ak[2 * i] += __uint_as_float(R.xk[j][i] << 16) * wl[j * 128 + 64 + c8 + 2 * i]; ak[2 * i + 1] += __uint_as_float(R.xk[j][i] & 0xffff0000u) * wl[j * 128 + 64 + c8 + 2 * i + 1]; } }
          u32x4v oq, ok;
#pragma unroll
          for (int i = 0; i < 4; ++i) { const float q0 = aq[2 * i] * sigmoidf_(aq[2 * i]), q1 = aq[2 * i + 1] * sigmoidf_(aq[2 * i + 1]);
              const float k0 = 0.125f * ak[2 * i] * sigmoidf_(ak[2 * i]), k1 = 0.125f * ak[2 * i + 1] * sigmoidf_(ak[2 * i + 1]);
              oq[i] = cvtpk(q0, q1); ok[i] = cvtpk(k0, k1); }
          *(u32x4v*)(QKC + (row0 + s) * 512 + 64 * h + c8) = oq; *(u32x4v*)(QKC + (row0 + s) * 512 + 256 + 64 * h + c8) = ok;
          *(LAS u32x4v*)(lds + ML_K + s * ML_KROW + c8 * 2) = ok; cv0 = R.v0; cv1 = R.v1; }
        if (wave == 0) { const size_t m = row0 + lane;
            const float ig = R.li + gb[h]; const float x = R.lf + gb[4 + h];
            float cs = fminf(x, 0.f) - log1pf(__expf(-fabsf(x)));
#pragma unroll
            for (int o = 1; o < 64; o <<= 1) { const float up = lane_get(cs, lane - o); if (lane >= o) cs += up; }
            const float bend = __int_as_float(__builtin_amdgcn_readlane(__float_as_int(cs), 63)); const float wend = bend - cs + ig; float aend = wend;
#pragma unroll
            for (int o = 1; o < 64; o <<= 1) aend = fmaxf(aend, lane_get(aend, lane ^ o));
            ((LAS float*)(lds + ML_E))[lane] = __expf(wend - aend);
            gates[m * 8 + h] = ig; gates[m * 8 + 4 + h] = cs;
            if (lane == 0) { scal[item] = bend; scal[2048 + item] = aend; } }
        if (item + c.nb < 2048) ml_chunk_load(R, c, item + c.nb, tid, lane, wave);
        __syncthreads();
        { const int s = tid >> 3, v16 = 16 * (tid & 7); const float e = ((LAS float*)(lds + ML_E))[s];
          const u32x4v x0 = cv0, x1 = cv1; u32x4v o0, o1;
#pragma unroll
          for (int i = 0; i < 4; ++i) { o0[i] = cvtpk(__uint_as_float(x0[i] << 16) * e, __uint_as_float(x0[i] & 0xffff0000u) * e); o1[i] = cvtpk(__uint_as_float(x1[i] << 16) * e, __uint_as_float(x1[i] & 0xffff0000u) * e); }
          *(LAS u32x4v*)(lds + ML_V + s * ML_VROW + v16 * 2) = o0; *(LAS u32x4v*)(lds + ML_V + s * ML_VROW + v16 * 2 + 16) = o1;
          if ((tid & 7) == 0) *(LAS bf16_t*)(lds + ML_V + s * ML_VROW + 256) = f2bf(e); }
        __syncthreads();
        { const int vt = wave >> 1, kt = wave & 1, li = lane & 15, g16 = lane >> 4;
          const LAS unsigned char* ap = lds + ML_V + (4 * (g16 >> 1) + (li >> 2)) * ML_VROW + (32 * vt + 16 * (g16 & 1) + 4 * (li & 3)) * 2;
          const LAS unsigned char* bp = lds + ML_K + (4 * (g16 >> 1) + (li >> 2)) * ML_KROW + (32 * kt + 16 * (g16 & 1) + 4 * (li & 3)) * 2;
          f32x16 acc = (f32x16){};
#pragma unroll
          for (int ks = 0; ks < 4; ++ks) {
              const s16x4v a0 = __builtin_bit_cast(s16x4v, __builtin_amdgcn_ds_read_tr16_b64_v4i16((LAS s16x4v*)(ap + (16 * ks) * ML_VROW)));
              const s16x4v a1 = __builtin_bit_cast(s16x4v, __builtin_amdgcn_ds_read_tr16_b64_v4i16((LAS s16x4v*)(ap + (16 * ks + 8) * ML_VROW)));
              const s16x4v b0 = __builtin_bit_cast(s16x4v, __builtin_amdgcn_ds_read_tr16_b64_v4i16((LAS s16x4v*)(bp + (16 * ks) * ML_KROW)));
              const s16x4v b1 = __builtin_bit_cast(s16x4v, __builtin_amdgcn_ds_read_tr16_b64_v4i16((LAS s16x4v*)(bp + (16 * ks + 8) * ML_KROW)));
              acc = __builtin_amdgcn_mfma_f32_32x32x16_bf16((bf16x8v){a0[0], a0[1], a0[2], a0[3], a1[0], a1[1], a1[2], a1[3]}, (bf16x8v){b0[0], b0[1], b0[2], b0[3], b1[0], b1[1], b1[2], b1[3]}, acc, 0, 0, 0);
          }
          bf16_t* dst = CC + (size_t)item * 8192 + (size_t)(32 * vt) * 64 + 32 * kt + r32;
#pragma unroll
          for (int r = 0; r < 16; ++r) dst[crow16(r, hi) * 64] = f2bf(acc[r]);
          if (wave < 2) {
              f32x16 an = (f32x16){}; const LAS unsigned char* ap2 = ap + (128 - 32 * vt) * 2;
#pragma unroll
              for (int ks = 0; ks < 4; ++ks) {
                  const s16x4v a0 = __builtin_bit_cast(s16x4v, __builtin_amdgcn_ds_read_tr16_b64_v4i16((LAS s16x4v*)(ap2 + (16 * ks) * ML_VROW)));
                  const s16x4v a1 = __builtin_bit_cast(s16x4v, __builtin_amdgcn_ds_read_tr16_b64_v4i16((LAS s16x4v*)(ap2 + (16 * ks + 8) * ML_VROW)));
                  const s16x4v b0 = __builtin_bit_cast(s16x4v, __builtin_amdgcn_ds_read_tr16_b64_v4i16((LAS s16x4v*)(bp + (16 * ks) * ML_KROW)));
                  const s16x4v b1 = __builtin_bit_cast(s16x4v, __builtin_amdgcn_ds_read_tr16_b64_v4i16((LAS s16x4v*)(bp + (16 * ks + 8) * ML_KROW)));
                  an = __builtin_amdgcn_mfma_f32_32x32x16_bf16((bf16x8v){a0[0], a0[1], a0[2], a0[3], a1[0], a1[1], a1[2], a1[3]}, (bf16x8v){b0[0], b0[1], b0[2], b0[3], b1[0], b1[1], b1[2], b1[3]}, an, 0, 0, 0);
              }
              if (hi == 0) nch[(size_t)item * 64 + 32 * kt + r32] = an[0];
          } }
        __syncthreads();
    }
}

__device__ __forceinline__ void ph_ml_scan(const Ctx& c_) {
    Ctx c = c_; c.lane = (int)__builtin_amdgcn_mbcnt_hi(~0u, __builtin_amdgcn_mbcnt_lo(~0u, 0u)); asm volatile("" : "+v"(c.lane)); c.tid = c.wave * 64 + c.lane; asm volatile("" : "+s"(c.bid)); asm volatile("" : "+s"(c.ws));
    const bf16_t* CC = (const bf16_t*)(c.ws + WS_CC); bf16_t* CP = (bf16_t*)(c.ws + WS_CPREV); float* scal = (float*)(c.ws + WS_SCAL);
    const float* nch = (const float*)(c.ws + WS_NCH); float* npv = (float*)(c.ws + WS_NPREV);
    for (int sl = c.bid; sl < 256; sl += c.nb) {
        const int bh = sl >> 2, qt = sl & 3; const size_t e0 = (size_t)qt * 2048 + 4 * c.tid;
        float C0 = 0.f, C1 = 0.f, C2 = 0.f, C3 = 0.f, m = 0.f, nst = 0.f;
        const bool do_n = (qt == 0 && c.tid < 64);
        uint2 pre[4];
#pragma unroll
        for (int i = 0; i < 4; ++i) pre[i] = *(const uint2*)(CC + (size_t)(bh * 32 + i) * 8192 + e0);
        for (int c4 = 0; c4 < 32; c4 += 4) {
#pragma unroll
            for (int i = 0; i < 4; ++i) { const int ch = c4 + i, item = bh * 32 + ch;
                const uint2 cur = pre[i];
                if (ch + 4 < 32) pre[i] = *(const uint2*)(CC + (size_t)(item + 4) * 8192 + e0);
                uint2 o; o.x = cvtpk(C0, C1); o.y = cvtpk(C2, C3);
                *(uint2*)(CP + (size_t)item * 8192 + e0) = o;
                if (do_n) npv[(size_t)item * 64 + c.tid] = nst;
                if (qt == 0 && c.tid == 0) scal[4096 + item] = m;
                const float be = scal[item], ae = scal[2048 + item];
                const float mn = fmaxf(be + m, ae), dec = __expf(be + m - mn), inj = __expf(ae - mn);
                C0 = dec * C0 + inj * __uint_as_float(cur.x << 16); C1 = dec * C1 + inj * __uint_as_float(cur.x & 0xffff0000u);
                C2 = dec * C2 + inj * __uint_as_float(cur.y << 16); C3 = dec * C3 + inj * __uint_as_float(cur.y & 0xffff0000u);
                if (do_n) nst = dec * nst + inj * nch[(size_t)item * 64 + c.tid];
                m = mn; }
        }
    }
}

constexpr int M3_K = 0, M3_V = 64 * AT_KROW, M3_VEC = M3_V + 64 * ML_VROW, M3_SS = M3_VEC + 2048;
struct MlIn { u32x4v k, v0, v1; bf16x8v q[4], cp[4]; float ig, bc, np, mprev; uint2 lo[4]; float4 g[4]; };
__device__ __forceinline__ void ml_out_load(MlIn& R, const Ctx& c, int L, int item, int tid, int lane, int wave) {
    const bf16_t* Z = (const bf16_t*)(c.ws + WS_Z); const bf16_t* QKC = (const bf16_t*)(c.ws + WS_QKC); const float* gates = (const float*)(c.ws + WS_GATES);
    const float* scal = (const float*)(c.ws + WS_SCAL); const float* npv = (const float*)(c.ws + WS_NPREV); const bf16_t* CP = (const bf16_t*)(c.ws + WS_CPREV);
    const float* hg = c.head_g + (size_t)L * DM + 256;
    const int r32 = lane & 31, hi = lane >> 5, th = wave & 1, vq = wave >> 1;
    const int bh = item >> 5, ch = item & 31, b = bh >> 2, h = bh & 3; const size_t row0 = (size_t)b * SEQ + 64 * ch;
    { const int s = tid >> 3, c8 = 8 * (tid & 7);
      R.k = *(const u32x4v*)(QKC + (row0 + s) * 512 + 256 + 64 * h + c8);
      const bf16_t* zr = Z + (row0 + s) * DINP + ZC_LV + 128 * h + 2 * c8; R.v0 = *(const u32x4v*)zr; R.v1 = *(const u32x4v*)(zr + 8); }
    const int tl = 32 * th + r32; const size_t mrow = row0 + tl;
#pragma unroll
    for (int d0 = 0; d0 < 4; ++d0) { R.q[d0] = *(const bf16x8v*)(QKC + mrow * 512 + 64 * h + 16 * d0 + 8 * hi);
        R.cp[d0] = *(const bf16x8v*)(CP + (size_t)item * 8192 + (size_t)(32 * vq + r32) * 64 + 8 * hi + 16 * d0); }
    if (wave == 0) { const size_t m = row0 + lane; R.ig = gates[m * 8 + h]; R.bc = gates[m * 8 + 4 + h]; R.np = npv[(size_t)item * 64 + lane]; }
    R.mprev = scal[4096 + item];
#pragma unroll
    for (int q4 = 0; q4 < 4; ++q4) { const int v = 32 * vq + 8 * q4 + 4 * hi; R.lo[q4] = *(const uint2*)(Z + mrow * DINP + ZC_LO + 128 * h + v); R.g[q4] = *(const float4*)(hg + 128 * h + v); }
}
__device__ __forceinline__ void ph_ml_out(const Ctx& c_, int L) {
    Ctx c = c_; c.lane = (int)__builtin_amdgcn_mbcnt_hi(~0u, __builtin_amdgcn_mbcnt_lo(~0u, 0u)); asm volatile("" : "+v"(c.lane)); c.tid = c.wave * 64 + c.lane; asm volatile("" : "+s"(c.bid)); asm volatile("" : "+s"(c.ws));
    bf16_t* Y = (bf16_t*)(c.ws + WS_Y);
    LAS unsigned char* lds = (LAS unsigned char*)c.lds;
    const int wave = c.wave, th = wave & 1, vq = wave >> 1;
    LAS float* uvec = (LAS float*)(lds + M3_VEC); LAS float* pmv = uvec + 64; LAS float* bcv = uvec + 128; LAS float* npl = uvec + 192; LAS float* ssl = (LAS float*)(lds + M3_SS);
    MlIn R;
    if (c.bid < 2048) ml_out_load(R, c, L, c.bid, c.tid, c.lane, wave);
    for (int item = c.bid; item < 2048; item += c.nb) {
        int lane = c.lane; asm volatile("" : "+v"(lane)); const int tid = wave * 64 + lane, r32 = lane & 31, hi = lane >> 5;
        const int bh = item >> 5, ch = item & 31, b = bh >> 2, h = bh & 3;
        const size_t row0 = (size_t)b * SEQ + 64 * ch;
        { const int s = tid >> 3, c8 = 8 * (tid & 7);
          *(LAS u32x4v*)(lds + M3_K + s * AT_KROW + c8 * 2) = R.k;
          *(LAS u32x4v*)(lds + M3_V + s * ML_VROW + c8 * 4) = R.v0; *(LAS u32x4v*)(lds + M3_V + s * ML_VROW + c8 * 4 + 16) = R.v1; }
        if (wave == 0) { const float u = R.ig - R.bc;
            float pm = u;
#pragma unroll
            for (int o = 1; o < 64; o <<= 1) { const float up = lane_get(pm, lane - o); if (lane >= o) pm = fmaxf(pm, up); }
            uvec[lane] = u * 1.4426950408889634f; pmv[lane] = pm; bcv[lane] = R.bc; npl[lane] = R.np; }
        const float mprev = R.mprev;
        const int tl = 32 * th + r32; const size_t mrow = row0 + tl;
        bf16x8v qf[4], cpf[4]; uint2 lo4[4]; float4 g4[4];
#pragma unroll
        for (int d0 = 0; d0 < 4; ++d0) { qf[d0] = R.q[d0]; cpf[d0] = R.cp[d0]; lo4[d0] = R.lo[d0]; g4[d0] = R.g[d0]; }
        if (item + c.nb < 2048) ml_out_load(R, c, L, item + c.nb, tid, lane, wave);
        f32x16 acc2 = (f32x16){};
#pragma unroll
        for (int d0 = 0; d0 < 4; ++d0) acc2 = __builtin_amdgcn_mfma_f32_32x32x16_bf16(cpf[d0], qf[d0], acc2, 0, 0, 0);
        __syncthreads();
        f32x16 p0 = (f32x16){}, p1 = (f32x16){};
        { const LAS unsigned char* kp = lds + M3_K + r32 * AT_KROW + hi * 16;
#pragma unroll
          for (int d0 = 0; d0 < 4; ++d0) {
              p0 = __builtin_amdgcn_mfma_f32_32x32x16_bf16(*(const LAS bf16x8v*)(kp + d0 * 32), qf[d0], p0, 0, 0, 0);
              p1 = __builtin_amdgcn_mfma_f32_32x32x16_bf16(*(const LAS bf16x8v*)(kp + 32 * AT_KROW + d0 * 32), qf[d0], p1, 0, 0, 0); } }
        const float bct = bcv[tl], mt = bct + fmaxf(mprev, pmv[tl]);
        const float eb2 = (bct - mt) * 1.4426950408889634f;
        const int tlim = tl - 4 * hi; float dsum = 0.f; const LAS float* ub = uvec + 4 * hi;
#pragma unroll
        for (int r = 0; r < 16; ++r) { const int cr = (r & 3) + 8 * (r >> 2);
            const float w0 = (cr <= tlim) ? __builtin_amdgcn_exp2f(eb2 + ub[cr]) : 0.f, w1 = (cr + 32 <= tlim) ? __builtin_amdgcn_exp2f(eb2 + ub[cr + 32]) : 0.f;
            p0[r] *= w0; p1[r] *= w1; dsum += p0[r] + p1[r]; }
        dsum = xhalf_sum(dsum);
        const float winter = __builtin_amdgcn_exp2f((bct + mprev - mt) * 1.4426950408889634f);
        float qn = 0.f; const LAS float* nb8 = npl + 8 * hi;
#pragma unroll
        for (int d0 = 0; d0 < 4; ++d0)
#pragma unroll
            for (int j = 0; j < 8; ++j) qn += bf2f((bf16_t)qf[d0][j]) * nb8[16 * d0 + j];
        qn = xhalf_sum(qn);
        const float den = dsum + winter * qn;
        const float rden = __builtin_amdgcn_rcpf(fmaxf(fabsf(den), __builtin_amdgcn_exp2f(-1.4426950408889634f * mt)));
        f32x16 acc1 = (f32x16){};
        { bf16x8v pf[4]; u32x4v w;
          w = (u32x4v){cvtpk(p0[0], p0[1]), cvtpk(p0[2], p0[3]), cvtpk(p0[4], p0[5]), cvtpk(p0[6], p0[7])}; pf[0] = __builtin_bit_cast(bf16x8v, w);
          w = (u32x4v){cvtpk(p0[8], p0[9]), cvtpk(p0[10], p0[11]), cvtpk(p0[12], p0[13]), cvtpk(p0[14], p0[15])}; pf[1] = __builtin_bit_cast(bf16x8v, w);
          w = (u32x4v){cvtpk(p1[0], p1[1]), cvtpk(p1[2], p1[3]), cvtpk(p1[4], p1[5]), cvtpk(p1[6], p1[7])}; pf[2] = __builtin_bit_cast(bf16x8v, w);
          w = (u32x4v){cvtpk(p1[8], p1[9]), cvtpk(p1[10], p1[11]), cvtpk(p1[12], p1[13]), cvtpk(p1[14], p1[15])}; pf[3] = __builtin_bit_cast(bf16x8v, w);
          const int li = lane & 15, g16 = lane >> 4;
          const LAS unsigned char* vp = lds + M3_V + (4 * (g16 >> 1) + (li >> 2)) * ML_VROW + (32 * vq + 16 * (g16 & 1) + 4 * (li & 3)) * 2;
#pragma unroll
          for (int ks = 0; ks < 4; ++ks) {
              const s16x4v a0 = __builtin_bit_cast(s16x4v, __builtin_amdgcn_ds_read_tr16_b64_v4i16((LAS s16x4v*)(vp + (16 * ks) * ML_VROW)));
              const s16x4v a1 = __builtin_bit_cast(s16x4v, __builtin_amdgcn_ds_read_tr16_b64_v4i16((LAS s16x4v*)(vp + (16 * ks + 8) * ML_VROW)));
              acc1 = __builtin_amdgcn_mfma_f32_32x32x16_bf16((bf16x8v){a0[0], a0[1], a0[2], a0[3], a1[0], a1[1], a1[2], a1[3]}, pf[ks], acc1, 0, 0, 0); } }
        float ss = 0.f;
#pragma unroll
        for (int r = 0; r < 16; ++r) { acc1[r] = (acc1[r] + winter * acc2[r]) * rden; ss += acc1[r] * acc1[r]; }
        ss = xhalf_sum(ss);
        if (hi == 0) ssl[vq * 64 + tl] = ss;
        __syncthreads();
        const float sst = ssl[tl] + ssl[64 + tl] + ssl[128 + tl] + ssl[192 + tl];
        const float rn = rsqrtf(sst * (1.f / 128.f) + EPS);
#pragma unroll
        for (int q4 = 0; q4 < 4; ++q4) { const int v = 32 * vq + 8 * q4 + 4 * hi;
            const float4 gg = g4[q4]; const uint2 lo = lo4[q4];
            const float y0 = acc1[4 * q4] * rn * gg.x * sigmoidf_(__uint_as_float(lo.x << 16)), y1 = acc1[4 * q4 + 1] * rn * gg.y * sigmoidf_(__uint_as_float(lo.x & 0xffff0000u));
            const float y2 = acc1[4 * q4 + 2] * rn * gg.z * sigmoidf_(__uint_as_float(lo.y << 16)), y3 = acc1[4 * q4 + 3] * rn * gg.w * sigmoidf_(__uint_as_float(lo.y & 0xffff0000u));
            uint2 w; w.x = cvtpk(y0, y1); w.y = cvtpk(y2, y3);
            *(uint2*)(Y + mrow * DM + 256 + 128 * h + v) = w; }
        __syncthreads();
    }
}

#ifndef R_P
#define R_P 0
#endif
constexpr int LDS_BYTES = 147456;
constexpr int LDSCTL_OFF = 131072, MISC_OFF = LDSCTL_OFF + 320;
struct Args { const float* in[13]; float* out; unsigned char* ws; };
#define REP(k, ...) { int n_ = (R_P == (k)) ? 2 : 1; asm volatile("" : "+s"(n_)); _Pragma("unroll 1") for (int r_ = 0; r_ < n_; ++r_) { __VA_ARGS__ } }

__global__ void __launch_bounds__(512, 2) mega_fwd(Args args) {
    extern __shared__ __attribute__((aligned(16))) unsigned char lds[];
    Ctx c;
    c.x_in = args.in[0]; c.norm_g = args.in[1]; c.w_in = args.in[2]; c.conv_w = args.in[3]; c.conv_b = args.in[4]; c.gate_b = args.in[5]; c.cmp_pe = args.in[6];
    c.cmp_w1 = args.in[7]; c.cmp_w2 = args.in[8]; c.head_g = args.in[9]; c.w_out = args.in[10]; c.w1 = args.in[11]; c.w2 = args.in[12];
    c.xo = args.out; c.ws = args.ws; c.lds = lds;
    c.tid = threadIdx.x; c.lane = c.tid & 63; c.wave = __builtin_amdgcn_readfirstlane(c.tid >> 6); asm volatile("" : "+s"(c.wave)); c.bid = blockIdx.x; c.nb = gridDim.x;
    for (int u = c.tid; u < (LDS_BYTES - LDSCTL_OFF) / 4; u += 512) ((LAS unsigned*)((LAS unsigned char*)lds + LDSCTL_OFF))[u] = 0u;
    __syncthreads();
    unsigned* ctl = (unsigned*)(c.ws + WS_CTL);
    XcdBarrier bar = xcd_barrier_post(ctl + CW_BAR, (volatile LAS unsigned*)((LAS unsigned char*)lds + MISC_OFF) + 8);
#define GRID_BAR() xcd_barrier(bar)
    bf16_t* Win_t = (bf16_t*)(c.ws + WS_WIN); bf16_t* Wout_t = (bf16_t*)(c.ws + WS_WOUT); bf16_t* W1_t = (bf16_t*)(c.ws + WS_W1); bf16_t* W2_t = (bf16_t*)(c.ws + WS_W2);
    bf16_t* Z = (bf16_t*)(c.ws + WS_Z); bf16_t* Y = (bf16_t*)(c.ws + WS_Y); bf16_t* H = (bf16_t*)(c.ws + WS_H); bf16_t* T = (bf16_t*)(c.ws + WS_T); bf16_t* T2 = (bf16_t*)(c.ws + WS_T2); bf16_t* XB = (bf16_t*)(c.ws + WS_XB);
    float* RS = (float*)(c.ws + WS_RS);

    ph_wconv(c, 0); ph_wconv_cmp(c, 0); ph_cpe_all(c);
    ph_resid<false, true>(c, c.x_in, (const bf16_t*)nullptr, XB, nullptr, RS);
    GRID_BAR();
    for (int L = 0; L < DEPTH; ++L) {
        const float* ng = c.norm_g + (size_t)L * 4 * DM;
        REP(1, { pg8::Gemm g{XB, Win_t, MTOK, DINP, DM, 0}; pg8::StaticOrder S; S.init(MTOK, DINP, c.nb, c.bid); pg8::EpiBf16<0> E{Z, RS, DINP, 0};
          pg8::gemm_phase<pg8::EpiBf16<0>, pg8::StaticOrder, true, true>((PG8_LAS unsigned char*)lds, g, S, E, c.wave); })
        GRID_BAR();
        REP(2, ph_kmean(c); ph_cmp(c, L); ph_ml_chunk(c, L);)
        GRID_BAR();
        REP(3, ph_ml_scan(c); ph_moba(c, L);)
        GRID_BAR();
        REP(4, ph_ml_out(c, L); ph_nsa(c, L);)
        GRID_BAR();
        REP(1, { pg8::Gemm g{Y, Wout_t, MTOK, DM, DM, 0}; pg8::StaticOrder S; S.init(MTOK, DM, c.nb, c.bid); pg8::EpiBf16<0> E{T, nullptr, DM, 0};
          pg8::gemm_phase<pg8::EpiBf16<0>, pg8::StaticOrder, true, true>((PG8_LAS unsigned char*)lds, g, S, E, c.wave); })
        GRID_BAR();
        if (L == 0) ph_resid<false, true>(c, c.x_in, T, XB, ng + DM, RS); else ph_resid<true, true>(c, XB, T, XB, ng + DM, RS);
        GRID_BAR();
        REP(1, { pg8::Gemm g{XB, W1_t, MTOK, DFF, DM, 0}; pg8::StaticOrder S; S.init(MTOK, DFF, c.nb, c.bid); pg8::EpiBf16<1> E{H, RS, DFF, 0};
          pg8::gemm_phase<pg8::EpiBf16<1>, pg8::StaticOrder, true, true>((PG8_LAS unsigned char*)lds, g, S, E, c.wave); })
        GRID_BAR();
        REP(1, { pg8::Gemm g{H, W2_t, MTOK, DM, DFF, 0}; pg8::StaticOrder S; S.init(MTOK, DM, c.nb, c.bid); pg8::EpiBf16<0> E{T2, nullptr, DM, 0};
          pg8::gemm_phase<pg8::EpiBf16<0>, pg8::StaticOrder, true, true>((PG8_LAS unsigned char*)lds, g, S, E, c.wave); })
        GRID_BAR();
        if (L + 1 < DEPTH) { ph_resid<true, true>(c, XB, T2, XB, ng + 3 * DM, RS); ph_wconv(c, L + 1); ph_wconv_cmp(c, L + 1); GRID_BAR(); }
        else ph_resid<true, false>(c, XB, T2, c.xo, ng + 3 * DM, nullptr);
    }
#undef GRID_BAR
}

extern "C" void kernel_launch(void* const* d_in, const int* in_sizes, int n_in, void* d_out, int out_size, void* d_ws, size_t ws_size, hipStream_t stream) {
    static int grid = 0;
    if (grid == 0) {
        if (n_in != 13 || in_sizes[0] != MTOK * DM || out_size != MTOK * DM || ws_size < WS_END) { fprintf(stderr, "kernel_launch: unexpected shapes / workspace (%zu)\n", ws_size); grid = -1; return; }
        int dev = 0, cus = 0, per_cu = 0;
        if (hipGetDevice(&dev) != hipSuccess || hipDeviceGetAttribute(&cus, hipDeviceAttributeMultiprocessorCount, dev) != hipSuccess) { grid = -1; return; }
        if (hipFuncSetAttribute((const void*)mega_fwd, hipFuncAttributeMaxDynamicSharedMemorySize, LDS_BYTES) != hipSuccess) { fprintf(stderr, "hipFuncSetAttribute failed\n"); grid = -1; return; }
        if (hipOccupancyMaxActiveBlocksPerMultiprocessor(&per_cu, (const void*)mega_fwd, 512, LDS_BYTES) != hipSuccess || per_cu < 1) { fprintf(stderr, "occupancy query: %d\n", per_cu); (void)hipGetLastError(); }
        grid = cus;
    }
    if (grid < 0) return;
    if (hipMemsetAsync((char*)d_ws + WS_CTL, 0, CTL_ZERO_BYTES, stream) != hipSuccess) return;
    Args a{};
    for (int i = 0; i < 13; ++i) a.in[i] = (const float*)d_in[i];
    a.out = (float*)d_out; a.ws = (unsigned char*)d_ws;
    hipLaunchKernelGGL(mega_fwd, dim3(grid), dim3(512), LDS_BYTES, stream, a);
}
```
